# Optimizing an MI355X kernel written in HIP

```python
import jax, jax.numpy as jnp
from jax import lax
import numpy as np

D_MODEL = 1024
BATCH = 4
SEQ = 8192
DEPTH = 1
DEC_BATCH = 8
DEC_SEQ = 32
PAST_LEN = 1024

CHUNK = 64
GLA_HEADS = 4
GLA_DK = 64
GLA_DV = 128
GLA_GATE_RANK = 16
GLA_GATE_NORM = 16.0
HG_HEADS = 4
HG_EXPAND = 128
HG_HEAD_DIM = 128
D_FF = 2816
EPS = 1e-6
D_IN = 2 * GLA_HEADS * GLA_DK + 2 * GLA_HEADS * GLA_DV + GLA_GATE_RANK + 2 * HG_HEADS * HG_EXPAND + 2 * HG_HEADS * HG_HEAD_DIM
D_MIX = GLA_HEADS * GLA_DV + HG_HEADS * HG_HEAD_DIM

kernel_name = "hybrid_gla_hgrn2_macaron_stream_step"


def _split_indices():
    sizes = (GLA_HEADS * GLA_DK, GLA_HEADS * GLA_DK, GLA_HEADS * GLA_DV, GLA_HEADS * GLA_DV, GLA_GATE_RANK,
             HG_HEADS * HG_EXPAND, HG_HEADS * HG_EXPAND, HG_HEADS * HG_HEAD_DIM, HG_HEADS * HG_HEAD_DIM)
    idx, acc = [], 0
    for s in sizes[:-1]:
        acc += s
        idx.append(acc)
    return idx


def _rmsnorm(x, g):
    xf = x.astype(jnp.float32)
    y = xf * lax.rsqrt(jnp.mean(xf * xf, axis=-1, keepdims=True) + EPS) * g.astype(jnp.float32)
    return y.astype(x.dtype)


def _swiglu(h, w_gate, w_up, w_down):
    return (jax.nn.silu(h @ w_gate) * (h @ w_up)) @ w_down


def _gated_head_norm(o, g, gate):
    o = o * lax.rsqrt(jnp.mean(o * o, axis=-1, keepdims=True) + EPS) * g.astype(jnp.float32)
    return o * jax.nn.silu(gate.astype(jnp.float32))


def _chunked_gated_recurrence(q, k, v, log_a, s0, L):
    B, T, H, dk = q.shape
    dv = v.shape[-1]
    N = T // L

    def to_blocks(a):
        return a.astype(jnp.float32).reshape(B, N, L, H, a.shape[-1]).transpose(1, 0, 3, 2, 4)

    causal = jnp.tril(jnp.ones((L, L), dtype=bool))[:, :, None]

    def step(S, blk):
        qc, kc, vc, gc = blk
        b = jnp.cumsum(gc, axis=-2)
        decay = jnp.exp(jnp.where(causal, b[..., :, None, :] - b[..., None, :, :], -jnp.inf))
        scores = jnp.einsum('bhid,bhijd,bhjd->bhij', qc, decay, kc)
        o = jnp.einsum('bhid,bhde->bhie', qc * jnp.exp(b), S) + jnp.einsum('bhij,bhje->bhie', scores, vc)
        b_last = b[..., -1:, :]
        S = S * jnp.exp(b_last[..., 0, :])[..., None] + jnp.einsum('bhjd,bhje->bhde', kc * jnp.exp(b_last - b), vc)
        return S, o

    S, o = lax.scan(step, s0.astype(jnp.float32), (to_blocks(q), to_blocks(k), to_blocks(v), to_blocks(log_a)))
    o = o.transpose(1, 0, 3, 2, 4).reshape(B, T, H, dv)
    return o, S


def _mixer(h, w_in, gla_gate_up, gla_gate_bias, gla_onorm, hg_onorm, lb, s_gla, s_hg, L):
    B, T, _ = h.shape
    proj = h @ w_in
    gq, gk, gv, gr, gd, hq, hf, hi, hgate = jnp.split(proj, _split_indices(), axis=-1)
    gla_log_a = jax.nn.log_sigmoid((gd @ gla_gate_up + gla_gate_bias).astype(jnp.float32)) / GLA_GATE_NORM
    q = gq.reshape(B, T, GLA_HEADS, GLA_DK) * (GLA_DK ** -0.5)
    k = gk.reshape(B, T, GLA_HEADS, GLA_DK)
    v = gv.reshape(B, T, GLA_HEADS, GLA_DV)
    o_gla, s_gla_new = _chunked_gated_recurrence(q, k, v, gla_log_a.reshape(B, T, GLA_HEADS, GLA_DK), s_gla, L)
    o_gla = _gated_head_norm(o_gla, gla_onorm, gr.reshape(B, T, GLA_HEADS, GLA_DV))
    z = hf.astype(jnp.float32).reshape(B, T, HG_HEADS, HG_EXPAND)
    lb = lb.reshape(HG_HEADS, HG_EXPAND)
    f = lb + (1.0 - lb) * jax.nn.sigmoid(z)
    hk = (1.0 - lb) * jax.nn.sigmoid(-z)
    hqs = jax.nn.silu(hq.astype(jnp.float32)).reshape(B, T, HG_HEADS, HG_EXPAND)
    hv = hi.reshape(B, T, HG_HEADS, HG_HEAD_DIM)
    o_hg, s_hg_new = _chunked_gated_recurrence(hqs, hk, hv, jnp.log(f), s_hg, L)
    o_hg = _gated_head_norm(o_hg, hg_onorm, hgate.reshape(B, T, HG_HEADS, HG_HEAD_DIM))
    o = jnp.concatenate([o_gla.reshape(B, T, -1), o_hg.reshape(B, T, -1)], axis=-1)
    return o.astype(h.dtype), s_gla_new, s_hg_new


def _trunk(x, s_gla, s_hg, L, params, lb_all):
    (norm_ffn1, ffn1_w_gate, ffn1_w_up, ffn1_w_down, norm_mix, w_in, gla_gate_up, gla_gate_bias,
     gla_onorm, hg_onorm, w_out, norm_ffn2, ffn2_w_gate, ffn2_w_up, ffn2_w_down, norm_final) = params
    new_gla, new_hg = [], []
    for l in range(DEPTH):
        x = x + 0.5 * _swiglu(_rmsnorm(x, norm_ffn1[l]), ffn1_w_gate[l], ffn1_w_up[l], ffn1_w_down[l])
        mix, sg, sh = _mixer(_rmsnorm(x, norm_mix[l]), w_in[l], gla_gate_up[l], gla_gate_bias[l],
                             gla_onorm[l], hg_onorm[l], lb_all[l], s_gla[l], s_hg[l], L)
        x = x + mix @ w_out[l]
        x = x + 0.5 * _swiglu(_rmsnorm(x, norm_ffn2[l]), ffn2_w_gate[l], ffn2_w_up[l], ffn2_w_down[l])
        new_gla.append(sg)
        new_hg.append(sh)
    return _rmsnorm(x, norm_final), jnp.stack(new_gla), jnp.stack(new_hg)


def setup_inputs(seed: int = 0) -> dict:
    key = jax.random.key(seed)
    ks = jax.random.split(key, 24)
    f32 = jnp.float32
    nrm = lambda k, shape, s: jax.random.normal(k, shape, f32) * s
    gain = lambda k, shape: 1.0 + 0.01 * jax.random.normal(k, shape, f32)
    return {
        "x_prompt": nrm(ks[0], (BATCH, SEQ, D_MODEL), 1.0),
        "x_sample": nrm(ks[1], (DEC_BATCH, DEC_SEQ, D_MODEL), 1.0),
        "state_gla": nrm(ks[2], (DEPTH, DEC_BATCH, GLA_HEADS, GLA_DK, GLA_DV), 1.0),
        "state_hgrn": nrm(ks[3], (DEPTH, DEC_BATCH, HG_HEADS, HG_EXPAND, HG_HEAD_DIM), 1.0),
        "norm_ffn1": gain(ks[4], (DEPTH, D_MODEL)),
        "ffn1_w_gate": nrm(ks[5], (DEPTH, D_MODEL, D_FF), D_MODEL ** -0.5),
        "ffn1_w_up": nrm(ks[6], (DEPTH, D_MODEL, D_FF), D_MODEL ** -0.5),
        "ffn1_w_down": nrm(ks[7], (DEPTH, D_FF, D_MODEL), D_FF ** -0.5),
        "norm_mix": gain(ks[8], (DEPTH, D_MODEL)),
        "w_in": nrm(ks[9], (DEPTH, D_MODEL, D_IN), D_MODEL ** -0.5),
        "gla_gate_up": nrm(ks[10], (DEPTH, GLA_GATE_RANK, GLA_HEADS * GLA_DK), GLA_GATE_RANK ** -0.5),
        "gla_gate_bias": nrm(ks[11], (DEPTH, GLA_HEADS * GLA_DK), 0.01),
        "gla_onorm": gain(ks[12], (DEPTH, GLA_DV)),
        "hg_lower_bound_logits": nrm(ks[13], (DEPTH + 1, HG_HEADS * HG_EXPAND), 0.1),
        "hg_onorm": gain(ks[14], (DEPTH, HG_HEAD_DIM)),
        "w_out": nrm(ks[15], (DEPTH, D_MIX, D_MODEL), D_MIX ** -0.5),
        "norm_ffn2": gain(ks[16], (DEPTH, D_MODEL)),
        "ffn2_w_gate": nrm(ks[17], (DEPTH, D_MODEL, D_FF), D_MODEL ** -0.5),
        "ffn2_w_up": nrm(ks[18], (DEPTH, D_MODEL, D_FF), D_MODEL ** -0.5),
        "ffn2_w_down": nrm(ks[19], (DEPTH, D_FF, D_MODEL), D_FF ** -0.5),
        "norm_final": gain(ks[20], (D_MODEL,)),
    }


def reference(x_prompt, x_sample, state_gla, state_hgrn, norm_ffn1, ffn1_w_gate, ffn1_w_up, ffn1_w_down,
              norm_mix, w_in, gla_gate_up, gla_gate_bias, gla_onorm, hg_lower_bound_logits, hg_onorm, w_out,
              norm_ffn2, ffn2_w_gate, ffn2_w_up, ffn2_w_down, norm_final):
    params = (norm_ffn1, ffn1_w_gate, ffn1_w_up, ffn1_w_down, norm_mix, w_in, gla_gate_up, gla_gate_bias,
              gla_onorm, hg_onorm, w_out, norm_ffn2, ffn2_w_gate, ffn2_w_up, ffn2_w_down, norm_final)
    lb_all = jnp.cumsum(jax.nn.softmax(hg_lower_bound_logits.astype(jnp.float32), axis=0), axis=0)
    Bp = x_prompt.shape[0]
    zero_gla = jnp.zeros((DEPTH, Bp, GLA_HEADS, GLA_DK, GLA_DV), jnp.float32)
    zero_hg = jnp.zeros((DEPTH, Bp, HG_HEADS, HG_EXPAND, HG_HEAD_DIM), jnp.float32)
    L_prompt = min(CHUNK, x_prompt.shape[1])
    y_prompt, gla_p, hg_p = _trunk(x_prompt, zero_gla, zero_hg, L_prompt, params, lb_all)
    y_sample, gla_s, hg_s = _trunk(x_sample, state_gla, state_hgrn, x_sample.shape[1], params, lb_all)
    sd_g, sd_h = state_gla.dtype, state_hgrn.dtype
    return (y_prompt, y_sample, gla_p.astype(sd_g), hg_p.astype(sd_h), gla_s.astype(sd_g), hg_s.astype(sd_h))
```

```cpp
#include <hip/hip_runtime.h>
#include <hip/hip_cooperative_groups.h>
#include <cstdio>
#include <cstdint>
namespace cg = cooperative_groups;
namespace pg8 {
#define PG8_LAS __attribute__((address_space(3)))
typedef unsigned short bf16_t;
typedef short bf16x8 __attribute__((ext_vector_type(8)));
typedef float f32x4 __attribute__((ext_vector_type(4)));
typedef unsigned u32x4 __attribute__((ext_vector_type(4)));
constexpr int BM = 256, BK = 64, HALF = 128, HTB = HALF * BK * 2  , STAGE_BYTES = 8 * HTB, NXCD = 8, WGM = 8;

__host__ __device__ __forceinline__ int lds_byte(int r, int c) { const int st = (r >> 4) * 2 + (c >> 5), rr = r & 15, cc = c & 31, ob = rr * 64 + cc * 2; return st * 1024 + (ob ^ (((ob >> 9) & 1) << 5)); }
__host__ __device__ __forceinline__ void stage_rc(int b, int& R, int& C) { const int st = b / 1024, sb = b % 1024, swz = sb ^ (((sb >> 9) & 1) << 5); R = (st >> 1) * 16 + swz / 64; C = (st & 1) * 32 + (swz % 64) / 2; }
__host__ __device__ __forceinline__ int perm32(int rho) { const int n = rho >> 4, i = rho & 15; return 8 * (i >> 2) + 4 * n + (i & 3); }

struct Unit { int pm, pn; };
struct Gemm { const bf16_t* A; const bf16_t* Bt; int M, N, K; };

struct StaticOrder {
    int nM, nN, nwg, G, c;
    __host__ __device__ void init(int M, int N, int G_, int c_) { nM = M / BM; nN = N / BM; nwg = nM * nN; G = G_; c = c_; }
    __host__ __device__ bool next(int i, Unit& u) const {
        const long L = (long)i * G + c; if (L >= nwg) return false;
        int wgid = (int)L; { const int q = nwg / NXCD, r = nwg % NXCD, xcd = wgid % NXCD, off = wgid / NXCD; wgid = (xcd < r ? xcd * (q + 1) : r * (q + 1) + (xcd - r) * q) + off; }
        const int nig = WGM * nN, gid = wgid / nig, fm = gid * WGM, gsz = (nM - fm) < WGM ? (nM - fm) : WGM;
        u.pm = fm + ((wgid % nig) % gsz); u.pn = (wgid % nig) / gsz; return true;
    }
    __device__ __forceinline__ void a_ready(const Unit&) const {}
    __device__ __forceinline__ void done(const Unit&) const {}
};

__device__ __forceinline__ unsigned cvt_pk_bf16(float lo, float hi) { unsigned r; asm volatile("v_cvt_pk_bf16_f32 %0, %1, %2" : "=v"(r) : "v"(lo), "v"(hi)); return r; }
typedef float f32x2 __attribute__((ext_vector_type(2)));
constexpr float RMS_EPS = 1e-6f;
__device__ __forceinline__ float silu_f(float g) { return g * __builtin_amdgcn_rcpf(1.0f + __expf(-g)); }
__device__ __forceinline__ float rstd_of(const float* ssq, int row) { return rsqrtf(ssq[row] * (1.0f / 1024.0f) + RMS_EPS); }

struct EpiUp {
    static constexpr bool PERM = true, AFTER_DRAIN = false;
    bf16_t* H; int ldh; const float* ssq;
    __device__ __forceinline__ void operator()(const f32x4 (&acc)[2][2][4][2], const Unit& u, int wr, int wc, int fr, int fq) const {
        const int row0 = u.pm * BM + wr * 64 + fr, hcol0 = u.pn * HALF + wc * 32 + 8 * fq;
#pragma unroll
        for (int ai = 0; ai < 2; ++ai)
#pragma unroll
            for (int m = 0; m < 4; ++m) {
                const int row = row0 + ai * HALF + m * 16; const float rs = rstd_of(ssq, row);
                float h[8];
#pragma unroll
                for (int n = 0; n < 2; ++n)
#pragma unroll
                    for (int i = 0; i < 4; ++i) { const float g = acc[ai][0][m][n][i] * rs, uu = acc[ai][1][m][n][i] * rs; h[4 * n + i] = silu_f(g) * uu; }
                u32x4 w; w.x = cvt_pk_bf16(h[0], h[1]); w.y = cvt_pk_bf16(h[2], h[3]); w.z = cvt_pk_bf16(h[4], h[5]); w.w = cvt_pk_bf16(h[6], h[7]);
                *(u32x4*)(H + (size_t)row * ldh + hcol0) = w;
            }
    }
};

struct EpiRes {
    static constexpr bool PERM = false, AFTER_DRAIN = false;
    const float* xi0; const float* xi1; int split_pm;
    float* xo; bf16_t* xob; float* ssq; float scale;
    __device__ __forceinline__ void operator()(const f32x4 (&acc)[2][2][4][2], const Unit& u, int wr, int wc, int fr, int fq) const {
        typedef unsigned u32x2v __attribute__((ext_vector_type(2)));
        const int row0 = u.pm * BM + wr * 64 + fr, col0 = u.pn * BM + wc * 32 + 4 * fq;
        const float* xin = (u.pm < split_pm) ? xi0 : (xi1 - (size_t)split_pm * BM * 1024);
#pragma unroll
        for (int ai = 0; ai < 2; ++ai)
#pragma unroll
            for (int m = 0; m < 4; ++m) {
                const int row = row0 + ai * HALF + m * 16; const size_t off = (size_t)row * 1024 + col0; float s = 0.f;
#pragma unroll
                for (int bj = 0; bj < 2; ++bj)
#pragma unroll
                    for (int n = 0; n < 2; ++n) {
                        const f32x4 b = *(const f32x4*)(xin + off + bj * HALF + n * 16);
                        const f32x4 v = b + acc[ai][bj][m][n] * scale;
                        *(f32x4*)(xo + off + bj * HALF + n * 16) = v;
                        s += (v[0] * v[0] + v[1] * v[1]) + (v[2] * v[2] + v[3] * v[3]);
                        if (xob) { u32x2v w; w.x = cvt_pk_bf16(v[0], v[1]); w.y = cvt_pk_bf16(v[2], v[3]); *(u32x2v*)(xob + off + bj * HALF + n * 16) = w; }
                    }
                s += __shfl_xor(s, 16); s += __shfl_xor(s, 32);
                if (fq == 0) __hip_atomic_fetch_add(ssq + row, s, __ATOMIC_RELAXED, __HIP_MEMORY_SCOPE_AGENT);
            }
    }
};

struct EpiWin {
    static constexpr bool PERM = true, AFTER_DRAIN = false;
    bf16_t* P; float* GA; const float* ssq; const float* gbias;
    __device__ __forceinline__ void operator()(const f32x4 (&acc)[2][2][4][2], const Unit& u, int wr, int wc, int fr, int fq) const {
        const int row0 = u.pm * BM + wr * 64 + fr, c0 = wc * 32 + 8 * fq, pn = u.pn;
#pragma unroll
        for (int ai = 0; ai < 2; ++ai)
#pragma unroll
            for (int m = 0; m < 4; ++m) {
                const int row = row0 + ai * HALF + m * 16; const float rs = rstd_of(ssq, row);
#pragma unroll
                for (int bj = 0; bj < 2; ++bj) {
                    float v[8];
#pragma unroll
                    for (int n = 0; n < 2; ++n)
#pragma unroll
                        for (int i = 0; i < 4; ++i) v[4 * n + i] = acc[ai][bj][m][n][i] * rs;
                    const int tc = bj * HALF + c0;
                    if (pn == 14) {
                        f32x4 o0, o1;
#pragma unroll
                        for (int i = 0; i < 8; ++i) { const float x = v[i] + gbias[tc + i]; const float ls = fminf(x, 0.f) - __logf(1.0f + __expf(-fabsf(x))); if (i < 4) o0[i] = ls * 0.0625f; else o1[i - 4] = ls * 0.0625f; }
                        *(f32x4*)(GA + (size_t)row * 256 + tc) = o0; *(f32x4*)(GA + (size_t)row * 256 + tc + 4) = o1;
                    } else {
                        if (pn == 0) {
#pragma unroll
                            for (int i = 0; i < 8; ++i) v[i] *= 0.125f;
                        } else if (pn == 6 || pn == 7) {
#pragma unroll
                            for (int i = 0; i < 8; ++i) v[i] = silu_f(v[i]);
                        }
                        u32x4 w; w.x = cvt_pk_bf16(v[0], v[1]); w.y = cvt_pk_bf16(v[2], v[3]); w.z = cvt_pk_bf16(v[4], v[5]); w.w = cvt_pk_bf16(v[6], v[7]);
                        *(u32x4*)(P + (size_t)row * 3584 + pn * BM + tc) = w;
                    }
                }
            }
    }
};
template <class Epi, class Sched, bool ALIGN_EPI = false, bool SP2 = false>
__device__ __forceinline__ void gemm_phase(PG8_LAS unsigned char* lds, const Gemm g, const Sched& S, const Epi& E) {
    const int tid = threadIdx.x, wid = __builtin_amdgcn_readfirstlane(tid >> 6), lane = tid & 63, wr = wid >> 2, wc = wid & 3, fr = lane & 15, fq = lane >> 4;
    const int K = g.K, nt = K / BK;
    unsigned voffA[2], voffB[2];
#pragma unroll
    for (int i = 0; i < 2; ++i) { int R, C; stage_rc(tid * 16 + i * 8192, R, C); const int Rb = Epi::PERM ? ((R & ~31) + perm32(R & 31)) : R;
        voffA[i] = (unsigned)(R * K + C) * 2u; voffB[i] = (unsigned)(Rb * K + C) * 2u; }
    const size_t kstep = (size_t)(BK * 2);
    const size_t hstep = (size_t)HALF * K * 2;
    const size_t tstep = 2 * hstep;
    const unsigned ldsw = (unsigned)wid * 1024u;
    const int aoff = lds_byte(wr * 64 + fr, fq * 8), boff = lds_byte(wc * 32 + fr, fq * 8);
#define PG8_SA(b, h) (((b) * 2 + (h)) * HTB)
#define PG8_SB(b, h) ((4 + (b) * 2 + (h)) * HTB)
#define PG8_STAGE(bufoff, gbase, voff) do { _Pragma("unroll") for (int _i = 0; _i < 2; ++_i) \
        __builtin_amdgcn_global_load_lds((const unsigned*)((const char*)(gbase) + (voff)[_i]), (PG8_LAS unsigned*)(lds + (bufoff) + ldsw + _i * 8192), 16, 0, 0); } while (0)
#define PG8_LDA(dst, b, h) do { _Pragma("unroll") for (int m = 0; m < 4; ++m) _Pragma("unroll") for (int k = 0; k < 2; ++k) dst[m][k] = *(const PG8_LAS bf16x8*)(lds + PG8_SA(b, h) + aoff + m * 2048 + k * 1024); } while (0)
#define PG8_LDB(dst, b, h) do { _Pragma("unroll") for (int n = 0; n < 2; ++n) _Pragma("unroll") for (int k = 0; k < 2; ++k) dst[n][k] = *(const PG8_LAS bf16x8*)(lds + PG8_SB(b, h) + boff + n * 2048 + k * 1024); } while (0)
#define PG8_MMA(ai, bj, At, Bt) do { __builtin_amdgcn_s_setprio(1); _Pragma("unroll") for (int m = 0; m < 4; ++m) _Pragma("unroll") for (int n = 0; n < 2; ++n) _Pragma("unroll") for (int k = 0; k < 2; ++k) \
        acc[ai][bj][m][n] = __builtin_amdgcn_mfma_f32_16x16x32_bf16(Bt[n][k], At[m][k], acc[ai][bj][m][n], 0, 0, 0); __builtin_amdgcn_s_setprio(0); } while (0)
#define PG8_WAIT_V(n) asm volatile("s_waitcnt vmcnt(" #n ")" ::: "memory")
#define PG8_WAIT_L(n) asm volatile("s_waitcnt lgkmcnt(" #n ")" ::: "memory")
#define PG8_BAR __builtin_amdgcn_s_barrier()
#define PG8_SCHED __builtin_amdgcn_sched_barrier(0)
    Unit cur, nxt; int ui = 0;
    if (!S.next(0, cur)) return;
    f32x4 acc[2][2][4][2];
#pragma unroll
    for (int a = 0; a < 2; ++a)
#pragma unroll
        for (int b = 0; b < 2; ++b)
#pragma unroll
            for (int m = 0; m < 4; ++m)
#pragma unroll
                for (int n = 0; n < 2; ++n) acc[a][b][m][n] = (f32x4){0.f, 0.f, 0.f, 0.f};
    bf16x8 At[4][2], B0[2][2], B1[2][2];
    const char* cA = (const char*)g.A + (size_t)cur.pm * tstep; const char* cB = (const char*)g.Bt + (size_t)cur.pn * tstep;
    S.a_ready(cur);
    if constexpr (SP2) {
        PG8_STAGE(PG8_SB(0, 0), cB, voffB); PG8_STAGE(PG8_SB(0, 1), cB + hstep, voffB); PG8_STAGE(PG8_SA(0, 0), cA, voffA); PG8_STAGE(PG8_SA(0, 1), cA + hstep, voffA);
        if (wr == 1) PG8_BAR;
        PG8_WAIT_V(2); PG8_BAR;
        PG8_STAGE(PG8_SB(1, 0), cB + kstep, voffB); PG8_STAGE(PG8_SA(1, 0), cA + kstep, voffA); PG8_STAGE(PG8_SB(1, 1), cB + hstep + kstep, voffB);
        PG8_WAIT_V(6); PG8_BAR;
    } else {
        PG8_STAGE(PG8_SB(0, 0), cB, voffB); PG8_STAGE(PG8_SA(0, 0), cA, voffA); PG8_STAGE(PG8_SB(0, 1), cB + hstep, voffB); PG8_STAGE(PG8_SA(0, 1), cA + hstep, voffA);
        if (wr == 1) PG8_BAR;
        PG8_WAIT_V(4); PG8_BAR;
        PG8_STAGE(PG8_SB(1, 0), cB + kstep, voffB); PG8_STAGE(PG8_SA(1, 0), cA + kstep, voffA); PG8_STAGE(PG8_SB(1, 1), cB + hstep + kstep, voffB);
        PG8_WAIT_V(6); PG8_BAR;
    }
    for (;;) {
        const bool has_next = S.next(ui + 1, nxt);
        const char* nA = has_next ? (const char*)g.A + (size_t)nxt.pm * tstep : cA; const char* nB = has_next ? (const char*)g.Bt + (size_t)nxt.pn * tstep : cB;
        for (int t = 0; t < nt; t += 2) {
            const bool last = (t == nt - 2);
            const char* a1 = cA + (size_t)(t + 1) * kstep;
            const char* a2 = last ? nA : cA + (size_t)(t + 2) * kstep; const char* b2 = last ? nB : cB + (size_t)(t + 2) * kstep;
            const char* a3 = a2 + kstep; const char* b3 = b2 + kstep;
            if (last && has_next) S.a_ready(nxt);
            if constexpr (SP2) {
            PG8_LDB(B0, 0, 0); PG8_LDB(B1, 0, 1); PG8_SCHED; PG8_LDA(At, 0, 0); PG8_STAGE(PG8_SA(1, 1), a1 + hstep, voffA);
            PG8_WAIT_V(8); PG8_WAIT_L(0); PG8_BAR; PG8_MMA(0, 0, At, B0); PG8_MMA(0, 1, At, B1); PG8_BAR; PG8_SCHED;
            PG8_LDA(At, 0, 1); PG8_STAGE(PG8_SB(0, 0), b2, voffB); PG8_STAGE(PG8_SB(0, 1), b2 + hstep, voffB); PG8_STAGE(PG8_SA(0, 0), a2, voffA);
            PG8_WAIT_V(8); PG8_WAIT_L(0); PG8_BAR; PG8_MMA(1, 0, At, B0); PG8_MMA(1, 1, At, B1); PG8_BAR; PG8_SCHED;
            PG8_LDB(B0, 1, 0); PG8_LDB(B1, 1, 1); PG8_SCHED; PG8_LDA(At, 1, 0); PG8_STAGE(PG8_SA(0, 1), a2 + hstep, voffA);
            PG8_WAIT_V(8); PG8_WAIT_L(0); PG8_BAR; PG8_MMA(0, 0, At, B0); PG8_MMA(0, 1, At, B1); PG8_BAR; PG8_SCHED;
            PG8_LDA(At, 1, 1); PG8_STAGE(PG8_SB(1, 0), b3, voffB); PG8_STAGE(PG8_SB(1, 1), b3 + hstep, voffB); PG8_STAGE(PG8_SA(1, 0), a3, voffA);
            PG8_WAIT_V(8); PG8_WAIT_L(0); PG8_BAR; PG8_MMA(1, 0, At, B0); PG8_MMA(1, 1, At, B1); PG8_BAR; PG8_SCHED;
            } else {
            PG8_LDB(B0, 0, 0); PG8_SCHED; PG8_LDA(At, 0, 0); PG8_STAGE(PG8_SA(1, 1), a1 + hstep, voffA);
            PG8_WAIT_L(8); PG8_BAR; PG8_WAIT_L(0); PG8_MMA(0, 0, At, B0); PG8_BAR; PG8_SCHED;
            PG8_LDB(B1, 0, 1); PG8_STAGE(PG8_SB(0, 0), b2, voffB);
            PG8_BAR; PG8_WAIT_L(0); PG8_MMA(0, 1, At, B1); PG8_BAR;
            PG8_LDA(At, 0, 1); PG8_STAGE(PG8_SA(0, 0), a2, voffA);
            PG8_BAR; PG8_WAIT_L(0); PG8_MMA(1, 0, At, B0); PG8_BAR; PG8_SCHED;
            PG8_STAGE(PG8_SB(0, 1), b2 + hstep, voffB);
            PG8_WAIT_V(6); PG8_BAR; PG8_MMA(1, 1, At, B1); PG8_BAR;
            PG8_LDB(B0, 1, 0); PG8_SCHED; PG8_LDA(At, 1, 0); PG8_STAGE(PG8_SA(0, 1), a2 + hstep, voffA);
            PG8_WAIT_L(8); PG8_BAR; PG8_WAIT_L(0); PG8_MMA(0, 0, At, B0); PG8_BAR; PG8_SCHED;
            PG8_LDB(B1, 1, 1); PG8_STAGE(PG8_SB(1, 0), b3, voffB);
            PG8_BAR; PG8_WAIT_L(0); PG8_MMA(0, 1, At, B1); PG8_BAR;
            PG8_LDA(At, 1, 1); PG8_STAGE(PG8_SA(1, 0), a3, voffA);
            PG8_BAR; PG8_WAIT_L(0); PG8_MMA(1, 0, At, B0); PG8_BAR; PG8_SCHED;
            PG8_STAGE(PG8_SB(1, 1), b3 + hstep, voffB);
            PG8_WAIT_V(6); PG8_BAR; PG8_MMA(1, 1, At, B1); PG8_BAR;
            }
        }
        if constexpr (ALIGN_EPI) { if (wr == 0) PG8_BAR; }
        if constexpr (!Epi::AFTER_DRAIN) { E(acc, cur, wr, wc, fr, fq); S.done(cur); }
        if (!has_next) break;
#pragma unroll
        for (int a = 0; a < 2; ++a)
#pragma unroll
            for (int b = 0; b < 2; ++b)
#pragma unroll
                for (int m = 0; m < 4; ++m)
#pragma unroll
                    for (int n = 0; n < 2; ++n) acc[a][b][m][n] = (f32x4){0.f, 0.f, 0.f, 0.f};
        cur = nxt; cA = nA; cB = nB; ++ui;
        if constexpr (ALIGN_EPI) { if (wr == 1) PG8_BAR; }
    }
    PG8_WAIT_V(0);
    if constexpr (!ALIGN_EPI) { if (wr == 0) PG8_BAR; }
    PG8_BAR;
    if constexpr (Epi::AFTER_DRAIN) { E.fused(acc, cur, wr, wc, fr, fq, lds, wid, lane); S.done(cur); }
#undef PG8_SA
#undef PG8_SB
#undef PG8_STAGE
#undef PG8_LDA
#undef PG8_LDB
#undef PG8_MMA
#undef PG8_WAIT_V
#undef PG8_WAIT_L
#undef PG8_BAR
#undef PG8_SCHED
}
}
#define GAS __attribute__((address_space(1)))
#define LAS __attribute__((address_space(3)))
typedef unsigned short bf16;
typedef unsigned v4u __attribute__((ext_vector_type(4)));
typedef float f32x4 __attribute__((ext_vector_type(4)));
constexpr int NWAVES = 8;
constexpr int D = 1024, FF = 2816, MP = 32768, MS = 256, M = MP + MS, PW = 3584, NIN = 3840, DINSRC = 3600;
constexpr float EPS = 1e-6f;
constexpr size_t MiB = 1u << 20;
constexpr size_t WS_SSQ = 0, SSQ_STRIDE = (size_t)M * 4;
constexpr size_t WS_WGU1 = 1 * MiB, WS_WD1 = 12 * MiB, WS_WIN = 18 * MiB, WS_WO = 26 * MiB, WS_WGU2 = 28 * MiB, WS_WD2 = 39 * MiB;
constexpr size_t WS_XB = 45 * MiB, WS_MIX = 110 * MiB, WS_P = 175 * MiB, WS_HID = WS_P, WS_GA = 401 * MiB, WS_ST = 434 * MiB, WS_END = 512 * MiB;
static_assert(WS_P + (size_t)M * PW * 2 <= WS_GA && WS_GA + (size_t)M * 256 * 4 <= WS_ST && WS_XB + (size_t)M * D * 2 <= WS_MIX && WS_MIX + (size_t)M * D * 2 <= WS_P, "ws map");
constexpr size_t O_Y = 0, O_SGP = (size_t)M * D, O_SHP = O_SGP + 4 * 4 * 64 * 128, O_SGS = O_SHP + 4 * 4 * 128 * 128, O_SHS = O_SGS + 8 * 4 * 64 * 128, O_END = O_SHS + 8 * 4 * 128 * 128;
constexpr int LDS_BYTES = 147456;

__device__ __forceinline__ unsigned f2bf(float f) { unsigned u = __builtin_bit_cast(unsigned, f); return (u + 0x7fffu + ((u >> 16) & 1u)) >> 16; }
__device__ __forceinline__ unsigned pk2(float lo, float hi) { return f2bf(lo) | (f2bf(hi) << 16); }
__device__ __forceinline__ float bf2f(bf16 b) { return __builtin_bit_cast(float, (unsigned)b << 16); }
#define LDS_WAIT() asm volatile("s_waitcnt lgkmcnt(0)" ::: "memory")

struct Args { const float* in[21]; float* out; unsigned char* ws; int ph_lo, ph_hi; };

__device__ __forceinline__ float wave_sum(float v) {
#pragma unroll
    for (int o = 1; o < 64; o <<= 1) v += __shfl_xor(v, o);
    return v;
}
__device__ __forceinline__ void tr_item(const float* W, int ldw, int src_col0, int k0, const float* gain, bf16* WT, int K, int dst_row0, LAS float* scr, int lane) {
#pragma unroll 8
    for (int i = 0; i < 32; ++i) { const int kk = 2 * i + (lane >> 5); float w = W[(size_t)(k0 + kk) * ldw + src_col0 + (lane & 31)]; if (gain) w *= gain[k0 + kk]; scr[kk * 33 + (lane & 31)] = w; }
    LDS_WAIT(); asm volatile("" ::: "memory");
    const int c = lane & 7;
#pragma unroll
    for (int j = 0; j < 4; ++j) { const int n = (lane >> 3) + 8 * j; const LAS float* s = scr + (8 * c) * 33 + n;
        v4u o; o.x = pk2(s[0 * 33], s[1 * 33]); o.y = pk2(s[2 * 33], s[3 * 33]); o.z = pk2(s[4 * 33], s[5 * 33]); o.w = pk2(s[6 * 33], s[7 * 33]);
        *(v4u*)(WT + (size_t)(dst_row0 + n) * K + k0 + 8 * c) = o; }
    LDS_WAIT(); asm volatile("" ::: "memory");
}
__device__ __forceinline__ void weff_item(const float* Win, const float* up, int n0, int k0, const float* gain, bf16* WT, LAS float* scr, int lane) {
    float upr[16];
#pragma unroll
    for (int r = 0; r < 16; ++r) upr[r] = up[r * 256 + n0 + (lane & 31)];
#pragma unroll 4
    for (int i = 0; i < 32; ++i) { const int kk = 2 * i + (lane >> 5); const float* wr = Win + (size_t)(k0 + kk) * DINSRC + 1536; float s = 0.f;
#pragma unroll
        for (int r = 0; r < 16; ++r) s += wr[r] * upr[r];
        scr[kk * 33 + (lane & 31)] = s * gain[k0 + kk]; }
    LDS_WAIT(); asm volatile("" ::: "memory");
    const int c = lane & 7;
#pragma unroll
    for (int j = 0; j < 4; ++j) { const int n = (lane >> 3) + 8 * j; const LAS float* s = scr + (8 * c) * 33 + n;
        v4u o; o.x = pk2(s[0 * 33], s[1 * 33]); o.y = pk2(s[2 * 33], s[3 * 33]); o.z = pk2(s[4 * 33], s[5 * 33]); o.w = pk2(s[6 * 33], s[7 * 33]);
        *(v4u*)(WT + (size_t)(3584 + n0 + n) * 1024 + k0 + 8 * c) = o; }
    LDS_WAIT(); asm volatile("" ::: "memory");
}
__device__ __forceinline__ void gu_item(int r, const float* wg, const float* wu, const float* gain, bf16* WT, LAS float* scr, int lane) {
    const int kb = r / 176, nb = r % 176, dst = 32 * nb, tile = dst >> 8, j = dst & 255;
    const float* W = (j < 128) ? wg : wu; const int src = tile * 128 + (j & 127);
    tr_item(W, FF, src, 64 * kb, gain, WT, D, dst, scr, lane);
}

__device__ __forceinline__ void p0_prologue(const Args& a, LAS unsigned char* lds, int gw, int NGW, int lane, int wave, int gtid, int NGT) {
    LAS float* scr = (LAS float*)(lds + wave * 16384);
    unsigned char* ws = a.ws;
    constexpr int I_GU = 16 * 176, I_D = 44 * 32, I_IN = 16 * 112, I_EFF = 16 * 8, I_O = 16 * 32;
    constexpr int NITEMS = 2 * I_GU + 2 * I_D + I_IN + I_EFF + I_O;
    for (int it = gw; it < NITEMS; it += NGW) {
        int r = it;
        if (r < I_GU) { gu_item(r, a.in[5], a.in[6], a.in[4], (bf16*)(ws + WS_WGU1), scr, lane); continue; } r -= I_GU;
        if (r < I_D) { tr_item(a.in[7], D, 32 * (r % 32), 64 * (r / 32), nullptr, (bf16*)(ws + WS_WD1), FF, 32 * (r % 32), scr, lane); continue; } r -= I_D;
        if (r < I_IN) { const int kb = r / 112, nb = r % 112, dst = 32 * nb, src = dst < 1536 ? dst : dst + 16;
            tr_item(a.in[9], DINSRC, src, 64 * kb, a.in[8], (bf16*)(ws + WS_WIN), D, dst, scr, lane); continue; } r -= I_IN;
        if (r < I_EFF) { weff_item(a.in[9], a.in[10], 32 * (r % 8), 64 * (r / 8), a.in[8], (bf16*)(ws + WS_WIN), scr, lane); continue; } r -= I_EFF;
        if (r < I_O) { tr_item(a.in[15], D, 32 * (r % 32), 64 * (r / 32), nullptr, (bf16*)(ws + WS_WO), D, 32 * (r % 32), scr, lane); continue; } r -= I_O;
        if (r < I_GU) { gu_item(r, a.in[17], a.in[18], a.in[16], (bf16*)(ws + WS_WGU2), scr, lane); continue; } r -= I_GU;
        tr_item(a.in[19], D, 32 * (r % 32), 64 * (r / 32), nullptr, (bf16*)(ws + WS_WD2), FF, 32 * (r % 32), scr, lane);
    }
    float* ssq1 = (float*)(ws + WS_SSQ); bf16* XB = (bf16*)(ws + WS_XB);
    for (int m = gw; m < M; m += NGW) {
        const float* xrow = (m < MP) ? a.in[0] + (size_t)m * D : a.in[1] + (size_t)(m - MP) * D;
        const f32x4* xr = (const f32x4*)xrow + lane; f32x4 v[4]; float s = 0.f;
#pragma unroll
        for (int j = 0; j < 4; ++j) { v[j] = xr[64 * j]; s += (v[j].x * v[j].x + v[j].y * v[j].y) + (v[j].z * v[j].z + v[j].w * v[j].w); }
        s = wave_sum(s);
        unsigned long long* o8 = (unsigned long long*)(XB + (size_t)m * D) + lane;
#pragma unroll
        for (int j = 0; j < 4; ++j) o8[64 * j] = (unsigned long long)pk2(v[j].x, v[j].y) | ((unsigned long long)pk2(v[j].z, v[j].w) << 32);
        if (lane == 0) ssq1[m] = s;
    }
    for (int i = gtid; i < 3 * M; i += NGT) ssq1[M + i] = 0.f;
}

__device__ __forceinline__ void p8_final(const Args& a, int gw, int NGW, int lane) {
    const float* ssq4 = (const float*)(a.ws + WS_SSQ) + 3 * (size_t)M; const f32x4* g = (const f32x4*)a.in[20] + lane;
    f32x4 gv[4];
#pragma unroll
    for (int j = 0; j < 4; ++j) gv[j] = g[64 * j];
    for (int m = gw; m < M; m += NGW) {
        f32x4* xr = (f32x4*)(a.out + (size_t)m * D) + lane; const float rs = rsqrtf(ssq4[m] * (1.0f / 1024.0f) + EPS);
#pragma unroll
        for (int j = 0; j < 4; ++j) xr[64 * j] = xr[64 * j] * rs * gv[j];
    }
}

template <int DK, bool HG>
__global__ void __launch_bounds__(128) rec_simple(const bf16* P, const float* GA, const float* lbl, const float* onorm, const float* st_in, float* st_out_p, float* st_out_s, bf16* MIX) {
    constexpr int TB = 16;
    __shared__ float sq[TB][DK], sk[TB][DK], sa[TB][DK], so[TB][128], srs[TB];
    const int b = blockIdx.x, tid = threadIdx.x, e = tid; const bool samp = b >= 16;
    const int seq = samp ? (b - 16) / 4 : b / 4, h = b % 4;
    const int T = samp ? 32 : 8192; const size_t row0 = samp ? (size_t)MP + seq * 32 : (size_t)seq * 8192;
    float S[DK];
#pragma unroll
    for (int d = 0; d < DK; ++d) S[d] = samp ? st_in[((size_t)(seq * 4 + h) * DK + d) * 128 + e] : 0.f;
    const int qoff = HG ? 1536 + h * 128 : h * 64, koff = HG ? 2048 + h * 128 : 256 + h * 64, voff = HG ? 2560 + h * 128 : 512 + h * 128, goff = HG ? 3072 + h * 128 : 1024 + h * 128, ooff = HG ? 512 + h * 128 : h * 128;
    for (int t0 = 0; t0 < T; t0 += TB) {
        for (int i = tid; i < TB * DK; i += 128) { const int t = i / DK, d = i % DK; const size_t row = row0 + t0 + t;
            const float q = bf2f(P[row * PW + qoff + d]); float k, av;
            if (HG) { const float z = bf2f(P[row * PW + koff + d]); const float l0 = lbl[h * 128 + d], l1 = lbl[512 + h * 128 + d]; const float lb = 1.0f / (1.0f + __expf(l1 - l0));
                const float sg = 1.0f / (1.0f + __expf(-z)), sn = 1.0f / (1.0f + __expf(z)); av = lb + (1.0f - lb) * sg; k = (1.0f - lb) * sn; }
            else { k = bf2f(P[row * PW + koff + d]); av = __expf(GA[row * 256 + h * 64 + d]); }
            sq[t][d] = q; sk[t][d] = k; sa[t][d] = av; }
        __syncthreads();
        for (int t = 0; t < TB; ++t) { const float v = bf2f(P[(row0 + t0 + t) * PW + voff + e]); float o = 0.f;
#pragma unroll
            for (int d = 0; d < DK; ++d) { S[d] = sa[t][d] * S[d] + sk[t][d] * v; o += sq[t][d] * S[d]; }
            so[t][e] = o; }
        __syncthreads();
        { const int t = tid / 8, part = tid % 8; float s = 0.f;
#pragma unroll
            for (int j = 0; j < 16; ++j) { const float x = so[t][part * 16 + j]; s += x * x; }
            s += __shfl_xor(s, 1); s += __shfl_xor(s, 2); s += __shfl_xor(s, 4);
            if (part == 0) srs[t] = rsqrtf(s * (1.0f / 128.0f) + EPS); }
        __syncthreads();
        for (int t = 0; t < TB; ++t) { const size_t row = row0 + t0 + t; const float gate = bf2f(P[row * PW + goff + e]);
            const float mix = so[t][e] * srs[t] * onorm[e] * (gate / (1.0f + __expf(-gate))); MIX[row * D + ooff + e] = (bf16)f2bf(mix); }
        __syncthreads();
    }
    float* so_ = samp ? st_out_s : st_out_p;
#pragma unroll
    for (int d = 0; d < DK; ++d) so_[((size_t)(seq * 4 + h) * DK + d) * 128 + e] = S[d];
}

__global__ void __launch_bounds__(NWAVES * 64, 2) mega_fwd(Args args) {
    extern __shared__ __attribute__((aligned(16))) unsigned char lds_raw[];
    cg::grid_group grid = cg::this_grid();
    LAS unsigned char* lds = (LAS unsigned char*)lds_raw;
    const int tid = threadIdx.x, lane = tid & 63, wave = __builtin_amdgcn_readfirstlane(tid >> 6);
    const int G = gridDim.x, bx = blockIdx.x;
    const int gw = bx * NWAVES + wave, NGW = G * NWAVES, gtid = bx * (NWAVES * 64) + tid, NGT = G * NWAVES * 64;
    unsigned char* ws = args.ws;
    float* ssq = (float*)(ws + WS_SSQ);
    const int lo = args.ph_lo, hi = args.ph_hi;
#define IN(k) (lo <= (k) && (k) < hi)
#define BOTH(k) (IN(k) && IN((k) + 1))
#define GRID_BAR() grid.sync()

    if (IN(0)) { p0_prologue(args, lds, gw, NGW, lane, wave, gtid, NGT); if (BOTH(0)) GRID_BAR(); }
    if (IN(1)) {
        pg8::Gemm g{(const bf16*)(ws + WS_XB), (const bf16*)(ws + WS_WGU1), M, 2 * FF, D}; pg8::StaticOrder S; S.init(M, 2 * FF, G, bx);
        pg8::EpiUp E{(bf16*)(ws + WS_HID), FF, ssq};
        pg8::gemm_phase<pg8::EpiUp, pg8::StaticOrder, true, true>(lds, g, S, E);
        if (BOTH(1)) GRID_BAR();
    }
    if (IN(2)) {
        pg8::Gemm g{(const bf16*)(ws + WS_HID), (const bf16*)(ws + WS_WD1), M, D, FF}; pg8::StaticOrder S; S.init(M, D, G, bx);
        pg8::EpiRes E{args.in[0], args.in[1], MP / 256, args.out, (bf16*)(ws + WS_XB), ssq + M, 0.5f};
        pg8::gemm_phase<pg8::EpiRes, pg8::StaticOrder, true, true>(lds, g, S, E);
        if (BOTH(2)) GRID_BAR();
    }
    if (IN(3)) {
        pg8::Gemm g{(const bf16*)(ws + WS_XB), (const bf16*)(ws + WS_WIN), M, NIN, D}; pg8::StaticOrder S; S.init(M, NIN, G, bx);
        pg8::EpiWin E{(bf16*)(ws + WS_P), (float*)(ws + WS_GA), ssq + M, args.in[11]};
        pg8::gemm_phase<pg8::EpiWin, pg8::StaticOrder, true, true>(lds, g, S, E);
        if (BOTH(3)) GRID_BAR();
    }
    if (IN(5)) {
        pg8::Gemm g{(const bf16*)(ws + WS_MIX), (const bf16*)(ws + WS_WO), M, D, D}; pg8::StaticOrder S; S.init(M, D, G, bx);
        pg8::EpiRes E{args.out, args.out, 1 << 30, args.out, (bf16*)(ws + WS_XB), ssq + 2 * M, 1.0f};
        pg8::gemm_phase<pg8::EpiRes, pg8::StaticOrder, true, true>(lds, g, S, E);
        if (BOTH(5)) GRID_BAR();
    }
    if (IN(6)) {
        pg8::Gemm g{(const bf16*)(ws + WS_XB), (const bf16*)(ws + WS_WGU2), M, 2 * FF, D}; pg8::StaticOrder S; S.init(M, 2 * FF, G, bx);
        pg8::EpiUp E{(bf16*)(ws + WS_HID), FF, ssq + 2 * M};
        pg8::gemm_phase<pg8::EpiUp, pg8::StaticOrder, true, true>(lds, g, S, E);
        if (BOTH(6)) GRID_BAR();
    }
    if (IN(7)) {
        pg8::Gemm g{(const bf16*)(ws + WS_HID), (const bf16*)(ws + WS_WD2), M, D, FF}; pg8::StaticOrder S; S.init(M, D, G, bx);
        pg8::EpiRes E{args.out, args.out, 1 << 30, args.out, nullptr, ssq + 3 * M, 0.5f};
        pg8::gemm_phase<pg8::EpiRes, pg8::StaticOrder, true, true>(lds, g, S, E);
        if (BOTH(7)) GRID_BAR();
    }
    if (IN(8)) p8_final(args, gw, NGW, lane);
#undef IN
#undef BOTH
}

extern "C" void kernel_launch(void* const* d_in, const int* in_sizes, int n_in, void* d_out, int out_size, void* d_ws, size_t ws_size, hipStream_t stream) {
    static int grid = 0;
    if (grid == 0) {
        if (n_in != 21 || out_size != (int)O_END || ws_size < WS_END) { fprintf(stderr, "kernel_launch: unexpected sizes n_in %d out %d ws %zu\n", n_in, out_size, ws_size); grid = -1; return; }
        int dev = 0, cus = 0, per_cu = 0;
        hipGetDevice(&dev); hipDeviceGetAttribute(&cus, hipDeviceAttributeMultiprocessorCount, dev);
        if (hipFuncSetAttribute((const void*)mega_fwd, hipFuncAttributeMaxDynamicSharedMemorySize, LDS_BYTES) != hipSuccess) { fprintf(stderr, "hipFuncSetAttribute failed\n"); grid = -1; return; }
        if (hipOccupancyMaxActiveBlocksPerMultiprocessor(&per_cu, (const void*)mega_fwd, NWAVES * 64, LDS_BYTES) != hipSuccess || per_cu < 1) { fprintf(stderr, "occupancy query: %d\n", per_cu); per_cu = 1; }
        (void)hipGetLastError();
        grid = cus;
    }
    if (grid < 0) return;
    Args a{};
    for (int i = 0; i < 21; ++i) a.in[i] = (const float*)d_in[i];
    a.out = (float*)d_out; a.ws = (unsigned char*)d_ws;
    float* out = (float*)d_out; unsigned char* ws = (unsigned char*)d_ws;
    auto launch = [&](int lo, int hi) { a.ph_lo = lo; a.ph_hi = hi; hipLaunchKernelGGL(mega_fwd, dim3(grid), dim3(NWAVES * 64), LDS_BYTES, stream, a); };
    launch(0, 1); launch(1, 2); launch(2, 3); launch(3, 4);
    hipLaunchKernelGGL((rec_simple<64, false>), dim3(48), dim3(128), 0, stream, (const bf16*)(ws + WS_P), (const float*)(ws + WS_GA), (const float*)d_in[13], (const float*)d_in[12], (const float*)d_in[2], out + O_SGP, out + O_SGS, (bf16*)(ws + WS_MIX));
    hipLaunchKernelGGL((rec_simple<128, true>), dim3(48), dim3(128), 0, stream, (const bf16*)(ws + WS_P), (const float*)(ws + WS_GA), (const float*)d_in[13], (const float*)d_in[14], (const float*)d_in[3], out + O_SHP, out + O_SHS, (bf16*)(ws + WS_MIX));
    launch(5, 6); launch(6, 7); launch(7, 8); launch(8, 9);
}
```

```cpp
#include <hip/hip_runtime.h>
#include <hip/hip_cooperative_groups.h>
#include <cstdio>
#include <cstdint>
namespace cg = cooperative_groups;
namespace pg8 {
#define PG8_LAS __attribute__((address_space(3)))
typedef unsigned short bf16_t;
typedef short bf16x8 __attribute__((ext_vector_type(8)));
typedef float f32x4 __attribute__((ext_vector_type(4)));
typedef unsigned u32x4 __attribute__((ext_vector_type(4)));
constexpr int BM = 256, BK = 64, HALF = 128, HTB = HALF * BK * 2  , STAGE_BYTES = 8 * HTB, NXCD = 8, WGM = 8;

__host__ __device__ __forceinline__ int lds_byte(int r, int c) { const int st = (r >> 4) * 2 + (c >> 5), rr = r & 15, cc = c & 31, ob = rr * 64 + cc * 2; return st * 1024 + (ob ^ (((ob >> 9) & 1) << 5)); }
__host__ __device__ __forceinline__ void stage_rc(int b, int& R, int& C) { const int st = b / 1024, sb = b % 1024, swz = sb ^ (((sb >> 9) & 1) << 5); R = (st >> 1) * 16 + swz / 64; C = (st & 1) * 32 + (swz % 64) / 2; }
__host__ __device__ __forceinline__ int perm32(int rho) { const int n = rho >> 4, i = rho & 15; return 8 * (i >> 2) + 4 * n + (i & 3); }

struct Unit { int pm, pn; };
struct Gemm { const bf16_t* A; const bf16_t* Bt; int M, N, K; };

struct StaticOrder {
    int nM, nN, nwg, G, c;
    __host__ __device__ void init(int M, int N, int G_, int c_) { nM = M / BM; nN = N / BM; nwg = nM * nN; G = G_; c = c_; }
    __host__ __device__ bool next(int i, Unit& u) const {
        const long L = (long)i * G + c; if (L >= nwg) return false;
        int wgid = (int)L; { const int q = nwg / NXCD, r = nwg % NXCD, xcd = wgid % NXCD, off = wgid / NXCD; wgid = (xcd < r ? xcd * (q + 1) : r * (q + 1) + (xcd - r) * q) + off; }
        const int nig = WGM * nN, gid = wgid / nig, fm = gid * WGM, gsz = (nM - fm) < WGM ? (nM - fm) : WGM;
        u.pm = fm + ((wgid % nig) % gsz); u.pn = (wgid % nig) / gsz; return true;
    }
    __device__ __forceinline__ void a_ready(const Unit&) const {}
    __device__ __forceinline__ void done(const Unit&) const {}
};

__device__ __forceinline__ unsigned cvt_pk_bf16(float lo, float hi) { unsigned r; asm volatile("v_cvt_pk_bf16_f32 %0, %1, %2" : "=v"(r) : "v"(lo), "v"(hi)); return r; }
typedef float f32x2 __attribute__((ext_vector_type(2)));
constexpr float RMS_EPS = 1e-6f;
__device__ __forceinline__ float silu_f(float g) { return g * __builtin_amdgcn_rcpf(1.0f + __expf(-g)); }
__device__ __forceinline__ float rstd_of(const float* ssq, int row) { return rsqrtf(ssq[row] * (1.0f / 1024.0f) + RMS_EPS); }

struct EpiUp {
    static constexpr bool PERM = true, AFTER_DRAIN = false;
    bf16_t* H; int ldh; const float* ssq;
    __device__ __forceinline__ void operator()(const f32x4 (&acc)[2][2][4][2], const Unit& u, int wr, int wc, int fr, int fq) const {
        const int row0 = u.pm * BM + wr * 64 + fr, hcol0 = u.pn * HALF + wc * 32 + 8 * fq;
#pragma unroll
        for (int ai = 0; ai < 2; ++ai)
#pragma unroll
            for (int m = 0; m < 4; ++m) {
                const int row = row0 + ai * HALF + m * 16; const float rs = rstd_of(ssq, row);
                float h[8];
#pragma unroll
                for (int n = 0; n < 2; ++n)
#pragma unroll
                    for (int i = 0; i < 4; ++i) { const float g = acc[ai][0][m][n][i] * rs, uu = acc[ai][1][m][n][i] * rs; h[4 * n + i] = silu_f(g) * uu; }
                u32x4 w; w.x = cvt_pk_bf16(h[0], h[1]); w.y = cvt_pk_bf16(h[2], h[3]); w.z = cvt_pk_bf16(h[4], h[5]); w.w = cvt_pk_bf16(h[6], h[7]);
                *(u32x4*)(H + (size_t)row * ldh + hcol0) = w;
            }
    }
};

struct EpiRes {
    static constexpr bool PERM = false, AFTER_DRAIN = false;
    const float* xi0; const float* xi1; int split_pm;
    float* xo; bf16_t* xob; float* ssq; float scale;
    __device__ __forceinline__ void operator()(const f32x4 (&acc)[2][2][4][2], const Unit& u, int wr, int wc, int fr, int fq) const {
        typedef unsigned u32x2v __attribute__((ext_vector_type(2)));
        const int row0 = u.pm * BM + wr * 64 + fr, col0 = u.pn * BM + wc * 32 + 4 * fq;
        const float* xin = (u.pm < split_pm) ? xi0 : (xi1 - (size_t)split_pm * BM * 1024);
#pragma unroll
        for (int ai = 0; ai < 2; ++ai)
#pragma unroll
            for (int m = 0; m < 4; ++m) {
                const int row = row0 + ai * HALF + m * 16; const size_t off = (size_t)row * 1024 + col0; float s = 0.f;
#pragma unroll
                for (int bj = 0; bj < 2; ++bj)
#pragma unroll
                    for (int n = 0; n < 2; ++n) {
                        const f32x4 b = *(const f32x4*)(xin + off + bj * HALF + n * 16);
                        const f32x4 v = b + acc[ai][bj][m][n] * scale;
                        *(f32x4*)(xo + off + bj * HALF + n * 16) = v;
                        s += (v[0] * v[0] + v[1] * v[1]) + (v[2] * v[2] + v[3] * v[3]);
                        if (xob) { u32x2v w; w.x = cvt_pk_bf16(v[0], v[1]); w.y = cvt_pk_bf16(v[2], v[3]); *(u32x2v*)(xob + off + bj * HALF + n * 16) = w; }
                    }
                s += __shfl_xor(s, 16); s += __shfl_xor(s, 32);
                if (fq == 0) __hip_atomic_fetch_add(ssq + row, s, __ATOMIC_RELAXED, __HIP_MEMORY_SCOPE_AGENT);
            }
    }
};

struct EpiWin {
    static constexpr bool PERM = true, AFTER_DRAIN = false;
    bf16_t* P; float* GA; const float* ssq; const float* gbias;
    __device__ __forceinline__ void operator()(const f32x4 (&acc)[2][2][4][2], const Unit& u, int wr, int wc, int fr, int fq) const {
        const int row0 = u.pm * BM + wr * 64 + fr, c0 = wc * 32 + 8 * fq, pn = u.pn;
#pragma unroll
        for (int ai = 0; ai < 2; ++ai)
#pragma unroll
            for (int m = 0; m < 4; ++m) {
                const int row = row0 + ai * HALF + m * 16; const float rs = rstd_of(ssq, row);
#pragma unroll
                for (int bj = 0; bj < 2; ++bj) {
                    float v[8];
#pragma unroll
                    for (int n = 0; n < 2; ++n)
#pragma unroll
                        for (int i = 0; i < 4; ++i) v[4 * n + i] = acc[ai][bj][m][n][i] * rs;
                    const int tc = bj * HALF + c0;
                    if (pn == 14) {
                        f32x4 o0, o1;
#pragma unroll
                        for (int i = 0; i < 8; ++i) { const float x = v[i] + gbias[tc + i]; const float ls = fminf(x, 0.f) - __logf(1.0f + __expf(-fabsf(x))); if (i < 4) o0[i] = ls * 0.0625f; else o1[i - 4] = ls * 0.0625f; }
                        *(f32x4*)(GA + (size_t)row * 256 + tc) = o0; *(f32x4*)(GA + (size_t)row * 256 + tc + 4) = o1;
                    } else {
                        if (pn == 0) {
#pragma unroll
                            for (int i = 0; i < 8; ++i) v[i] *= 0.125f;
                        } else if (pn == 6 || pn == 7) {
#pragma unroll
                            for (int i = 0; i < 8; ++i) v[i] = silu_f(v[i]);
                        }
                        u32x4 w; w.x = cvt_pk_bf16(v[0], v[1]); w.y = cvt_pk_bf16(v[2], v[3]); w.z = cvt_pk_bf16(v[4], v[5]); w.w = cvt_pk_bf16(v[6], v[7]);
                        *(u32x4*)(P + (size_t)row * 3584 + pn * BM + tc) = w;
                    }
                }
            }
    }
};
template <class Epi, class Sched, bool ALIGN_EPI = false, bool SP2 = false>
__device__ __forceinline__ void gemm_phase(PG8_LAS unsigned char* lds, const Gemm g, const Sched& S, const Epi& E) {
    const int tid = threadIdx.x, wid = __builtin_amdgcn_readfirstlane(tid >> 6), lane = tid & 63, wr = wid >> 2, wc = wid & 3, fr = lane & 15, fq = lane >> 4;
    const int K = g.K, nt = K / BK;
    unsigned voffA[2], voffB[2];
#pragma unroll
    for (int i = 0; i < 2; ++i) { int R, C; stage_rc(tid * 16 + i * 8192, R, C); const int Rb = Epi::PERM ? ((R & ~31) + perm32(R & 31)) : R;
        voffA[i] = (unsigned)(R * K + C) * 2u; voffB[i] = (unsigned)(Rb * K + C) * 2u; }
    const size_t kstep = (size_t)(BK * 2);
    const size_t hstep = (size_t)HALF * K * 2;
    const size_t tstep = 2 * hstep;
    const unsigned ldsw = (unsigned)wid * 1024u;
    const int aoff = lds_byte(wr * 64 + fr, fq * 8), boff = lds_byte(wc * 32 + fr, fq * 8);
#define PG8_SA(b, h) (((b) * 2 + (h)) * HTB)
#define PG8_SB(b, h) ((4 + (b) * 2 + (h)) * HTB)
#define PG8_STAGE(bufoff, gbase, voff) do { _Pragma("unroll") for (int _i = 0; _i < 2; ++_i) \
        __builtin_amdgcn_global_load_lds((const unsigned*)((const char*)(gbase) + (voff)[_i]), (PG8_LAS unsigned*)(lds + (bufoff) + ldsw + _i * 8192), 16, 0, 0); } while (0)
#define PG8_LDA(dst, b, h) do { _Pragma("unroll") for (int m = 0; m < 4; ++m) _Pragma("unroll") for (int k = 0; k < 2; ++k) dst[m][k] = *(const PG8_LAS bf16x8*)(lds + PG8_SA(b, h) + aoff + m * 2048 + k * 1024); } while (0)
#define PG8_LDB(dst, b, h) do { _Pragma("unroll") for (int n = 0; n < 2; ++n) _Pragma("unroll") for (int k = 0; k < 2; ++k) dst[n][k] = *(const PG8_LAS bf16x8*)(lds + PG8_SB(b, h) + boff + n * 2048 + k * 1024); } while (0)
#define PG8_MMA(ai, bj, At, Bt) do { __builtin_amdgcn_s_setprio(1); _Pragma("unroll") for (int m = 0; m < 4; ++m) _Pragma("unroll") for (int n = 0; n < 2; ++n) _Pragma("unroll") for (int k = 0; k < 2; ++k) \
        acc[ai][bj][m][n] = __builtin_amdgcn_mfma_f32_16x16x32_bf16(Bt[n][k], At[m][k], acc[ai][bj][m][n], 0, 0, 0); __builtin_amdgcn_s_setprio(0); } while (0)
#define PG8_WAIT_V(n) asm volatile("s_waitcnt vmcnt(" #n ")" ::: "memory")
#define PG8_WAIT_L(n) asm volatile("s_waitcnt lgkmcnt(" #n ")" ::: "memory")
#define PG8_BAR __builtin_amdgcn_s_barrier()
#define PG8_SCHED __builtin_amdgcn_sched_barrier(0)
    Unit cur, nxt; int ui = 0;
    if (!S.next(0, cur)) return;
    f32x4 acc[2][2][4][2];
#pragma unroll
    for (int a = 0; a < 2; ++a)
#pragma unroll
        for (int b = 0; b < 2; ++b)
#pragma unroll
            for (int m = 0; m < 4; ++m)
#pragma unroll
                for (int n = 0; n < 2; ++n) acc[a][b][m][n] = (f32x4){0.f, 0.f, 0.f, 0.f};
    bf16x8 At[4][2], B0[2][2], B1[2][2];
    const char* cA = (const char*)g.A + (size_t)cur.pm * tstep; const char* cB = (const char*)g.Bt + (size_t)cur.pn * tstep;
    S.a_ready(cur);
    if constexpr (SP2) {
        PG8_STAGE(PG8_SB(0, 0), cB, voffB); PG8_STAGE(PG8_SB(0, 1), cB + hstep, voffB); PG8_STAGE(PG8_SA(0, 0), cA, voffA); PG8_STAGE(PG8_SA(0, 1), cA + hstep, voffA);
        if (wr == 1) PG8_BAR;
        PG8_WAIT_V(2); PG8_BAR;
        PG8_STAGE(PG8_SB(1, 0), cB + kstep, voffB); PG8_STAGE(PG8_SA(1, 0), cA + kstep, voffA); PG8_STAGE(PG8_SB(1, 1), cB + hstep + kstep, voffB);
        PG8_WAIT_V(6); PG8_BAR;
    } else {
        PG8_STAGE(PG8_SB(0, 0), cB, voffB); PG8_STAGE(PG8_SA(0, 0), cA, voffA); PG8_STAGE(PG8_SB(0, 1), cB + hstep, voffB); PG8_STAGE(PG8_SA(0, 1), cA + hstep, voffA);
        if (wr == 1) PG8_BAR;
        PG8_WAIT_V(4); PG8_BAR;
        PG8_STAGE(PG8_SB(1, 0), cB + kstep, voffB); PG8_STAGE(PG8_SA(1, 0), cA + kstep, voffA); PG8_STAGE(PG8_SB(1, 1), cB + hstep + kstep, voffB);
        PG8_WAIT_V(6); PG8_BAR;
    }
    for (;;) {
        const bool has_next = S.next(ui + 1, nxt);
        const char* nA = has_next ? (const char*)g.A + (size_t)nxt.pm * tstep : cA; const char* nB = has_next ? (const char*)g.Bt + (size_t)nxt.pn * tstep : cB;
        for (int t = 0; t < nt; t += 2) {
            const bool last = (t == nt - 2);
            const char* a1 = cA + (size_t)(t + 1) * kstep;
            const char* a2 = last ? nA : cA + (size_t)(t + 2) * kstep; const char* b2 = last ? nB : cB + (size_t)(t + 2) * kstep;
            const char* a3 = a2 + kstep; const char* b3 = b2 + kstep;
            if (last && has_next) S.a_ready(nxt);
            if constexpr (SP2) {
            PG8_LDB(B0, 0, 0); PG8_LDB(B1, 0, 1); PG8_SCHED; PG8_LDA(At, 0, 0); PG8_STAGE(PG8_SA(1, 1), a1 + hstep, voffA);
            PG8_WAIT_V(8); PG8_WAIT_L(0); PG8_BAR; PG8_MMA(0, 0, At, B0); PG8_MMA(0, 1, At, B1); PG8_BAR; PG8_SCHED;
            PG8_LDA(At, 0, 1); PG8_STAGE(PG8_SB(0, 0), b2, voffB); PG8_STAGE(PG8_SB(0, 1), b2 + hstep, voffB); PG8_STAGE(PG8_SA(0, 0), a2, voffA);
            PG8_WAIT_V(8); PG8_WAIT_L(0); PG8_BAR; PG8_MMA(1, 0, At, B0); PG8_MMA(1, 1, At, B1); PG8_BAR; PG8_SCHED;
            PG8_LDB(B0, 1, 0); PG8_LDB(B1, 1, 1); PG8_SCHED; PG8_LDA(At, 1, 0); PG8_STAGE(PG8_SA(0, 1), a2 + hstep, voffA);
            PG8_WAIT_V(8); PG8_WAIT_L(0); PG8_BAR; PG8_MMA(0, 0, At, B0); PG8_MMA(0, 1, At, B1); PG8_BAR; PG8_SCHED;
            PG8_LDA(At, 1, 1); PG8_STAGE(PG8_SB(1, 0), b3, voffB); PG8_STAGE(PG8_SB(1, 1), b3 + hstep, voffB); PG8_STAGE(PG8_SA(1, 0), a3, voffA);
            PG8_WAIT_V(8); PG8_WAIT_L(0); PG8_BAR; PG8_MMA(1, 0, At, B0); PG8_MMA(1, 1, At, B1); PG8_BAR; PG8_SCHED;
            } else {
            PG8_LDB(B0, 0, 0); PG8_SCHED; PG8_LDA(At, 0, 0); PG8_STAGE(PG8_SA(1, 1), a1 + hstep, voffA);
            PG8_WAIT_L(8); PG8_BAR; PG8_WAIT_L(0); PG8_MMA(0, 0, At, B0); PG8_BAR; PG8_SCHED;
            PG8_LDB(B1, 0, 1); PG8_STAGE(PG8_SB(0, 0), b2, voffB);
            PG8_BAR; PG8_WAIT_L(0); PG8_MMA(0, 1, At, B1); PG8_BAR;
            PG8_LDA(At, 0, 1); PG8_STAGE(PG8_SA(0, 0), a2, voffA);
            PG8_BAR; PG8_WAIT_L(0); PG8_MMA(1, 0, At, B0); PG8_BAR; PG8_SCHED;
            PG8_STAGE(PG8_SB(0, 1), b2 + hstep, voffB);
            PG8_WAIT_V(6); PG8_BAR; PG8_MMA(1, 1, At, B1); PG8_BAR;
            PG8_LDB(B0, 1, 0); PG8_SCHED; PG8_LDA(At, 1, 0); PG8_STAGE(PG8_SA(0, 1), a2 + hstep, voffA);
            PG8_WAIT_L(8); PG8_BAR; PG8_WAIT_L(0); PG8_MMA(0, 0, At, B0); PG8_BAR; PG8_SCHED;
            PG8_LDB(B1, 1, 1); PG8_STAGE(PG8_SB(1, 0), b3, voffB);
            PG8_BAR; PG8_WAIT_L(0); PG8_MMA(0, 1, At, B1); PG8_BAR;
            PG8_LDA(At, 1, 1); PG8_STAGE(PG8_SA(1, 0), a3, voffA);
            PG8_BAR; PG8_WAIT_L(0); PG8_MMA(1, 0, At, B0); PG8_BAR; PG8_SCHED;
            PG8_STAGE(PG8_SB(1, 1), b3 + hstep, voffB);
            PG8_WAIT_V(6); PG8_BAR; PG8_MMA(1, 1, At, B1); PG8_BAR;
            }
        }
        if constexpr (ALIGN_EPI) { if (wr == 0) PG8_BAR; }
        if constexpr (!Epi::AFTER_DRAIN) { E(acc, cur, wr, wc, fr, fq); S.done(cur); }
        if (!has_next) break;
#pragma unroll
        for (int a = 0; a < 2; ++a)
#pragma unroll
            for (int b = 0; b < 2; ++b)
#pragma unroll
                for (int m = 0; m < 4; ++m)
#pragma unroll
                    for (int n = 0; n < 2; ++n) acc[a][b][m][n] = (f32x4){0.f, 0.f, 0.f, 0.f};
        cur = nxt; cA = nA; cB = nB; ++ui;
        if constexpr (ALIGN_EPI) { if (wr == 1) PG8_BAR; }
    }
    PG8_WAIT_V(0);
    if constexpr (!ALIGN_EPI) { if (wr == 0) PG8_BAR; }
    PG8_BAR;
    if constexpr (Epi::AFTER_DRAIN) { E.fused(acc, cur, wr, wc, fr, fq, lds, wid, lane); S.done(cur); }
#undef PG8_SA
#undef PG8_SB
#undef PG8_STAGE
#undef PG8_LDA
#undef PG8_LDB
#undef PG8_MMA
#undef PG8_WAIT_V
#undef PG8_WAIT_L
#undef PG8_BAR
#undef PG8_SCHED
}
}
#define GAS __attribute__((address_space(1)))
#define LAS __attribute__((address_space(3)))
typedef unsigned short bf16;
typedef unsigned v4u __attribute__((ext_vector_type(4)));
typedef float f32x4 __attribute__((ext_vector_type(4)));
constexpr int NWAVES = 8;
constexpr int D = 1024, FF = 2816, MP = 32768, MS = 256, M = MP + MS, PW = 3584, NIN = 3840, DINSRC = 3600;
constexpr float EPS = 1e-6f;
constexpr size_t MiB = 1u << 20;
constexpr size_t WS_SSQ = 0, SSQ_STRIDE = (size_t)M * 4;
constexpr size_t WS_WGU1 = 1 * MiB, WS_WD1 = 12 * MiB, WS_WIN = 18 * MiB, WS_WO = 26 * MiB, WS_WGU2 = 28 * MiB, WS_WD2 = 39 * MiB;
constexpr size_t WS_XB = 45 * MiB, WS_MIX = 110 * MiB, WS_P = 175 * MiB, WS_HID = WS_P, WS_GA = 401 * MiB, WS_ST = 434 * MiB, WS_END = 512 * MiB;
static_assert(WS_P + (size_t)M * PW * 2 <= WS_GA && WS_GA + (size_t)M * 256 * 4 <= WS_ST && WS_XB + (size_t)M * D * 2 <= WS_MIX && WS_MIX + (size_t)M * D * 2 <= WS_P, "ws map");
constexpr size_t O_Y = 0, O_SGP = (size_t)M * D, O_SHP = O_SGP + 4 * 4 * 64 * 128, O_SGS = O_SHP + 4 * 4 * 128 * 128, O_SHS = O_SGS + 8 * 4 * 64 * 128, O_END = O_SHS + 8 * 4 * 128 * 128;
constexpr int LDS_BYTES = 147456;

__device__ __forceinline__ unsigned f2bf(float f) { unsigned u = __builtin_bit_cast(unsigned, f); return (u + 0x7fffu + ((u >> 16) & 1u)) >> 16; }
__device__ __forceinline__ unsigned pk2(float lo, float hi) { return f2bf(lo) | (f2bf(hi) << 16); }
__device__ __forceinline__ float bf2f(bf16 b) { return __builtin_bit_cast(float, (unsigned)b << 16); }
#define LDS_WAIT() asm volatile("s_waitcnt lgkmcnt(0)" ::: "memory")

struct Args { const float* in[21]; float* out; unsigned char* ws; int ph_lo, ph_hi; };

__device__ __forceinline__ float wave_sum(float v) {
#pragma unroll
    for (int o = 1; o < 64; o <<= 1) v += __shfl_xor(v, o);
    return v;
}
__device__ __forceinline__ void tr_item(const float* W, int ldw, int src_col0, int k0, const float* gain, bf16* WT, int K, int dst_row0, LAS float* scr, int lane) {
#pragma unroll 8
    for (int i = 0; i < 32; ++i) { const int kk = 2 * i + (lane >> 5); float w = W[(size_t)(k0 + kk) * ldw + src_col0 + (lane & 31)]; if (gain) w *= gain[k0 + kk]; scr[kk * 33 + (lane & 31)] = w; }
    LDS_WAIT(); asm volatile("" ::: "memory");
    const int c = lane & 7;
#pragma unroll
    for (int j = 0; j < 4; ++j) { const int n = (lane >> 3) + 8 * j; const LAS float* s = scr + (8 * c) * 33 + n;
        v4u o; o.x = pk2(s[0 * 33], s[1 * 33]); o.y = pk2(s[2 * 33], s[3 * 33]); o.z = pk2(s[4 * 33], s[5 * 33]); o.w = pk2(s[6 * 33], s[7 * 33]);
        *(v4u*)(WT + (size_t)(dst_row0 + n) * K + k0 + 8 * c) = o; }
    LDS_WAIT(); asm volatile("" ::: "memory");
}
__device__ __forceinline__ void weff_item(const float* Win, const float* up, int n0, int k0, const float* gain, bf16* WT, LAS float* scr, int lane) {
    float upr[16];
#pragma unroll
    for (int r = 0; r < 16; ++r) upr[r] = up[r * 256 + n0 + (lane & 31)];
#pragma unroll 4
    for (int i = 0; i < 32; ++i) { const int kk = 2 * i + (lane >> 5); const float* wr = Win + (size_t)(k0 + kk) * DINSRC + 1536; float s = 0.f;
#pragma unroll
        for (int r = 0; r < 16; ++r) s += wr[r] * upr[r];
        scr[kk * 33 + (lane & 31)] = s * gain[k0 + kk]; }
    LDS_WAIT(); asm volatile("" ::: "memory");
    const int c = lane & 7;
#pragma unroll
    for (int j = 0; j < 4; ++j) { const int n = (lane >> 3) + 8 * j; const LAS float* s = scr + (8 * c) * 33 + n;
        v4u o; o.x = pk2(s[0 * 33], s[1 * 33]); o.y = pk2(s[2 * 33], s[3 * 33]); o.z = pk2(s[4 * 33], s[5 * 33]); o.w = pk2(s[6 * 33], s[7 * 33]);
        *(v4u*)(WT + (size_t)(3584 + n0 + n) * 1024 + k0 + 8 * c) = o; }
    LDS_WAIT(); asm volatile("" ::: "memory");
}
__device__ __forceinline__ void gu_item(int r, const float* wg, const float* wu, const float* gain, bf16* WT, LAS float* scr, int lane) {
    const int kb = r / 176, nb = r % 176, dst = 32 * nb, tile = dst >> 8, j = dst & 255;
    const float* W = (j < 128) ? wg : wu; const int src = tile * 128 + (j & 127);
    tr_item(W, FF, src, 64 * kb, gain, WT, D, dst, scr, lane);
}

__device__ __forceinline__ void p0_prologue(const Args& a, LAS unsigned char* lds, int gw, int NGW, int lane, int wave, int gtid, int NGT) {
    LAS float* scr = (LAS float*)(lds + wave * 16384);
    unsigned char* ws = a.ws;
    constexpr int I_GU = 16 * 176, I_D = 44 * 32, I_IN = 16 * 112, I_EFF = 16 * 8, I_O = 16 * 32;
    constexpr int NITEMS = 2 * I_GU + 2 * I_D + I_IN + I_EFF + I_O;
    for (int it = gw; it < NITEMS; it += NGW) {
        int r = it;
        if (r < I_GU) { gu_item(r, a.in[5], a.in[6], a.in[4], (bf16*)(ws + WS_WGU1), scr, lane); continue; } r -= I_GU;
        if (r < I_D) { tr_item(a.in[7], D, 32 * (r % 32), 64 * (r / 32), nullptr, (bf16*)(ws + WS_WD1), FF, 32 * (r % 32), scr, lane); continue; } r -= I_D;
        if (r < I_IN) { const int kb = r / 112, nb = r % 112, dst = 32 * nb, src = dst < 1536 ? dst : dst + 16;
            tr_item(a.in[9], DINSRC, src, 64 * kb, a.in[8], (bf16*)(ws + WS_WIN), D, dst, scr, lane); continue; } r -= I_IN;
        if (r < I_EFF) { weff_item(a.in[9], a.in[10], 32 * (r % 8), 64 * (r / 8), a.in[8], (bf16*)(ws + WS_WIN), scr, lane); continue; } r -= I_EFF;
        if (r < I_O) { tr_item(a.in[15], D, 32 * (r % 32), 64 * (r / 32), nullptr, (bf16*)(ws + WS_WO), D, 32 * (r % 32), scr, lane); continue; } r -= I_O;
        if (r < I_GU) { gu_item(r, a.in[17], a.in[18], a.in[16], (bf16*)(ws + WS_WGU2), scr, lane); continue; } r -= I_GU;
        tr_item(a.in[19], D, 32 * (r % 32), 64 * (r / 32), nullptr, (bf16*)(ws + WS_WD2), FF, 32 * (r % 32), scr, lane);
    }
    float* ssq1 = (float*)(ws + WS_SSQ); bf16* XB = (bf16*)(ws + WS_XB);
    for (int m = gw; m < M; m += NGW) {
        const float* xrow = (m < MP) ? a.in[0] + (size_t)m * D : a.in[1] + (size_t)(m - MP) * D;
        const f32x4* xr = (const f32x4*)xrow + lane; f32x4 v[4]; float s = 0.f;
#pragma unroll
        for (int j = 0; j < 4; ++j) { v[j] = xr[64 * j]; s += (v[j].x * v[j].x + v[j].y * v[j].y) + (v[j].z * v[j].z + v[j].w * v[j].w); }
        s = wave_sum(s);
        unsigned long long* o8 = (unsigned long long*)(XB + (size_t)m * D) + lane;
#pragma unroll
        for (int j = 0; j < 4; ++j) o8[64 * j] = (unsigned long long)pk2(v[j].x, v[j].y) | ((unsigned long long)pk2(v[j].z, v[j].w) << 32);
        if (lane == 0) ssq1[m] = s;
    }
    for (int i = gtid; i < 3 * M; i += NGT) ssq1[M + i] = 0.f;
}

__device__ __forceinline__ void p8_final(const Args& a, int gw, int NGW, int lane) {
    const float* ssq4 = (const float*)(a.ws + WS_SSQ) + 3 * (size_t)M; const f32x4* g = (const f32x4*)a.in[20] + lane;
    f32x4 gv[4];
#pragma unroll
    for (int j = 0; j < 4; ++j) gv[j] = g[64 * j];
    for (int m = gw; m < M; m += NGW) {
        f32x4* xr = (f32x4*)(a.out + (size_t)m * D) + lane; const float rs = rsqrtf(ssq4[m] * (1.0f / 1024.0f) + EPS);
#pragma unroll
        for (int j = 0; j < 4; ++j) xr[64 * j] = xr[64 * j] * rs * gv[j];
    }
}

template <int DK, bool HG>
__device__ __forceinline__ void rec_simple(LAS unsigned char* lds, int pair, bool samp, const bf16* P, const float* GA, const float* lbl, const float* onorm, const float* st_in, float* st_out, bf16* MIX) {
    constexpr int TB = 16;
    const int tid = threadIdx.x & 127, e = tid, grp = threadIdx.x >> 7;
    LAS float* base = (LAS float*)(lds + grp * 33024);
    LAS float* sq = base; LAS float* sk = base + TB * DK; LAS float* sa = base + 2 * TB * DK; LAS float* so = base + 3 * TB * DK; LAS float* srs = so + TB * 128;
    const int seq = pair / 4, h = pair % 4;
    const int T = samp ? 32 : 8192; const size_t row0 = samp ? (size_t)MP + seq * 32 : (size_t)seq * 8192;
    float S[DK];
#pragma unroll
    for (int d = 0; d < DK; ++d) S[d] = samp ? st_in[((size_t)(seq * 4 + h) * DK + d) * 128 + e] : 0.f;
    const int qoff = HG ? 1536 + h * 128 : h * 64, koff = HG ? 2048 + h * 128 : 256 + h * 64, voff = HG ? 2560 + h * 128 : 512 + h * 128, goff = HG ? 3072 + h * 128 : 1024 + h * 128, ooff = HG ? 512 + h * 128 : h * 128;
    for (int t0 = 0; t0 < T; t0 += TB) {
        for (int i = tid; i < TB * DK; i += 128) { const int t = i / DK, d = i % DK; const size_t row = row0 + t0 + t;
            const float q = bf2f(P[row * PW + qoff + d]); float k, av;
            if (HG) { const float z = bf2f(P[row * PW + koff + d]); const float l0 = lbl[h * 128 + d], l1 = lbl[512 + h * 128 + d]; const float lb = 1.0f / (1.0f + __expf(l1 - l0));
                const float sg = 1.0f / (1.0f + __expf(-z)), sn = 1.0f / (1.0f + __expf(z)); av = lb + (1.0f - lb) * sg; k = (1.0f - lb) * sn; }
            else { k = bf2f(P[row * PW + koff + d]); av = __expf(GA[row * 256 + h * 64 + d]); }
            sq[t * DK + d] = q; sk[t * DK + d] = k; sa[t * DK + d] = av; }
        __syncthreads();
        for (int t = 0; t < TB; ++t) { const float v = bf2f(P[(row0 + t0 + t) * PW + voff + e]); float o = 0.f;
#pragma unroll
            for (int d = 0; d < DK; ++d) { S[d] = sa[t * DK + d] * S[d] + sk[t * DK + d] * v; o += sq[t * DK + d] * S[d]; }
            so[t * 128 + e] = o; }
        __syncthreads();
        { const int t = tid / 8, part = tid % 8; float s = 0.f;
#pragma unroll
            for (int j = 0; j < 16; ++j) { const float x = so[t * 128 + part * 16 + j]; s += x * x; }
            s += __shfl_xor(s, 1); s += __shfl_xor(s, 2); s += __shfl_xor(s, 4);
            if (part == 0) srs[t] = rsqrtf(s * (1.0f / 128.0f) + EPS); }
        __syncthreads();
        for (int t = 0; t < TB; ++t) { const size_t row = row0 + t0 + t; const float gate = bf2f(P[row * PW + goff + e]);
            const float mix = so[t * 128 + e] * srs[t] * onorm[e] * (gate / (1.0f + __expf(-gate))); MIX[row * D + ooff + e] = (bf16)f2bf(mix); }
        __syncthreads();
    }
#pragma unroll
    for (int d = 0; d < DK; ++d) st_out[((size_t)(seq * 4 + h) * DK + d) * 128 + e] = S[d];
}

__global__ void __launch_bounds__(NWAVES * 64, 2) mega_fwd(Args args) {
    extern __shared__ __attribute__((aligned(16))) unsigned char lds_raw[];
    cg::grid_group grid = cg::this_grid();
    LAS unsigned char* lds = (LAS unsigned char*)lds_raw;
    const int tid = threadIdx.x, lane = tid & 63, wave = __builtin_amdgcn_readfirstlane(tid >> 6);
    const int G = gridDim.x, bx = blockIdx.x;
    const int gw = bx * NWAVES + wave, NGW = G * NWAVES, gtid = bx * (NWAVES * 64) + tid, NGT = G * NWAVES * 64;
    unsigned char* ws = args.ws;
    float* ssq = (float*)(ws + WS_SSQ);
    const int lo = args.ph_lo, hi = args.ph_hi;
#define IN(k) (lo <= (k) && (k) < hi)
#define BOTH(k) (IN(k) && IN((k) + 1))
#define GRID_BAR() grid.sync()

    if (IN(0)) { p0_prologue(args, lds, gw, NGW, lane, wave, gtid, NGT); if (BOTH(0)) GRID_BAR(); }
    if (IN(1)) {
        pg8::Gemm g{(const bf16*)(ws + WS_XB), (const bf16*)(ws + WS_WGU1), M, 2 * FF, D}; pg8::StaticOrder S; S.init(M, 2 * FF, G, bx);
        pg8::EpiUp E{(bf16*)(ws + WS_HID), FF, ssq};
        pg8::gemm_phase<pg8::EpiUp, pg8::StaticOrder, true, true>(lds, g, S, E);
        if (BOTH(1)) GRID_BAR();
    }
    if (IN(2)) {
        pg8::Gemm g{(const bf16*)(ws + WS_HID), (const bf16*)(ws + WS_WD1), M, D, FF}; pg8::StaticOrder S; S.init(M, D, G, bx);
        pg8::EpiRes E{args.in[0], args.in[1], MP / 256, args.out, (bf16*)(ws + WS_XB), ssq + M, 0.5f};
        pg8::gemm_phase<pg8::EpiRes, pg8::StaticOrder, true, true>(lds, g, S, E);
        if (BOTH(2)) GRID_BAR();
    }
    if (IN(3)) {
        pg8::Gemm g{(const bf16*)(ws + WS_XB), (const bf16*)(ws + WS_WIN), M, NIN, D}; pg8::StaticOrder S; S.init(M, NIN, G, bx);
        pg8::EpiWin E{(bf16*)(ws + WS_P), (float*)(ws + WS_GA), ssq + M, args.in[11]};
        pg8::gemm_phase<pg8::EpiWin, pg8::StaticOrder, true, true>(lds, g, S, E);
        if (BOTH(3)) GRID_BAR();
    }
    if (IN(4)) {
        const bf16* P = (const bf16*)(ws + WS_P); const float* GA = (const float*)(ws + WS_GA); bf16* MIX = (bf16*)(ws + WS_MIX); const int grp = tid >> 7;
        if (bx < 4) rec_simple<64, false>(lds, bx * 4 + grp, false, P, GA, args.in[13], args.in[12], args.in[2], args.out + O_SGP, MIX);
        else if (bx < 8) rec_simple<128, true>(lds, (bx - 4) * 4 + grp, false, P, GA, args.in[13], args.in[14], args.in[3], args.out + O_SHP, MIX);
        else if (bx < 16) rec_simple<64, false>(lds, (bx - 8) * 4 + grp, true, P, GA, args.in[13], args.in[12], args.in[2], args.out + O_SGS, MIX);
        else if (bx < 24) rec_simple<128, true>(lds, (bx - 16) * 4 + grp, true, P, GA, args.in[13], args.in[14], args.in[3], args.out + O_SHS, MIX);
        if (BOTH(4)) GRID_BAR();
    }
    if (IN(5)) {
        pg8::Gemm g{(const bf16*)(ws + WS_MIX), (const bf16*)(ws + WS_WO), M, D, D}; pg8::StaticOrder S; S.init(M, D, G, bx);
        pg8::EpiRes E{args.out, args.out, 1 << 30, args.out, (bf16*)(ws + WS_XB), ssq + 2 * M, 1.0f};
        pg8::gemm_phase<pg8::EpiRes, pg8::StaticOrder, true, true>(lds, g, S, E);
        if (BOTH(5)) GRID_BAR();
    }
    if (IN(6)) {
        pg8::Gemm g{(const bf16*)(ws + WS_XB), (const bf16*)(ws + WS_WGU2), M, 2 * FF, D}; pg8::StaticOrder S; S.init(M, 2 * FF, G, bx);
        pg8::EpiUp E{(bf16*)(ws + WS_HID), FF, ssq + 2 * M};
        pg8::gemm_phase<pg8::EpiUp, pg8::StaticOrder, true, true>(lds, g, S, E);
        if (BOTH(6)) GRID_BAR();
    }
    if (IN(7)) {
        pg8::Gemm g{(const bf16*)(ws + WS_HID), (const bf16*)(ws + WS_WD2), M, D, FF}; pg8::StaticOrder S; S.init(M, D, G, bx);
        pg8::EpiRes E{args.out, args.out, 1 << 30, args.out, nullptr, ssq + 3 * M, 0.5f};
        pg8::gemm_phase<pg8::EpiRes, pg8::StaticOrder, true, true>(lds, g, S, E);
        if (BOTH(7)) GRID_BAR();
    }
    if (IN(8)) p8_final(args, gw, NGW, lane);
#undef IN
#undef BOTH
}

extern "C" void kernel_launch(void* const* d_in, const int* in_sizes, int n_in, void* d_out, int out_size, void* d_ws, size_t ws_size, hipStream_t stream) {
    static int grid = 0;
    if (grid == 0) {
        if (n_in != 21 || out_size != (int)O_END || ws_size < WS_END) { fprintf(stderr, "kernel_launch: unexpected sizes n_in %d out %d ws %zu\n", n_in, out_size, ws_size); grid = -1; return; }
        int dev = 0, cus = 0, per_cu = 0;
        (void)hipGetDevice(&dev); (void)hipDeviceGetAttribute(&cus, hipDeviceAttributeMultiprocessorCount, dev);
        if (hipFuncSetAttribute((const void*)mega_fwd, hipFuncAttributeMaxDynamicSharedMemorySize, LDS_BYTES) != hipSuccess) { fprintf(stderr, "hipFuncSetAttribute failed\n"); grid = -1; return; }
        if (hipOccupancyMaxActiveBlocksPerMultiprocessor(&per_cu, (const void*)mega_fwd, NWAVES * 64, LDS_BYTES) != hipSuccess || per_cu < 1) { fprintf(stderr, "occupancy query: %d\n", per_cu); per_cu = 1; }
        (void)hipGetLastError();
        grid = cus * per_cu;
    }
    if (grid < 0) return;
    Args a{};
    for (int i = 0; i < 21; ++i) a.in[i] = (const float*)d_in[i];
    a.out = (float*)d_out; a.ws = (unsigned char*)d_ws;
    a.ph_lo = 0; a.ph_hi = 9;
    void* kargs[] = {&a};
    hipError_t e = hipLaunchCooperativeKernel((const void*)mega_fwd, dim3(grid), dim3(NWAVES * 64), kargs, LDS_BYTES, stream);
    if (e != hipSuccess) fprintf(stderr, "cooperative launch failed: %s (grid %d)\n", hipGetErrorString(e), grid);
}
```

```cpp
#include <hip/hip_runtime.h>
#include <hip/hip_cooperative_groups.h>
#include <cstdio>
#include <cstdint>
namespace cg = cooperative_groups;
namespace pg8 {
#define PG8_LAS __attribute__((address_space(3)))
typedef unsigned short bf16_t;
typedef short bf16x8 __attribute__((ext_vector_type(8)));
typedef float f32x4 __attribute__((ext_vector_type(4)));
typedef unsigned u32x4 __attribute__((ext_vector_type(4)));
constexpr int BM = 256, BK = 64, HALF = 128, HTB = HALF * BK * 2  , STAGE_BYTES = 8 * HTB, NXCD = 8, WGM = 8;

__host__ __device__ __forceinline__ int lds_byte(int r, int c) { const int st = (r >> 4) * 2 + (c >> 5), rr = r & 15, cc = c & 31, ob = rr * 64 + cc * 2; return st * 1024 + (ob ^ (((ob >> 9) & 1) << 5)); }
__host__ __device__ __forceinline__ void stage_rc(int b, int& R, int& C) { const int st = b / 1024, sb = b % 1024, swz = sb ^ (((sb >> 9) & 1) << 5); R = (st >> 1) * 16 + swz / 64; C = (st & 1) * 32 + (swz % 64) / 2; }
__host__ __device__ __forceinline__ int perm32(int rho) { const int n = rho >> 4, i = rho & 15; return 8 * (i >> 2) + 4 * n + (i & 3); }

struct Unit { int pm, pn; };
struct Gemm { const bf16_t* A; const bf16_t* Bt; int M, N, K; };

struct StaticOrder {
    int nM, nN, nwg, G, c;
    __host__ __device__ void init(int M, int N, int G_, int c_) { nM = M / BM; nN = N / BM; nwg = nM * nN; G = G_; c = c_; }
    __host__ __device__ bool next(int i, Unit& u) const {
        const long L = (long)i * G + c; if (L >= nwg) return false;
        int wgid = (int)L; { const int q = nwg / NXCD, r = nwg % NXCD, xcd = wgid % NXCD, off = wgid / NXCD; wgid = (xcd < r ? xcd * (q + 1) : r * (q + 1) + (xcd - r) * q) + off; }
        const int nig = WGM * nN, gid = wgid / nig, fm = gid * WGM, gsz = (nM - fm) < WGM ? (nM - fm) : WGM;
        u.pm = fm + ((wgid % nig) % gsz); u.pn = (wgid % nig) / gsz; return true;
    }
    __device__ __forceinline__ void a_ready(const Unit&) const {}
    __device__ __forceinline__ void done(const Unit&) const {}
};

__device__ __forceinline__ unsigned cvt_pk_bf16(float lo, float hi) { unsigned r; asm volatile("v_cvt_pk_bf16_f32 %0, %1, %2" : "=v"(r) : "v"(lo), "v"(hi)); return r; }
typedef float f32x2 __attribute__((ext_vector_type(2)));
constexpr float RMS_EPS = 1e-6f;
__device__ __forceinline__ float silu_f(float g) { return g * __builtin_amdgcn_rcpf(1.0f + __expf(-g)); }
__device__ __forceinline__ float rstd_of(const float* ssq, int row) { return rsqrtf(ssq[row] * (1.0f / 1024.0f) + RMS_EPS); }

struct EpiUp {
    static constexpr bool PERM = true, AFTER_DRAIN = false;
    bf16_t* H; int ldh; const float* ssq;
    __device__ __forceinline__ void operator()(const f32x4 (&acc)[2][2][4][2], const Unit& u, int wr, int wc, int fr, int fq) const {
        const int row0 = u.pm * BM + wr * 64 + fr, hcol0 = u.pn * HALF + wc * 32 + 8 * fq;
#pragma unroll
        for (int ai = 0; ai < 2; ++ai)
#pragma unroll
            for (int m = 0; m < 4; ++m) {
                const int row = row0 + ai * HALF + m * 16; const float rs = rstd_of(ssq, row);
                float h[8];
#pragma unroll
                for (int n = 0; n < 2; ++n)
#pragma unroll
                    for (int i = 0; i < 4; ++i) { const float g = acc[ai][0][m][n][i] * rs, uu = acc[ai][1][m][n][i] * rs; h[4 * n + i] = silu_f(g) * uu; }
                u32x4 w; w.x = cvt_pk_bf16(h[0], h[1]); w.y = cvt_pk_bf16(h[2], h[3]); w.z = cvt_pk_bf16(h[4], h[5]); w.w = cvt_pk_bf16(h[6], h[7]);
                *(u32x4*)(H + (size_t)row * ldh + hcol0) = w;
            }
    }
};

struct EpiRes {
    static constexpr bool PERM = false, AFTER_DRAIN = false;
    const float* xi0; const float* xi1; int split_pm;
    float* xo; bf16_t* xob; float* ssq; float scale;
    __device__ __forceinline__ void operator()(const f32x4 (&acc)[2][2][4][2], const Unit& u, int wr, int wc, int fr, int fq) const {
        typedef unsigned u32x2v __attribute__((ext_vector_type(2)));
        const int row0 = u.pm * BM + wr * 64 + fr, col0 = u.pn * BM + wc * 32 + 4 * fq;
        const float* xin = (u.pm < split_pm) ? xi0 : (xi1 - (size_t)split_pm * BM * 1024);
#pragma unroll
        for (int ai = 0; ai < 2; ++ai)
#pragma unroll
            for (int m = 0; m < 4; ++m) {
                const int row = row0 + ai * HALF + m * 16; const size_t off = (size_t)row * 1024 + col0; float s = 0.f;
#pragma unroll
                for (int bj = 0; bj < 2; ++bj)
#pragma unroll
                    for (int n = 0; n < 2; ++n) {
                        const f32x4 b = *(const f32x4*)(xin + off + bj * HALF + n * 16);
                        const f32x4 v = b + acc[ai][bj][m][n] * scale;
                        *(f32x4*)(xo + off + bj * HALF + n * 16) = v;
                        s += (v[0] * v[0] + v[1] * v[1]) + (v[2] * v[2] + v[3] * v[3]);
                        if (xob) { u32x2v w; w.x = cvt_pk_bf16(v[0], v[1]); w.y = cvt_pk_bf16(v[2], v[3]); *(u32x2v*)(xob + off + bj * HALF + n * 16) = w; }
                    }
                s += __shfl_xor(s, 16); s += __shfl_xor(s, 32);
                if (fq == 0) __hip_atomic_fetch_add(ssq + row, s, __ATOMIC_RELAXED, __HIP_MEMORY_SCOPE_AGENT);
            }
    }
};

struct EpiWin {
    static constexpr bool PERM = true, AFTER_DRAIN = false;
    bf16_t* P; float* GA; const float* ssq; const float* gbias;
    __device__ __forceinline__ void operator()(const f32x4 (&acc)[2][2][4][2], const Unit& u, int wr, int wc, int fr, int fq) const {
        const int row0 = u.pm * BM + wr * 64 + fr, c0 = wc * 32 + 8 * fq, pn = u.pn;
#pragma unroll
        for (int ai = 0; ai < 2; ++ai)
#pragma unroll
            for (int m = 0; m < 4; ++m) {
                const int row = row0 + ai * HALF + m * 16; const float rs = rstd_of(ssq, row);
#pragma unroll
                for (int bj = 0; bj < 2; ++bj) {
                    float v[8];
#pragma unroll
                    for (int n = 0; n < 2; ++n)
#pragma unroll
                        for (int i = 0; i < 4; ++i) v[4 * n + i] = acc[ai][bj][m][n][i] * rs;
                    const int tc = bj * HALF + c0;
                    if (pn == 14) {
                        f32x4 o0, o1;
#pragma unroll
                        for (int i = 0; i < 8; ++i) { const float x = v[i] + gbias[tc + i]; const float ls = fminf(x, 0.f) - __logf(1.0f + __expf(-fabsf(x))); if (i < 4) o0[i] = ls * 0.0625f; else o1[i - 4] = ls * 0.0625f; }
                        *(f32x4*)(GA + (size_t)row * 256 + tc) = o0; *(f32x4*)(GA + (size_t)row * 256 + tc + 4) = o1;
                    } else {
                        if (pn == 0) {
#pragma unroll
                            for (int i = 0; i < 8; ++i) v[i] *= 0.125f;
                        } else if (pn == 6 || pn == 7) {
#pragma unroll
                            for (int i = 0; i < 8; ++i) v[i] = silu_f(v[i]);
                        }
                        u32x4 w; w.x = cvt_pk_bf16(v[0], v[1]); w.y = cvt_pk_bf16(v[2], v[3]); w.z = cvt_pk_bf16(v[4], v[5]); w.w = cvt_pk_bf16(v[6], v[7]);
                        *(u32x4*)(P + (size_t)row * 3584 + pn * BM + tc) = w;
                    }
                }
            }
    }
};
template <class Epi, class Sched, bool ALIGN_EPI = false, bool SP2 = false>
__device__ __forceinline__ void gemm_phase(PG8_LAS unsigned char* lds, const Gemm g, const Sched& S, const Epi& E) {
    const int tid = threadIdx.x, wid = __builtin_amdgcn_readfirstlane(tid >> 6), lane = tid & 63, wr = wid >> 2, wc = wid & 3, fr = lane & 15, fq = lane >> 4;
    const int K = g.K, nt = K / BK;
    unsigned voffA[2], voffB[2];
#pragma unroll
    for (int i = 0; i < 2; ++i) { int R, C; stage_rc(tid * 16 + i * 8192, R, C); const int Rb = Epi::PERM ? ((R & ~31) + perm32(R & 31)) : R;
        voffA[i] = (unsigned)(R * K + C) * 2u; voffB[i] = (unsigned)(Rb * K + C) * 2u; }
    const size_t kstep = (size_t)(BK * 2);
    const size_t hstep = (size_t)HALF * K * 2;
    const size_t tstep = 2 * hstep;
    const unsigned ldsw = (unsigned)wid * 1024u;
    const int aoff = lds_byte(wr * 64 + fr, fq * 8), boff = lds_byte(wc * 32 + fr, fq * 8);
#define PG8_SA(b, h) (((b) * 2 + (h)) * HTB)
#define PG8_SB(b, h) ((4 + (b) * 2 + (h)) * HTB)
#define PG8_STAGE(bufoff, gbase, voff) do { _Pragma("unroll") for (int _i = 0; _i < 2; ++_i) \
        __builtin_amdgcn_global_load_lds((const unsigned*)((const char*)(gbase) + (voff)[_i]), (PG8_LAS unsigned*)(lds + (bufoff) + ldsw + _i * 8192), 16, 0, 0); } while (0)
#define PG8_LDA(dst, b, h) do { _Pragma("unroll") for (int m = 0; m < 4; ++m) _Pragma("unroll") for (int k = 0; k < 2; ++k) dst[m][k] = *(const PG8_LAS bf16x8*)(lds + PG8_SA(b, h) + aoff + m * 2048 + k * 1024); } while (0)
#define PG8_LDB(dst, b, h) do { _Pragma("unroll") for (int n = 0; n < 2; ++n) _Pragma("unroll") for (int k = 0; k < 2; ++k) dst[n][k] = *(const PG8_LAS bf16x8*)(lds + PG8_SB(b, h) + boff + n * 2048 + k * 1024); } while (0)
#define PG8_MMA(ai, bj, At, Bt) do { __builtin_amdgcn_s_setprio(1); _Pragma("unroll") for (int m = 0; m < 4; ++m) _Pragma("unroll") for (int n = 0; n < 2; ++n) _Pragma("unroll") for (int k = 0; k < 2; ++k) \
        acc[ai][bj][m][n] = __builtin_amdgcn_mfma_f32_16x16x32_bf16(Bt[n][k], At[m][k], acc[ai][bj][m][n], 0, 0, 0); __builtin_amdgcn_s_setprio(0); } while (0)
#define PG8_WAIT_V(n) asm volatile("s_waitcnt vmcnt(" #n ")" ::: "memory")
#define PG8_WAIT_L(n) asm volatile("s_waitcnt lgkmcnt(" #n ")" ::: "memory")
#define PG8_BAR __builtin_amdgcn_s_barrier()
#define PG8_SCHED __builtin_amdgcn_sched_barrier(0)
    Unit cur, nxt; int ui = 0;
    if (!S.next(0, cur)) return;
    f32x4 acc[2][2][4][2];
#pragma unroll
    for (int a = 0; a < 2; ++a)
#pragma unroll
        for (int b = 0; b < 2; ++b)
#pragma unroll
            for (int m = 0; m < 4; ++m)
#pragma unroll
                for (int n = 0; n < 2; ++n) acc[a][b][m][n] = (f32x4){0.f, 0.f, 0.f, 0.f};
    bf16x8 At[4][2], B0[2][2], B1[2][2];
    const char* cA = (const char*)g.A + (size_t)cur.pm * tstep; const char* cB = (const char*)g.Bt + (size_t)cur.pn * tstep;
    S.a_ready(cur);
    if constexpr (SP2) {
        PG8_STAGE(PG8_SB(0, 0), cB, voffB); PG8_STAGE(PG8_SB(0, 1), cB + hstep, voffB); PG8_STAGE(PG8_SA(0, 0), cA, voffA); PG8_STAGE(PG8_SA(0, 1), cA + hstep, voffA);
        if (wr == 1) PG8_BAR;
        PG8_WAIT_V(2); PG8_BAR;
        PG8_STAGE(PG8_SB(1, 0), cB + kstep, voffB); PG8_STAGE(PG8_SA(1, 0), cA + kstep, voffA); PG8_STAGE(PG8_SB(1, 1), cB + hstep + kstep, voffB);
        PG8_WAIT_V(6); PG8_BAR;
    } else {
        PG8_STAGE(PG8_SB(0, 0), cB, voffB); PG8_STAGE(PG8_SA(0, 0), cA, voffA); PG8_STAGE(PG8_SB(0, 1), cB + hstep, voffB); PG8_STAGE(PG8_SA(0, 1), cA + hstep, voffA);
        if (wr == 1) PG8_BAR;
        PG8_WAIT_V(4); PG8_BAR;
        PG8_STAGE(PG8_SB(1, 0), cB + kstep, voffB); PG8_STAGE(PG8_SA(1, 0), cA + kstep, voffA); PG8_STAGE(PG8_SB(1, 1), cB + hstep + kstep, voffB);
        PG8_WAIT_V(6); PG8_BAR;
    }
    for (;;) {
        const bool has_next = S.next(ui + 1, nxt);
        const char* nA = has_next ? (const char*)g.A + (size_t)nxt.pm * tstep : cA; const char* nB = has_next ? (const char*)g.Bt + (size_t)nxt.pn * tstep : cB;
        for (int t = 0; t < nt; t += 2) {
            const bool last = (t == nt - 2);
            const char* a1 = cA + (size_t)(t + 1) * kstep;
            const char* a2 = last ? nA : cA + (size_t)(t + 2) * kstep; const char* b2 = last ? nB : cB + (size_t)(t + 2) * kstep;
            const char* a3 = a2 + kstep; const char* b3 = b2 + kstep;
            if (last && has_next) S.a_ready(nxt);
            if constexpr (SP2) {
            PG8_LDB(B0, 0, 0); PG8_LDB(B1, 0, 1); PG8_SCHED; PG8_LDA(At, 0, 0); PG8_STAGE(PG8_SA(1, 1), a1 + hstep, voffA);
            PG8_WAIT_V(8); PG8_WAIT_L(0); PG8_BAR; PG8_MMA(0, 0, At, B0); PG8_MMA(0, 1, At, B1); PG8_BAR; PG8_SCHED;
            PG8_LDA(At, 0, 1); PG8_STAGE(PG8_SB(0, 0), b2, voffB); PG8_STAGE(PG8_SB(0, 1), b2 + hstep, voffB); PG8_STAGE(PG8_SA(0, 0), a2, voffA);
            PG8_WAIT_V(8); PG8_WAIT_L(0); PG8_BAR; PG8_MMA(1, 0, At, B0); PG8_MMA(1, 1, At, B1); PG8_BAR; PG8_SCHED;
            PG8_LDB(B0, 1, 0); PG8_LDB(B1, 1, 1); PG8_SCHED; PG8_LDA(At, 1, 0); PG8_STAGE(PG8_SA(0, 1), a2 + hstep, voffA);
            PG8_WAIT_V(8); PG8_WAIT_L(0); PG8_BAR; PG8_MMA(0, 0, At, B0); PG8_MMA(0, 1, At, B1); PG8_BAR; PG8_SCHED;
            PG8_LDA(At, 1, 1); PG8_STAGE(PG8_SB(1, 0), b3, voffB); PG8_STAGE(PG8_SB(1, 1), b3 + hstep, voffB); PG8_STAGE(PG8_SA(1, 0), a3, voffA);
            PG8_WAIT_V(8); PG8_WAIT_L(0); PG8_BAR; PG8_MMA(1, 0, At, B0); PG8_MMA(1, 1, At, B1); PG8_BAR; PG8_SCHED;
            } else {
            PG8_LDB(B0, 0, 0); PG8_SCHED; PG8_LDA(At, 0, 0); PG8_STAGE(PG8_SA(1, 1), a1 + hstep, voffA);
            PG8_WAIT_L(8); PG8_BAR; PG8_WAIT_L(0); PG8_MMA(0, 0, At, B0); PG8_BAR; PG8_SCHED;
            PG8_LDB(B1, 0, 1); PG8_STAGE(PG8_SB(0, 0), b2, voffB);
            PG8_BAR; PG8_WAIT_L(0); PG8_MMA(0, 1, At, B1); PG8_BAR;
            PG8_LDA(At, 0, 1); PG8_STAGE(PG8_SA(0, 0), a2, voffA);
            PG8_BAR; PG8_WAIT_L(0); PG8_MMA(1, 0, At, B0); PG8_BAR; PG8_SCHED;
            PG8_STAGE(PG8_SB(0, 1), b2 + hstep, voffB);
            PG8_WAIT_V(6); PG8_BAR; PG8_MMA(1, 1, At, B1); PG8_BAR;
            PG8_LDB(B0, 1, 0); PG8_SCHED; PG8_LDA(At, 1, 0); PG8_STAGE(PG8_SA(0, 1), a2 + hstep, voffA);
            PG8_WAIT_L(8); PG8_BAR; PG8_WAIT_L(0); PG8_MMA(0, 0, At, B0); PG8_BAR; PG8_SCHED;
            PG8_LDB(B1, 1, 1); PG8_STAGE(PG8_SB(1, 0), b3, voffB);
            PG8_BAR; PG8_WAIT_L(0); PG8_MMA(0, 1, At, B1); PG8_BAR;
            PG8_LDA(At, 1, 1); PG8_STAGE(PG8_SA(1, 0), a3, voffA);
            PG8_BAR; PG8_WAIT_L(0); PG8_MMA(1, 0, At, B0); PG8_BAR; PG8_SCHED;
            PG8_STAGE(PG8_SB(1, 1), b3 + hstep, voffB);
            PG8_WAIT_V(6); PG8_BAR; PG8_MMA(1, 1, At, B1); PG8_BAR;
            }
        }
        if constexpr (ALIGN_EPI) { if (wr == 0) PG8_BAR; }
        if constexpr (!Epi::AFTER_DRAIN) { E(acc, cur, wr, wc, fr, fq); S.done(cur); }
        if (!has_next) break;
#pragma unroll
        for (int a = 0; a < 2; ++a)
#pragma unroll
            for (int b = 0; b < 2; ++b)
#pragma unroll
                for (int m = 0; m < 4; ++m)
#pragma unroll
                    for (int n = 0; n < 2; ++n) acc[a][b][m][n] = (f32x4){0.f, 0.f, 0.f, 0.f};
        cur = nxt; cA = nA; cB = nB; ++ui;
        if constexpr (ALIGN_EPI) { if (wr == 1) PG8_BAR; }
    }
    PG8_WAIT_V(0);
    if constexpr (!ALIGN_EPI) { if (wr == 0) PG8_BAR; }
    PG8_BAR;
    if constexpr (Epi::AFTER_DRAIN) { E.fused(acc, cur, wr, wc, fr, fq, lds, wid, lane); S.done(cur); }
#undef PG8_SA
#undef PG8_SB
#undef PG8_STAGE
#undef PG8_LDA
#undef PG8_LDB
#undef PG8_MMA
#undef PG8_WAIT_V
#undef PG8_WAIT_L
#undef PG8_BAR
#undef PG8_SCHED
}
}
namespace rec {
#define RLAS __attribute__((address_space(3)))
typedef unsigned short bf16;
typedef short bf16x8 __attribute__((ext_vector_type(8)));
typedef short s16x4 __attribute__((ext_vector_type(4)));
typedef float f32x4 __attribute__((ext_vector_type(4)));
typedef float f32x2 __attribute__((ext_vector_type(2)));
typedef unsigned u32x2 __attribute__((ext_vector_type(2)));
typedef unsigned u32x4 __attribute__((ext_vector_type(4)));
constexpr int PWID = 3584, DM = 1024;
constexpr float R_EPS = 1e-6f;

typedef __bf16 bf16x2_t __attribute__((ext_vector_type(2)));
__device__ __forceinline__ unsigned pkbf(float lo, float hi) { const f32x2 v = {lo, hi}; const bf16x2_t b = __builtin_convertvector(v, bf16x2_t); return __builtin_bit_cast(unsigned, b); }
__device__ __forceinline__ float bflo(unsigned u) { return __builtin_bit_cast(float, u << 16); }
__device__ __forceinline__ float bfhi(unsigned u) { return __builtin_bit_cast(float, u & 0xffff0000u); }

template <int DK> struct Lay {
    static constexpr int NP = DK / 2, NSEG = 512 / NP, TL = 64 / NSEG, SEGREF = 32 / TL - 1, NDT = DK / 16, NKS = DK / 32;
    static constexpr int PK = DK * 2 + 32, PV = 288, PP = 160, PO = 528;
    static constexpr int OFF_Q = 0, OFF_K = OFF_Q + 64 * PK, OFF_KH = OFF_K + 64 * PK, OFF_V = OFF_KH + 64 * PK, OFF_P = OFF_V + 64 * PV, OFF_O = OFF_P + 64 * PP,
                         OFF_SEG = OFF_O + 64 * PO, OFF_D = OFF_SEG + NSEG * DK * 4, OFF_E = OFF_D + DK * 4, OFF_END = OFF_E + DK * 4;
    static_assert(OFF_END <= 131072, "recurrence LDS map");
};

__device__ __forceinline__ bf16x8 tr_frag(RLAS unsigned char* img, int pitch, int k0, int n0, int lane) {
    const int g = lane >> 4, q = (lane & 15) >> 2, p = lane & 3;
    RLAS unsigned char* a = img + (k0 + 8 * g + q) * pitch + n0 * 2 + 8 * p;
    const s16x4 lo = __builtin_amdgcn_ds_read_tr16_b64_v4i16((RLAS s16x4*)a);
    const s16x4 hi = __builtin_amdgcn_ds_read_tr16_b64_v4i16((RLAS s16x4*)(a + 4 * pitch));
    return __builtin_shufflevector(lo, hi, 0, 1, 2, 3, 4, 5, 6, 7);
}

struct HeadIo {
    const bf16* P; const float* GA; bf16* MIX;
    int qoff, koff, voff, goff, ooff, gaoff;
    const float* onorm; float lb0, lb1;
};

template <int DK, bool HG, bool DO_OUT>
__device__ __forceinline__ void chunk(RLAS unsigned char* lds, const HeadIo& io, size_t row0, int tvalid, f32x4 (&S)[DK / 16], float& dtot) {
    typedef Lay<DK> L;
    int tid = threadIdx.x; asm volatile("" : "+v"(tid));
    const int lane = tid & 63, wave = tid >> 6, r = lane & 15, g = lane >> 4, e0 = 16 * wave;
    const int dp = tid % L::NP, seg = tid / L::NP;
    unsigned q2[L::TL], k2[L::TL]; f32x2 lg[L::TL];
#pragma unroll
    for (int tt = 0; tt < L::TL; ++tt) {
        const int t = seg * L::TL + tt; const size_t row = row0 + t; const bool ok = t < tvalid;
        q2[tt] = ok ? *(const unsigned*)(io.P + row * PWID + io.qoff + 2 * dp) : 0u;
        k2[tt] = ok ? *(const unsigned*)(io.P + row * PWID + io.koff + 2 * dp) : 0u;
        if (!HG) lg[tt] = ok ? *(const f32x2*)(io.GA + row * 256 + io.gaoff + 2 * dp) : (f32x2){0.f, 0.f};
    }
    {
        const int vr = tid >> 3, vc = (tid & 7) * 16; u32x4 v0 = {0u, 0u, 0u, 0u}, v1 = {0u, 0u, 0u, 0u};
        if (vr < tvalid) { const u32x4* src = (const u32x4*)(io.P + (row0 + vr) * PWID + io.voff + vc); v0 = src[0]; v1 = src[1]; }
        RLAS u32x4* dst = (RLAS u32x4*)(lds + L::OFF_V + vr * L::PV + vc * 2); dst[0] = v0; dst[1] = v1;
    }
    float kx[L::TL], ky[L::TL];
#pragma unroll
    for (int tt = 0; tt < L::TL; ++tt) {
        if (HG) {
            const bool ok = seg * L::TL + tt < tvalid;
            const float zx = fminf(fmaxf(bflo(k2[tt]), -30.f), 30.f), zy = fminf(fmaxf(bfhi(k2[tt]), -30.f), 30.f);
            const float ex = __expf(-zx), ey = __expf(-zy), sx = __builtin_amdgcn_rcpf(1.f + ex), sy = __builtin_amdgcn_rcpf(1.f + ey);
            const float fx = io.lb0 + (1.f - io.lb0) * sx, fy = io.lb1 + (1.f - io.lb1) * sy;
            kx[tt] = ok ? (1.f - io.lb0) * ex * sx : 0.f; ky[tt] = ok ? (1.f - io.lb1) * ey * sy : 0.f;
            lg[tt] = ok ? (f32x2){__logf(fx), __logf(fy)} : (f32x2){0.f, 0.f};
        } else { kx[tt] = bflo(k2[tt]); ky[tt] = bfhi(k2[tt]); }
    }
#pragma unroll
    for (int tt = 1; tt < L::TL; ++tt) lg[tt] += lg[tt - 1];
    *(RLAS f32x2*)(lds + L::OFF_SEG + (seg * DK + 2 * dp) * 4) = lg[L::TL - 1];
    __syncthreads();
    f32x2 off = {0.f, 0.f}, bref = {0.f, 0.f}, blast = {0.f, 0.f};
#pragma unroll
    for (int s = 0; s < L::NSEG; ++s) { const f32x2 v = *(RLAS f32x2*)(lds + L::OFF_SEG + (s * DK + 2 * dp) * 4); if (s < seg) off += v; if (s <= L::SEGREF) bref += v; blast += v; }
#pragma unroll
    for (int tt = 0; tt < L::TL; ++tt) {
        const int t = seg * L::TL + tt; const f32x2 b = off + lg[tt];
        const float qx = bflo(q2[tt]), qy = bfhi(q2[tt]);
        const float eqx = __expf(b.x - bref.x), eqy = __expf(b.y - bref.y), ekx = __expf(bref.x - b.x), eky = __expf(bref.y - b.y), ehx = __expf(blast.x - b.x), ehy = __expf(blast.y - b.y);
        *(RLAS unsigned*)(lds + L::OFF_Q + t * L::PK + 4 * dp) = pkbf(qx * eqx, qy * eqy);
        *(RLAS unsigned*)(lds + L::OFF_K + t * L::PK + 4 * dp) = pkbf(kx[tt] * ekx, ky[tt] * eky);
        *(RLAS unsigned*)(lds + L::OFF_KH + t * L::PK + 4 * dp) = pkbf(kx[tt] * ehx, ky[tt] * ehy);
    }
    if (seg == 0) { *(RLAS f32x2*)(lds + L::OFF_D + 8 * dp) = (f32x2){__expf(blast.x), __expf(blast.y)}; *(RLAS f32x2*)(lds + L::OFF_E + 8 * dp) = (f32x2){__expf(bref.x), __expf(bref.y)}; }
    __syncthreads();
    if (tid < DK) dtot *= *(RLAS float*)(lds + L::OFF_D + 4 * tid);
    f32x4 O[4];
    if (DO_OUT) {
        const int it = wave >> 1;
#pragma unroll
        for (int jj = 0; jj < 2; ++jj) {
            const int jt = 2 * (wave & 1) + jj; f32x4 acc = {0.f, 0.f, 0.f, 0.f};
            if (jt <= it) {
#pragma unroll
                for (int s = 0; s < L::NKS; ++s) {
                    const bf16x8 kf = *(RLAS bf16x8*)(lds + L::OFF_K + (16 * jt + r) * L::PK + (32 * s + 8 * g) * 2);
                    const bf16x8 qf = *(RLAS bf16x8*)(lds + L::OFF_Q + (16 * it + r) * L::PK + (32 * s + 8 * g) * 2);
                    acc = __builtin_amdgcn_mfma_f32_16x16x32_bf16(kf, qf, acc, 0, 0, 0);
                }
            }
            const int i = 16 * it + r, j = 16 * jt + 4 * g;
            u32x2 w; w.x = pkbf(j <= i ? acc[0] : 0.f, j + 1 <= i ? acc[1] : 0.f); w.y = pkbf(j + 2 <= i ? acc[2] : 0.f, j + 3 <= i ? acc[3] : 0.f);
            *(RLAS u32x2*)(lds + L::OFF_P + i * L::PP + j * 2) = w;
        }
#pragma unroll
        for (int m = 0; m < 4; ++m) O[m] = (f32x4){0.f, 0.f, 0.f, 0.f};
#pragma unroll
        for (int s = 0; s < L::NKS; ++s) {
            const f32x4 ea = *(RLAS f32x4*)(lds + L::OFF_E + (32 * s + 4 * g) * 4), eb = *(RLAS f32x4*)(lds + L::OFF_E + (32 * s + 16 + 4 * g) * 4);
            const f32x4 sa = S[2 * s] * ea, sb = S[2 * s + 1] * eb;
            u32x4 sp; sp.x = pkbf(sa[0], sa[1]); sp.y = pkbf(sa[2], sa[3]); sp.z = pkbf(sb[0], sb[1]); sp.w = pkbf(sb[2], sb[3]);
            const bf16x8 sf = __builtin_bit_cast(bf16x8, sp);
#pragma unroll
            for (int m = 0; m < 4; ++m) {
                const s16x4 qlo = *(RLAS s16x4*)(lds + L::OFF_Q + (16 * m + r) * L::PK + (32 * s + 4 * g) * 2), qhi = *(RLAS s16x4*)(lds + L::OFF_Q + (16 * m + r) * L::PK + (32 * s + 16 + 4 * g) * 2);
                const bf16x8 qf = __builtin_shufflevector(qlo, qhi, 0, 1, 2, 3, 4, 5, 6, 7);
                O[m] = __builtin_amdgcn_mfma_f32_16x16x32_bf16(qf, sf, O[m], 0, 0, 0);
            }
        }
        __syncthreads();
    }
    const bf16x8 vf0 = tr_frag(lds + L::OFF_V, L::PV, 0, e0, lane), vf1 = tr_frag(lds + L::OFF_V, L::PV, 32, e0, lane);
    if (DO_OUT) {
#pragma unroll
        for (int m = 0; m < 4; ++m) {
            const bf16x8 p0 = *(RLAS bf16x8*)(lds + L::OFF_P + (16 * m + r) * L::PP + (8 * g) * 2), p1 = *(RLAS bf16x8*)(lds + L::OFF_P + (16 * m + r) * L::PP + (32 + 8 * g) * 2);
            O[m] = __builtin_amdgcn_mfma_f32_16x16x32_bf16(p0, vf0, O[m], 0, 0, 0);
            O[m] = __builtin_amdgcn_mfma_f32_16x16x32_bf16(p1, vf1, O[m], 0, 0, 0);
        }
    }
#pragma unroll
    for (int dt = 0; dt < L::NDT; ++dt) {
        const f32x4 dv = *(RLAS f32x4*)(lds + L::OFF_D + (16 * dt + 4 * g) * 4);
        const bf16x8 k0 = tr_frag(lds + L::OFF_KH, L::PK, 0, 16 * dt, lane), k1 = tr_frag(lds + L::OFF_KH, L::PK, 32, 16 * dt, lane);
        f32x4 acc = S[dt] * dv;
        acc = __builtin_amdgcn_mfma_f32_16x16x32_bf16(k0, vf0, acc, 0, 0, 0);
        acc = __builtin_amdgcn_mfma_f32_16x16x32_bf16(k1, vf1, acc, 0, 0, 0);
        S[dt] = acc;
    }
    if (DO_OUT) {
#pragma unroll
        for (int m = 0; m < 4; ++m)
#pragma unroll
            for (int ii = 0; ii < 4; ++ii) *(RLAS float*)(lds + L::OFF_O + (16 * m + 4 * g + ii) * L::PO + (e0 + r) * 4) = O[m][ii];
        __syncthreads();
        const int orow = tid >> 3, oc = (tid & 7) * 16;
        f32x4 ov[4]; float ss = 0.f;
#pragma unroll
        for (int c = 0; c < 4; ++c) { ov[c] = *(RLAS f32x4*)(lds + L::OFF_O + orow * L::PO + (oc + 4 * c) * 4); ss += (ov[c][0] * ov[c][0] + ov[c][1] * ov[c][1]) + (ov[c][2] * ov[c][2] + ov[c][3] * ov[c][3]); }
        ss += __shfl_xor(ss, 1); ss += __shfl_xor(ss, 2); ss += __shfl_xor(ss, 4);
        const float rs = rsqrtf(ss * (1.0f / 128.0f) + R_EPS);
        if (orow < tvalid) {
            const size_t row = row0 + orow; const u32x4* gp = (const u32x4*)(io.P + row * PWID + io.goff + oc); const u32x4 g0 = gp[0], g1 = gp[1];
            const unsigned gw[8] = {g0.x, g0.y, g0.z, g0.w, g1.x, g1.y, g1.z, g1.w};
            unsigned ow[8];
#pragma unroll
            for (int c = 0; c < 8; ++c) {
                const float ga = bflo(gw[c]), gb = bfhi(gw[c]);
                const float oa = ov[c >> 1][(c & 1) * 2] * rs * io.onorm[oc + 2 * c] * (ga * __builtin_amdgcn_rcpf(1.f + __expf(-ga)));
                const float ob = ov[c >> 1][(c & 1) * 2 + 1] * rs * io.onorm[oc + 2 * c + 1] * (gb * __builtin_amdgcn_rcpf(1.f + __expf(-gb)));
                ow[c] = pkbf(oa, ob);
            }
            u32x4* op = (u32x4*)(io.MIX + row * DM + io.ooff + oc);
            op[0] = (u32x4){ow[0], ow[1], ow[2], ow[3]}; op[1] = (u32x4){ow[4], ow[5], ow[6], ow[7]};
        }
    } else {
        __syncthreads();
    }
}

template <int NDT> __device__ __forceinline__ void load_state(f32x4 (&S)[NDT], const float* mem) {
    const int lane = threadIdx.x & 63, wave = threadIdx.x >> 6, r = lane & 15, g = lane >> 4;
#pragma unroll
    for (int dt = 0; dt < NDT; ++dt)
#pragma unroll
        for (int i = 0; i < 4; ++i) S[dt][i] = mem ? mem[(16 * dt + 4 * g + i) * 128 + 16 * wave + r] : 0.f;
}
template <int NDT> __device__ __forceinline__ void store_state(const f32x4 (&S)[NDT], float* mem) {
    const int lane = threadIdx.x & 63, wave = threadIdx.x >> 6, r = lane & 15, g = lane >> 4;
#pragma unroll
    for (int dt = 0; dt < NDT; ++dt)
#pragma unroll
        for (int i = 0; i < 4; ++i) mem[(16 * dt + 4 * g + i) * 128 + 16 * wave + r] = S[dt][i];
}

struct RecArgs {
    const bf16* P; const float* GA; bf16* MIX; const float* lbl; const float* gla_onorm; const float* hg_onorm;
    const float* st_gla_in; const float* st_hg_in; float* ST; float* DT; float* out_sgp; float* out_shp; float* out_sgs; float* out_shs;
};
constexpr int SC_TOK = 256, NCH = SC_TOK / 64, NSC = 8192 / SC_TOK, ST_PER = 4 * 64 * 128 + 4 * 128 * 128, DT_PER = 4 * 64 + 4 * 128;

template <int DK, bool HG> __device__ __forceinline__ HeadIo make_io(const RecArgs& a, int h) {
    HeadIo io; io.P = a.P; io.GA = a.GA; io.MIX = a.MIX;
    if (HG) { io.qoff = 1536 + h * 128; io.koff = 2048 + h * 128; io.voff = 2560 + h * 128; io.goff = 3072 + h * 128; io.ooff = 512 + h * 128; io.gaoff = 0; io.onorm = a.hg_onorm;
        const int d = 2 * ((int)threadIdx.x % (DK / 2)); const float l0 = a.lbl[h * 128 + d], l1 = a.lbl[512 + h * 128 + d], m0 = a.lbl[h * 128 + d + 1], m1 = a.lbl[512 + h * 128 + d + 1];
        io.lb0 = 1.0f / (1.0f + __expf(l1 - l0)); io.lb1 = 1.0f / (1.0f + __expf(m1 - m0)); }
    else { io.qoff = h * 64; io.koff = 256 + h * 64; io.voff = 512 + h * 128; io.goff = 1024 + h * 128; io.ooff = h * 128; io.gaoff = h * 64; io.onorm = a.gla_onorm; io.lb0 = 0.f; io.lb1 = 0.f; }
    return io;
}

template <int DK, bool HG> __device__ __forceinline__ void r1_unit(RLAS unsigned char* lds, const RecArgs& a, int seq, int sc, int h) {
    const HeadIo io = make_io<DK, HG>(a, h);
    f32x4 S[DK / 16]; load_state<DK / 16>(S, nullptr); float dtot = 1.f;
    for (int c = 0; c < NCH; ++c) chunk<DK, HG, false>(lds, io, (size_t)seq * 8192 + sc * SC_TOK + c * 64, 64, S, dtot);
    const size_t u = (size_t)seq * NSC + sc;
    store_state<DK / 16>(S, a.ST + u * ST_PER + (HG ? 32768 + h * 16384 : h * 8192));
    if ((int)threadIdx.x < DK) a.DT[u * DT_PER + (HG ? 256 + h * 128 : h * 64) + threadIdx.x] = dtot;
}
template <int DK, bool HG> __device__ __forceinline__ void r3_unit(RLAS unsigned char* lds, const RecArgs& a, int seq, int sc, int h) {
    const HeadIo io = make_io<DK, HG>(a, h);
    const size_t u = (size_t)seq * NSC + sc;
    f32x4 S[DK / 16]; load_state<DK / 16>(S, a.ST + u * ST_PER + (HG ? 32768 + h * 16384 : h * 8192)); float dtot = 1.f;
    for (int c = 0; c < NCH; ++c) chunk<DK, HG, true>(lds, io, (size_t)seq * 8192 + sc * SC_TOK + c * 64, 64, S, dtot);
    if (sc == NSC - 1) store_state<DK / 16>(S, (HG ? a.out_shp : a.out_sgp) + (size_t)(seq * 4 + h) * DK * 128);
}
template <int DK, bool HG> __device__ __forceinline__ void rs_unit(RLAS unsigned char* lds, const RecArgs& a, int seq, int h) {
    const HeadIo io = make_io<DK, HG>(a, h);
    f32x4 S[DK / 16]; load_state<DK / 16>(S, (HG ? a.st_hg_in : a.st_gla_in) + (size_t)(seq * 4 + h) * DK * 128); float dtot = 1.f;
    chunk<DK, HG, true>(lds, io, (size_t)32768 + seq * 32, 32, S, dtot);
    store_state<DK / 16>(S, (HG ? a.out_shs : a.out_sgs) + (size_t)(seq * 4 + h) * DK * 128);
}
__device__ __forceinline__ void decode_unit(int u, int& scidx, int& head) { scidx = u >> 3; head = ((u & 7) + 4 * ((u >> 8) & 1)) & 7; }

__device__ __forceinline__ void phase_r1(RLAS unsigned char* lds, const RecArgs& a, int G, int bx) {
    for (int u = bx; u < 4 * NSC * 8; u += G) { int scidx, head; decode_unit(u, scidx, head); const int seq = scidx / NSC, sc = scidx % NSC;
        if (sc == NSC - 1) continue;
        if (head < 4) r1_unit<64, false>(lds, a, seq, sc, head); else r1_unit<128, true>(lds, a, seq, sc, head - 4); }
}
__device__ __forceinline__ void phase_r2(const RecArgs& a, int gtid, int NGT) {
    for (int idx = gtid; idx < 4 * ST_PER; idx += NGT) {
        const int seq = idx / ST_PER, off = idx % ST_PER; int dti;
        if (off < 32768) dti = (off / 8192) * 64 + (off % 8192) / 128; else { const int o2 = off - 32768; dti = 256 + (o2 / 16384) * 128 + (o2 % 16384) / 128; }
        float x = 0.f;
        for (int s0 = 0; s0 < NSC; s0 += 8) {
            float tmp[8], dd[8];
#pragma unroll
            for (int j = 0; j < 8; ++j) { const size_t u = (size_t)seq * NSC + s0 + j; const bool has = (s0 + j) < NSC - 1; tmp[j] = has ? a.ST[u * ST_PER + off] : 0.f; dd[j] = has ? a.DT[u * DT_PER + dti] : 0.f; }
#pragma unroll
            for (int j = 0; j < 8; ++j) { const size_t u = (size_t)seq * NSC + s0 + j; a.ST[u * ST_PER + off] = x; x = dd[j] * x + tmp[j]; }
        }
    }
}
__device__ __forceinline__ void phase_r3(RLAS unsigned char* lds, const RecArgs& a, int G, int bx) {
    for (int u = bx; u < 4 * NSC * 8; u += G) { int scidx, head; decode_unit(u, scidx, head); const int seq = scidx / NSC, sc = scidx % NSC;
        if (head < 4) r3_unit<64, false>(lds, a, seq, sc, head); else r3_unit<128, true>(lds, a, seq, sc, head - 4); }
    for (int u = bx; u < 64; u += G) { const int seq = u >> 3, head = u & 7;
        if (head < 4) rs_unit<64, false>(lds, a, seq, head); else rs_unit<128, true>(lds, a, seq, head - 4); }
}
}
#define GAS __attribute__((address_space(1)))
#define LAS __attribute__((address_space(3)))
typedef unsigned short bf16;
typedef unsigned v4u __attribute__((ext_vector_type(4)));
typedef float f32x4 __attribute__((ext_vector_type(4)));
constexpr int NWAVES = 8;
constexpr int D = 1024, FF = 2816, MP = 32768, MS = 256, M = MP + MS, PW = 3584, NIN = 3840, DINSRC = 3600;
constexpr float EPS = 1e-6f;
constexpr size_t MiB = 1u << 20;
constexpr size_t WS_SSQ = 0, SSQ_STRIDE = (size_t)M * 4;
constexpr size_t WS_WGU1 = 1 * MiB, WS_WD1 = 12 * MiB, WS_WIN = 18 * MiB, WS_WO = 26 * MiB, WS_WGU2 = 28 * MiB, WS_WD2 = 39 * MiB;
constexpr size_t WS_XB = 45 * MiB, WS_MIX = 110 * MiB, WS_P = 175 * MiB, WS_HID = WS_P, WS_GA = 401 * MiB, WS_ST = 434 * MiB, WS_DT = 483 * MiB, WS_END = 512 * MiB;
static_assert(WS_P + (size_t)M * PW * 2 <= WS_GA && WS_GA + (size_t)M * 256 * 4 <= WS_ST && WS_XB + (size_t)M * D * 2 <= WS_MIX && WS_MIX + (size_t)M * D * 2 <= WS_P, "ws map");
constexpr size_t O_Y = 0, O_SGP = (size_t)M * D, O_SHP = O_SGP + 4 * 4 * 64 * 128, O_SGS = O_SHP + 4 * 4 * 128 * 128, O_SHS = O_SGS + 8 * 4 * 64 * 128, O_END = O_SHS + 8 * 4 * 128 * 128;
constexpr int LDS_BYTES = 147456;

__device__ __forceinline__ unsigned f2bf(float f) { unsigned u = __builtin_bit_cast(unsigned, f); return (u + 0x7fffu + ((u >> 16) & 1u)) >> 16; }
__device__ __forceinline__ unsigned pk2(float lo, float hi) { return f2bf(lo) | (f2bf(hi) << 16); }
__device__ __forceinline__ float bf2f(bf16 b) { return __builtin_bit_cast(float, (unsigned)b << 16); }
#define LDS_WAIT() asm volatile("s_waitcnt lgkmcnt(0)" ::: "memory")

struct Args { const float* in[21]; float* out; unsigned char* ws; int ph_lo, ph_hi; };

__device__ __forceinline__ float wave_sum(float v) {
#pragma unroll
    for (int o = 1; o < 64; o <<= 1) v += __shfl_xor(v, o);
    return v;
}
__device__ __forceinline__ void tr_item(const float* W, int ldw, int src_col0, int k0, const float* gain, bf16* WT, int K, int dst_row0, LAS float* scr, int lane) {
#pragma unroll 8
    for (int i = 0; i < 32; ++i) { const int kk = 2 * i + (lane >> 5); float w = W[(size_t)(k0 + kk) * ldw + src_col0 + (lane & 31)]; if (gain) w *= gain[k0 + kk]; scr[kk * 33 + (lane & 31)] = w; }
    LDS_WAIT(); asm volatile("" ::: "memory");
    const int c = lane & 7;
#pragma unroll
    for (int j = 0; j < 4; ++j) { const int n = (lane >> 3) + 8 * j; const LAS float* s = scr + (8 * c) * 33 + n;
        v4u o; o.x = pk2(s[0 * 33], s[1 * 33]); o.y = pk2(s[2 * 33], s[3 * 33]); o.z = pk2(s[4 * 33], s[5 * 33]); o.w = pk2(s[6 * 33], s[7 * 33]);
        *(v4u*)(WT + (size_t)(dst_row0 + n) * K + k0 + 8 * c) = o; }
    LDS_WAIT(); asm volatile("" ::: "memory");
}
__device__ __forceinline__ void weff_item(const float* Win, const float* up, int n0, int k0, const float* gain, bf16* WT, LAS float* scr, int lane) {
    float upr[16];
#pragma unroll
    for (int r = 0; r < 16; ++r) upr[r] = up[r * 256 + n0 + (lane & 31)];
#pragma unroll 4
    for (int i = 0; i < 32; ++i) { const int kk = 2 * i + (lane >> 5); const float* wr = Win + (size_t)(k0 + kk) * DINSRC + 1536; float s = 0.f;
#pragma unroll
        for (int r = 0; r < 16; ++r) s += wr[r] * upr[r];
        scr[kk * 33 + (lane & 31)] = s * gain[k0 + kk]; }
    LDS_WAIT(); asm volatile("" ::: "memory");
    const int c = lane & 7;
#pragma unroll
    for (int j = 0; j < 4; ++j) { const int n = (lane >> 3) + 8 * j; const LAS float* s = scr + (8 * c) * 33 + n;
        v4u o; o.x = pk2(s[0 * 33], s[1 * 33]); o.y = pk2(s[2 * 33], s[3 * 33]); o.z = pk2(s[4 * 33], s[5 * 33]); o.w = pk2(s[6 * 33], s[7 * 33]);
        *(v4u*)(WT + (size_t)(3584 + n0 + n) * 1024 + k0 + 8 * c) = o; }
    LDS_WAIT(); asm volatile("" ::: "memory");
}
__device__ __forceinline__ void gu_item(int r, const float* wg, const float* wu, const float* gain, bf16* WT, LAS float* scr, int lane) {
    const int kb = r / 176, nb = r % 176, dst = 32 * nb, tile = dst >> 8, j = dst & 255;
    const float* W = (j < 128) ? wg : wu; const int src = tile * 128 + (j & 127);
    tr_item(W, FF, src, 64 * kb, gain, WT, D, dst, scr, lane);
}

__device__ __forceinline__ void p0_prologue(const Args& a, LAS unsigned char* lds, int gw, int NGW, int lane, int wave, int gtid, int NGT) {
    LAS float* scr = (LAS float*)(lds + wave * 16384);
    unsigned char* ws = a.ws;
    constexpr int I_GU = 16 * 176, I_D = 44 * 32, I_IN = 16 * 112, I_EFF = 16 * 8, I_O = 16 * 32;
    constexpr int NITEMS = 2 * I_GU + 2 * I_D + I_IN + I_EFF + I_O;
    for (int it = gw; it < NITEMS; it += NGW) {
        int r = it; asm volatile("" : "+s"(ws));
        if (r < I_GU) { gu_item(r, a.in[5], a.in[6], a.in[4], (bf16*)(ws + WS_WGU1), scr, lane); continue; } r -= I_GU;
        if (r < I_D) { tr_item(a.in[7], D, 32 * (r % 32), 64 * (r / 32), nullptr, (bf16*)(ws + WS_WD1), FF, 32 * (r % 32), scr, lane); continue; } r -= I_D;
        if (r < I_IN) { const int kb = r / 112, nb = r % 112, dst = 32 * nb, src = dst < 1536 ? dst : dst + 16;
            tr_item(a.in[9], DINSRC, src, 64 * kb, a.in[8], (bf16*)(ws + WS_WIN), D, dst, scr, lane); continue; } r -= I_IN;
        if (r < I_EFF) { weff_item(a.in[9], a.in[10], 32 * (r % 8), 64 * (r / 8), a.in[8], (bf16*)(ws + WS_WIN), scr, lane); continue; } r -= I_EFF;
        if (r < I_O) { tr_item(a.in[15], D, 32 * (r % 32), 64 * (r / 32), nullptr, (bf16*)(ws + WS_WO), D, 32 * (r % 32), scr, lane); continue; } r -= I_O;
        if (r < I_GU) { gu_item(r, a.in[17], a.in[18], a.in[16], (bf16*)(ws + WS_WGU2), scr, lane); continue; } r -= I_GU;
        tr_item(a.in[19], D, 32 * (r % 32), 64 * (r / 32), nullptr, (bf16*)(ws + WS_WD2), FF, 32 * (r % 32), scr, lane);
    }
    float* ssq1 = (float*)(ws + WS_SSQ); bf16* XB = (bf16*)(ws + WS_XB);
    for (int m = gw; m < M; m += NGW) {
        const float* xrow = (m < MP) ? a.in[0] + (size_t)m * D : a.in[1] + (size_t)(m - MP) * D;
        const f32x4* xr = (const f32x4*)xrow + lane; f32x4 v[4]; float s = 0.f;
#pragma unroll
        for (int j = 0; j < 4; ++j) { v[j] = xr[64 * j]; s += (v[j].x * v[j].x + v[j].y * v[j].y) + (v[j].z * v[j].z + v[j].w * v[j].w); }
        s = wave_sum(s);
        unsigned long long* o8 = (unsigned long long*)(XB + (size_t)m * D) + lane;
#pragma unroll
        for (int j = 0; j < 4; ++j) o8[64 * j] = (unsigned long long)pk2(v[j].x, v[j].y) | ((unsigned long long)pk2(v[j].z, v[j].w) << 32);
        if (lane == 0) ssq1[m] = s;
    }
    for (int i = gtid; i < 3 * M; i += NGT) ssq1[M + i] = 0.f;
}

__device__ __forceinline__ void p8_final(const Args& a, int gw, int NGW, int lane) {
    const float* ssq4 = (const float*)(a.ws + WS_SSQ) + 3 * (size_t)M; const f32x4* g = (const f32x4*)a.in[20] + lane;
    f32x4 gv[4];
#pragma unroll
    for (int j = 0; j < 4; ++j) gv[j] = g[64 * j];
    for (int m = gw; m < M; m += NGW) {
        f32x4* xr = (f32x4*)(a.out + (size_t)m * D) + lane; const float rs = rsqrtf(ssq4[m] * (1.0f / 1024.0f) + EPS);
#pragma unroll
        for (int j = 0; j < 4; ++j) xr[64 * j] = xr[64 * j] * rs * gv[j];
    }
}

__global__ void __launch_bounds__(NWAVES * 64, 2) mega_fwd(Args args) {
    extern __shared__ __attribute__((aligned(16))) unsigned char lds_raw[];
    cg::grid_group grid = cg::this_grid();
    LAS unsigned char* lds = (LAS unsigned char*)lds_raw;
    const int tid = threadIdx.x, lane = tid & 63, wave = __builtin_amdgcn_readfirstlane(tid >> 6);
    const int G = gridDim.x, bx = blockIdx.x;
    const int gw = bx * NWAVES + wave, NGW = G * NWAVES, gtid = bx * (NWAVES * 64) + tid, NGT = G * NWAVES * 64;
    unsigned char* ws = args.ws;
    float* ssq = (float*)(ws + WS_SSQ);
    const int lo = args.ph_lo, hi = args.ph_hi;
#define IN(k) (lo <= (k) && (k) < hi)
#define BOTH(k) (IN(k) && IN((k) + 1))
#define GRID_BAR() grid.sync()

    if (IN(0)) { p0_prologue(args, lds, gw, NGW, lane, wave, gtid, NGT); if (BOTH(0)) GRID_BAR(); }
    if (IN(1)) {
        pg8::Gemm g{(const bf16*)(ws + WS_XB), (const bf16*)(ws + WS_WGU1), M, 2 * FF, D}; pg8::StaticOrder S; S.init(M, 2 * FF, G, bx);
        pg8::EpiUp E{(bf16*)(ws + WS_HID), FF, ssq};
        pg8::gemm_phase<pg8::EpiUp, pg8::StaticOrder, true, true>(lds, g, S, E);
        if (BOTH(1)) GRID_BAR();
    }
    if (IN(2)) {
        pg8::Gemm g{(const bf16*)(ws + WS_HID), (const bf16*)(ws + WS_WD1), M, D, FF}; pg8::StaticOrder S; S.init(M, D, G, bx);
        pg8::EpiRes E{args.in[0], args.in[1], MP / 256, args.out, (bf16*)(ws + WS_XB), ssq + M, 0.5f};
        pg8::gemm_phase<pg8::EpiRes, pg8::StaticOrder, true, true>(lds, g, S, E);
        if (BOTH(2)) GRID_BAR();
    }
    if (IN(3)) {
        pg8::Gemm g{(const bf16*)(ws + WS_XB), (const bf16*)(ws + WS_WIN), M, NIN, D}; pg8::StaticOrder S; S.init(M, NIN, G, bx);
        pg8::EpiWin E{(bf16*)(ws + WS_P), (float*)(ws + WS_GA), ssq + M, args.in[11]};
        pg8::gemm_phase<pg8::EpiWin, pg8::StaticOrder, true, true>(lds, g, S, E);
        if (BOTH(3)) GRID_BAR();
    }
    {
        rec::RecArgs ra{(const bf16*)(ws + WS_P), (const float*)(ws + WS_GA), (bf16*)(ws + WS_MIX), args.in[13], args.in[12], args.in[14], args.in[2], args.in[3],
                        (float*)(ws + WS_ST), (float*)(ws + WS_DT), args.out + O_SGP, args.out + O_SHP, args.out + O_SGS, args.out + O_SHS};
        if (IN(4)) { rec::phase_r1(lds, ra, G, bx); if (BOTH(4)) GRID_BAR(); }
        if (IN(5)) { rec::phase_r2(ra, gtid, NGT); if (BOTH(5)) GRID_BAR(); }
        if (IN(6)) { rec::phase_r3(lds, ra, G, bx); if (BOTH(6)) GRID_BAR(); }
    }
    if (IN(7)) {
        pg8::Gemm g{(const bf16*)(ws + WS_MIX), (const bf16*)(ws + WS_WO), M, D, D}; pg8::StaticOrder S; S.init(M, D, G, bx);
        pg8::EpiRes E{args.out, args.out, 1 << 30, args.out, (bf16*)(ws + WS_XB), ssq + 2 * M, 1.0f};
        pg8::gemm_phase<pg8::EpiRes, pg8::StaticOrder, true, true>(lds, g, S, E);
        if (BOTH(7)) GRID_BAR();
    }
    if (IN(8)) {
        pg8::Gemm g{(const bf16*)(ws + WS_XB), (const bf16*)(ws + WS_WGU2), M, 2 * FF, D}; pg8::StaticOrder S; S.init(M, 2 * FF, G, bx);
        pg8::EpiUp E{(bf16*)(ws + WS_HID), FF, ssq + 2 * M};
        pg8::gemm_phase<pg8::EpiUp, pg8::StaticOrder, true, true>(lds, g, S, E);
        if (BOTH(8)) GRID_BAR();
    }
    if (IN(9)) {
        pg8::Gemm g{(const bf16*)(ws + WS_HID), (const bf16*)(ws + WS_WD2), M, D, FF}; pg8::StaticOrder S; S.init(M, D, G, bx);
        pg8::EpiRes E{args.out, args.out, 1 << 30, args.out, nullptr, ssq + 3 * M, 0.5f};
        pg8::gemm_phase<pg8::EpiRes, pg8::StaticOrder, true, true>(lds, g, S, E);
        if (BOTH(9)) GRID_BAR();
    }
    if (IN(10)) p8_final(args, gw, NGW, lane);
#undef IN
#undef BOTH
}

extern "C" void kernel_launch(void* const* d_in, const int* in_sizes, int n_in, void* d_out, int out_size, void* d_ws, size_t ws_size, hipStream_t stream) {
    static int grid = 0;
    if (grid == 0) {
        if (n_in != 21 || out_size != (int)O_END || ws_size < WS_END) { fprintf(stderr, "kernel_launch: unexpected sizes n_in %d out %d ws %zu\n", n_in, out_size, ws_size); grid = -1; return; }
        int dev = 0, cus = 0, per_cu = 0;
        (void)hipGetDevice(&dev); (void)hipDeviceGetAttribute(&cus, hipDeviceAttributeMultiprocessorCount, dev);
        if (hipFuncSetAttribute((const void*)mega_fwd, hipFuncAttributeMaxDynamicSharedMemorySize, LDS_BYTES) != hipSuccess) { fprintf(stderr, "hipFuncSetAttribute failed\n"); grid = -1; return; }
        if (hipOccupancyMaxActiveBlocksPerMultiprocessor(&per_cu, (const void*)mega_fwd, NWAVES * 64, LDS_BYTES) != hipSuccess || per_cu < 1) { fprintf(stderr, "occupancy query: %d\n", per_cu); per_cu = 1; }
        (void)hipGetLastError();
        grid = cus * per_cu;
    }
    if (grid < 0) return;
    Args a{};
    for (int i = 0; i < 21; ++i) a.in[i] = (const float*)d_in[i];
    a.out = (float*)d_out; a.ws = (unsigned char*)d_ws;
    a.ph_lo = 0; a.ph_hi = 11;
    void* kargs[] = {&a};
    hipError_t e = hipLaunchCooperativeKernel((const void*)mega_fwd, dim3(grid), dim3(NWAVES * 64), kargs, LDS_BYTES, stream);
    if (e != hipSuccess) fprintf(stderr, "cooperative launch failed: %s (grid %d)\n", hipGetErrorString(e), grid);
}
```

```cpp
#include <hip/hip_runtime.h>
#include <hip/hip_cooperative_groups.h>
#include <cstdio>
#include <cstdint>
namespace cg = cooperative_groups;
namespace pg8 {
#define PG8_LAS __attribute__((address_space(3)))
typedef unsigned short bf16_t;
typedef short bf16x8 __attribute__((ext_vector_type(8)));
typedef float f32x4 __attribute__((ext_vector_type(4)));
typedef unsigned u32x4 __attribute__((ext_vector_type(4)));
constexpr int BM = 256, BK = 64, HALF = 128, HTB = HALF * BK * 2  , STAGE_BYTES = 8 * HTB, NXCD = 8, WGM = 8;

__host__ __device__ __forceinline__ int lds_byte(int r, int c) { const int st = (r >> 4) * 2 + (c >> 5), rr = r & 15, cc = c & 31, ob = rr * 64 + cc * 2; return st * 1024 + (ob ^ (((ob >> 9) & 1) << 5)); }
__host__ __device__ __forceinline__ void stage_rc(int b, int& R, int& C) { const int st = b / 1024, sb = b % 1024, swz = sb ^ (((sb >> 9) & 1) << 5); R = (st >> 1) * 16 + swz / 64; C = (st & 1) * 32 + (swz % 64) / 2; }
__host__ __device__ __forceinline__ int perm32(int rho) { const int n = rho >> 4, i = rho & 15; return 8 * (i >> 2) + 4 * n + (i & 3); }

struct Unit { int pm, pn; };
struct Gemm { const bf16_t* A; const bf16_t* Bt; int M, N, K; };

struct StaticOrder {
    int nM, nN, nwg, G, c;
    __host__ __device__ void init(int M, int N, int G_, int c_) { nM = M / BM; nN = N / BM; nwg = nM * nN; G = G_; c = c_; }
    __host__ __device__ bool next(int i, Unit& u) const {
        const long L = (long)i * G + c; if (L >= nwg) return false;
        int wgid = (int)L; { const int q = nwg / NXCD, r = nwg % NXCD, xcd = wgid % NXCD, off = wgid / NXCD; wgid = (xcd < r ? xcd * (q + 1) : r * (q + 1) + (xcd - r) * q) + off; }
        const int nig = WGM * nN, gid = wgid / nig, fm = gid * WGM, gsz = (nM - fm) < WGM ? (nM - fm) : WGM;
        u.pm = fm + ((wgid % nig) % gsz); u.pn = (wgid % nig) / gsz; return true;
    }
    __device__ __forceinline__ void a_ready(const Unit&) const {}
    __device__ __forceinline__ void done(const Unit&) const {}
};

__device__ __forceinline__ unsigned cvt_pk_bf16(float lo, float hi) { unsigned r; asm volatile("v_cvt_pk_bf16_f32 %0, %1, %2" : "=v"(r) : "v"(lo), "v"(hi)); return r; }
typedef float f32x2 __attribute__((ext_vector_type(2)));
constexpr float RMS_EPS = 1e-6f;
__device__ __forceinline__ float silu_f(float g) { return g * __builtin_amdgcn_rcpf(1.0f + __expf(-g)); }
__device__ __forceinline__ float rstd_of(const float* ssq, int row) { return rsqrtf(ssq[row] * (1.0f / 1024.0f) + RMS_EPS); }

struct EpiUp {
    static constexpr bool PERM = true, AFTER_DRAIN = false;
    bf16_t* H; int ldh; const float* ssq;
    __device__ __forceinline__ void operator()(const f32x4 (&acc)[2][2][4][2], const Unit& u, int wr, int wc, int fr, int fq) const {
        const int row0 = u.pm * BM + wr * 64 + fr, hcol0 = u.pn * HALF + wc * 32 + 8 * fq;
#pragma unroll
        for (int ai = 0; ai < 2; ++ai)
#pragma unroll
            for (int m = 0; m < 4; ++m) {
                const int row = row0 + ai * HALF + m * 16; const float rs = rstd_of(ssq, row);
                float h[8];
#pragma unroll
                for (int n = 0; n < 2; ++n)
#pragma unroll
                    for (int i = 0; i < 4; ++i) { const float g = acc[ai][0][m][n][i] * rs, uu = acc[ai][1][m][n][i] * rs; h[4 * n + i] = silu_f(g) * uu; }
                u32x4 w; w.x = cvt_pk_bf16(h[0], h[1]); w.y = cvt_pk_bf16(h[2], h[3]); w.z = cvt_pk_bf16(h[4], h[5]); w.w = cvt_pk_bf16(h[6], h[7]);
                *(u32x4*)(H + (size_t)row * ldh + hcol0) = w;
            }
    }
};

struct EpiRes {
    static constexpr bool PERM = false, AFTER_DRAIN = false;
    const float* xi0; const float* xi1; int split_pm;
    float* xo; bf16_t* xob; float* ssq; float scale;
    __device__ __forceinline__ void operator()(const f32x4 (&acc)[2][2][4][2], const Unit& u, int wr, int wc, int fr, int fq) const {
        typedef unsigned u32x2v __attribute__((ext_vector_type(2)));
        const int row0 = u.pm * BM + wr * 64 + fr, col0 = u.pn * BM + wc * 32 + 4 * fq;
        const float* xin = (u.pm < split_pm) ? xi0 : (xi1 - (size_t)split_pm * BM * 1024);
#pragma unroll
        for (int ai = 0; ai < 2; ++ai)
#pragma unroll
            for (int m = 0; m < 4; ++m) {
                const int row = row0 + ai * HALF + m * 16; const size_t off = (size_t)row * 1024 + col0; float s = 0.f;
#pragma unroll
                for (int bj = 0; bj < 2; ++bj)
#pragma unroll
                    for (int n = 0; n < 2; ++n) {
                        const f32x4 b = *(const f32x4*)(xin + off + bj * HALF + n * 16);
                        const f32x4 v = b + acc[ai][bj][m][n] * scale;
                        *(f32x4*)(xo + off + bj * HALF + n * 16) = v;
                        s += (v[0] * v[0] + v[1] * v[1]) + (v[2] * v[2] + v[3] * v[3]);
                        if (xob) { u32x2v w; w.x = cvt_pk_bf16(v[0], v[1]); w.y = cvt_pk_bf16(v[2], v[3]); *(u32x2v*)(xob + off + bj * HALF + n * 16) = w; }
                    }
                s += __shfl_xor(s, 16); s += __shfl_xor(s, 32);
                if (fq == 0) __hip_atomic_fetch_add(ssq + row, s, __ATOMIC_RELAXED, __HIP_MEMORY_SCOPE_AGENT);
            }
    }
};

struct EpiWin {
    static constexpr bool PERM = true, AFTER_DRAIN = false;
    bf16_t* P; float* GA; const float* ssq; const float* gbias;
    __device__ __forceinline__ void operator()(const f32x4 (&acc)[2][2][4][2], const Unit& u, int wr, int wc, int fr, int fq) const {
        const int row0 = u.pm * BM + wr * 64 + fr, c0 = wc * 32 + 8 * fq, pn = u.pn;
#pragma unroll
        for (int ai = 0; ai < 2; ++ai)
#pragma unroll
            for (int m = 0; m < 4; ++m) {
                const int row = row0 + ai * HALF + m * 16; const float rs = rstd_of(ssq, row);
#pragma unroll
                for (int bj = 0; bj < 2; ++bj) {
                    float v[8];
#pragma unroll
                    for (int n = 0; n < 2; ++n)
#pragma unroll
                        for (int i = 0; i < 4; ++i) v[4 * n + i] = acc[ai][bj][m][n][i] * rs;
                    const int tc = bj * HALF + c0;
                    if (pn == 14) {
                        f32x4 o0, o1;
#pragma unroll
                        for (int i = 0; i < 8; ++i) { const float x = v[i] + gbias[tc + i]; const float ls = fminf(x, 0.f) - __logf(1.0f + __expf(-fabsf(x))); if (i < 4) o0[i] = ls * 0.0625f; else o1[i - 4] = ls * 0.0625f; }
                        *(f32x4*)(GA + (size_t)row * 256 + tc) = o0; *(f32x4*)(GA + (size_t)row * 256 + tc + 4) = o1;
                    } else {
                        if (pn == 0) {
#pragma unroll
                            for (int i = 0; i < 8; ++i) v[i] *= 0.125f;
                        } else if (pn == 6 || pn == 7) {
#pragma unroll
                            for (int i = 0; i < 8; ++i) v[i] = silu_f(v[i]);
                        }
                        u32x4 w; w.x = cvt_pk_bf16(v[0], v[1]); w.y = cvt_pk_bf16(v[2], v[3]); w.z = cvt_pk_bf16(v[4], v[5]); w.w = cvt_pk_bf16(v[6], v[7]);
                        *(u32x4*)(P + (size_t)row * 3584 + pn * BM + tc) = w;
                    }
                }
            }
    }
};
template <class Epi, class Sched, bool ALIGN_EPI = false, bool SP2 = false>
__device__ __forceinline__ void gemm_phase(PG8_LAS unsigned char* lds, const Gemm g, const Sched& S, const Epi& E) {
    const int tid = threadIdx.x, wid = __builtin_amdgcn_readfirstlane(tid >> 6), lane = tid & 63, wr = wid >> 2, wc = wid & 3, fr = lane & 15, fq = lane >> 4;
    const int K = g.K, nt = K / BK;
    unsigned voffA[2], voffB[2];
#pragma unroll
    for (int i = 0; i < 2; ++i) { int R, C; stage_rc(tid * 16 + i * 8192, R, C); const int Rb = Epi::PERM ? ((R & ~31) + perm32(R & 31)) : R;
        voffA[i] = (unsigned)(R * K + C) * 2u; voffB[i] = (unsigned)(Rb * K + C) * 2u; }
    const size_t kstep = (size_t)(BK * 2);
    const size_t hstep = (size_t)HALF * K * 2;
    const size_t tstep = 2 * hstep;
    const unsigned ldsw = (unsigned)wid * 1024u;
    const int aoff = lds_byte(wr * 64 + fr, fq * 8), boff = lds_byte(wc * 32 + fr, fq * 8);
#define PG8_SA(b, h) (((b) * 2 + (h)) * HTB)
#define PG8_SB(b, h) ((4 + (b) * 2 + (h)) * HTB)
#define PG8_STAGE(bufoff, gbase, voff) do { _Pragma("unroll") for (int _i = 0; _i < 2; ++_i) \
        __builtin_amdgcn_global_load_lds((const unsigned*)((const char*)(gbase) + (voff)[_i]), (PG8_LAS unsigned*)(lds + (bufoff) + ldsw + _i * 8192), 16, 0, 0); } while (0)
#define PG8_LDA(dst, b, h) do { _Pragma("unroll") for (int m = 0; m < 4; ++m) _Pragma("unroll") for (int k = 0; k < 2; ++k) dst[m][k] = *(const PG8_LAS bf16x8*)(lds + PG8_SA(b, h) + aoff + m * 2048 + k * 1024); } while (0)
#define PG8_LDB(dst, b, h) do { _Pragma("unroll") for (int n = 0; n < 2; ++n) _Pragma("unroll") for (int k = 0; k < 2; ++k) dst[n][k] = *(const PG8_LAS bf16x8*)(lds + PG8_SB(b, h) + boff + n * 2048 + k * 1024); } while (0)
#define PG8_MMA(ai, bj, At, Bt) do { __builtin_amdgcn_s_setprio(1); _Pragma("unroll") for (int m = 0; m < 4; ++m) _Pragma("unroll") for (int n = 0; n < 2; ++n) _Pragma("unroll") for (int k = 0; k < 2; ++k) \
        acc[ai][bj][m][n] = __builtin_amdgcn_mfma_f32_16x16x32_bf16(Bt[n][k], At[m][k], acc[ai][bj][m][n], 0, 0, 0); __builtin_amdgcn_s_setprio(0); } while (0)
#define PG8_WAIT_V(n) asm volatile("s_waitcnt vmcnt(" #n ")" ::: "memory")
#define PG8_WAIT_L(n) asm volatile("s_waitcnt lgkmcnt(" #n ")" ::: "memory")
#define PG8_BAR __builtin_amdgcn_s_barrier()
#define PG8_SCHED __builtin_amdgcn_sched_barrier(0)
    Unit cur, nxt; int ui = 0;
    if (!S.next(0, cur)) return;
    f32x4 acc[2][2][4][2];
#pragma unroll
    for (int a = 0; a < 2; ++a)
#pragma unroll
        for (int b = 0; b < 2; ++b)
#pragma unroll
            for (int m = 0; m < 4; ++m)
#pragma unroll
                for (int n = 0; n < 2; ++n) acc[a][b][m][n] = (f32x4){0.f, 0.f, 0.f, 0.f};
    bf16x8 At[4][2], B0[2][2], B1[2][2];
    const char* cA = (const char*)g.A + (size_t)cur.pm * tstep; const char* cB = (const char*)g.Bt + (size_t)cur.pn * tstep;
    S.a_ready(cur);
    if constexpr (SP2) {
        PG8_STAGE(PG8_SB(0, 0), cB, voffB); PG8_STAGE(PG8_SB(0, 1), cB + hstep, voffB); PG8_STAGE(PG8_SA(0, 0), cA, voffA); PG8_STAGE(PG8_SA(0, 1), cA + hstep, voffA);
        if (wr == 1) PG8_BAR;
        PG8_WAIT_V(2); PG8_BAR;
        PG8_STAGE(PG8_SB(1, 0), cB + kstep, voffB); PG8_STAGE(PG8_SA(1, 0), cA + kstep, voffA); PG8_STAGE(PG8_SB(1, 1), cB + hstep + kstep, voffB);
        PG8_WAIT_V(6); PG8_BAR;
    } else {
        PG8_STAGE(PG8_SB(0, 0), cB, voffB); PG8_STAGE(PG8_SA(0, 0), cA, voffA); PG8_STAGE(PG8_SB(0, 1), cB + hstep, voffB); PG8_STAGE(PG8_SA(0, 1), cA + hstep, voffA);
        if (wr == 1) PG8_BAR;
        PG8_WAIT_V(4); PG8_BAR;
        PG8_STAGE(PG8_SB(1, 0), cB + kstep, voffB); PG8_STAGE(PG8_SA(1, 0), cA + kstep, voffA); PG8_STAGE(PG8_SB(1, 1), cB + hstep + kstep, voffB);
        PG8_WAIT_V(6); PG8_BAR;
    }
    for (;;) {
        const bool has_next = S.next(ui + 1, nxt);
        const char* nA = has_next ? (const char*)g.A + (size_t)nxt.pm * tstep : cA; const char* nB = has_next ? (const char*)g.Bt + (size_t)nxt.pn * tstep : cB;
        for (int t = 0; t < nt; t += 2) {
            const bool last = (t == nt - 2);
            const char* a1 = cA + (size_t)(t + 1) * kstep;
            const char* a2 = last ? nA : cA + (size_t)(t + 2) * kstep; const char* b2 = last ? nB : cB + (size_t)(t + 2) * kstep;
            const char* a3 = a2 + kstep; const char* b3 = b2 + kstep;
            if (last && has_next) S.a_ready(nxt);
            if constexpr (SP2) {
            PG8_LDB(B0, 0, 0); PG8_LDB(B1, 0, 1); PG8_SCHED; PG8_LDA(At, 0, 0); PG8_STAGE(PG8_SA(1, 1), a1 + hstep, voffA);
            PG8_WAIT_V(8); PG8_WAIT_L(0); PG8_BAR; PG8_MMA(0, 0, At, B0); PG8_MMA(0, 1, At, B1); PG8_BAR; PG8_SCHED;
            PG8_LDA(At, 0, 1); PG8_STAGE(PG8_SB(0, 0), b2, voffB); PG8_STAGE(PG8_SB(0, 1), b2 + hstep, voffB); PG8_STAGE(PG8_SA(0, 0), a2, voffA);
            PG8_WAIT_V(8); PG8_WAIT_L(0); PG8_BAR; PG8_MMA(1, 0, At, B0); PG8_MMA(1, 1, At, B1); PG8_BAR; PG8_SCHED;
            PG8_LDB(B0, 1, 0); PG8_LDB(B1, 1, 1); PG8_SCHED; PG8_LDA(At, 1, 0); PG8_STAGE(PG8_SA(0, 1), a2 + hstep, voffA);
            PG8_WAIT_V(8); PG8_WAIT_L(0); PG8_BAR; PG8_MMA(0, 0, At, B0); PG8_MMA(0, 1, At, B1); PG8_BAR; PG8_SCHED;
            PG8_LDA(At, 1, 1); PG8_STAGE(PG8_SB(1, 0), b3, voffB); PG8_STAGE(PG8_SB(1, 1), b3 + hstep, voffB); PG8_STAGE(PG8_SA(1, 0), a3, voffA);
            PG8_WAIT_V(8); PG8_WAIT_L(0); PG8_BAR; PG8_MMA(1, 0, At, B0); PG8_MMA(1, 1, At, B1); PG8_BAR; PG8_SCHED;
            } else {
            PG8_LDB(B0, 0, 0); PG8_SCHED; PG8_LDA(At, 0, 0); PG8_STAGE(PG8_SA(1, 1), a1 + hstep, voffA);
            PG8_WAIT_L(8); PG8_BAR; PG8_WAIT_L(0); PG8_MMA(0, 0, At, B0); PG8_BAR; PG8_SCHED;
            PG8_LDB(B1, 0, 1); PG8_STAGE(PG8_SB(0, 0), b2, voffB);
            PG8_BAR; PG8_WAIT_L(0); PG8_MMA(0, 1, At, B1); PG8_BAR;
            PG8_LDA(At, 0, 1); PG8_STAGE(PG8_SA(0, 0), a2, voffA);
            PG8_BAR; PG8_WAIT_L(0); PG8_MMA(1, 0, At, B0); PG8_BAR; PG8_SCHED;
            PG8_STAGE(PG8_SB(0, 1), b2 + hstep, voffB);
            PG8_WAIT_V(6); PG8_BAR; PG8_MMA(1, 1, At, B1); PG8_BAR;
            PG8_LDB(B0, 1, 0); PG8_SCHED; PG8_LDA(At, 1, 0); PG8_STAGE(PG8_SA(0, 1), a2 + hstep, voffA);
            PG8_WAIT_L(8); PG8_BAR; PG8_WAIT_L(0); PG8_MMA(0, 0, At, B0); PG8_BAR; PG8_SCHED;
            PG8_LDB(B1, 1, 1); PG8_STAGE(PG8_SB(1, 0), b3, voffB);
            PG8_BAR; PG8_WAIT_L(0); PG8_MMA(0, 1, At, B1); PG8_BAR;
            PG8_LDA(At, 1, 1); PG8_STAGE(PG8_SA(1, 0), a3, voffA);
            PG8_BAR; PG8_WAIT_L(0); PG8_MMA(1, 0, At, B0); PG8_BAR; PG8_SCHED;
            PG8_STAGE(PG8_SB(1, 1), b3 + hstep, voffB);
            PG8_WAIT_V(6); PG8_BAR; PG8_MMA(1, 1, At, B1); PG8_BAR;
            }
        }
        if constexpr (ALIGN_EPI) { if (wr == 0) PG8_BAR; }
        if constexpr (!Epi::AFTER_DRAIN) { E(acc, cur, wr, wc, fr, fq); S.done(cur); }
        if (!has_next) break;
#pragma unroll
        for (int a = 0; a < 2; ++a)
#pragma unroll
            for (int b = 0; b < 2; ++b)
#pragma unroll
                for (int m = 0; m < 4; ++m)
#pragma unroll
                    for (int n = 0; n < 2; ++n) acc[a][b][m][n] = (f32x4){0.f, 0.f, 0.f, 0.f};
        cur = nxt; cA = nA; cB = nB; ++ui;
        if constexpr (ALIGN_EPI) { if (wr == 1) PG8_BAR; }
    }
    PG8_WAIT_V(0);
    if constexpr (!ALIGN_EPI) { if (wr == 0) PG8_BAR; }
    PG8_BAR;
    if constexpr (Epi::AFTER_DRAIN) { E.fused(acc, cur, wr, wc, fr, fq, lds, wid, lane); S.done(cur); }
#undef PG8_SA
#undef PG8_SB
#undef PG8_STAGE
#undef PG8_LDA
#undef PG8_LDB
#undef PG8_MMA
#undef PG8_WAIT_V
#undef PG8_WAIT_L
#undef PG8_BAR
#undef PG8_SCHED
}
}
namespace rec {
#define RLAS __attribute__((address_space(3)))
typedef unsigned short bf16;
typedef short bf16x8 __attribute__((ext_vector_type(8)));
typedef short s16x4 __attribute__((ext_vector_type(4)));
typedef float f32x4 __attribute__((ext_vector_type(4)));
typedef float f32x2 __attribute__((ext_vector_type(2)));
typedef unsigned u32x2 __attribute__((ext_vector_type(2)));
typedef unsigned u32x4 __attribute__((ext_vector_type(4)));
constexpr int PWID = 3584, DM = 1024;
constexpr float R_EPS = 1e-6f;

typedef __bf16 bf16x2_t __attribute__((ext_vector_type(2)));
__device__ __forceinline__ unsigned pkbf(float lo, float hi) { const f32x2 v = {lo, hi}; const bf16x2_t b = __builtin_convertvector(v, bf16x2_t); return __builtin_bit_cast(unsigned, b); }
__device__ __forceinline__ float bflo(unsigned u) { return __builtin_bit_cast(float, u << 16); }
__device__ __forceinline__ float bfhi(unsigned u) { return __builtin_bit_cast(float, u & 0xffff0000u); }

template <int DK> struct Lay {
    static constexpr int NP = DK / 2, NSEG = 512 / NP, TL = 64 / NSEG, SEGREF = 32 / TL - 1, NDT = DK / 16, NKS = DK / 32;
    static constexpr int PK = DK * 2 + 32, PV = 288, PP = 160, PO = 528;
    static constexpr int OFF_Q = 0, OFF_K = OFF_Q + 64 * PK, OFF_KH = OFF_K + 64 * PK, OFF_V = OFF_KH + 64 * PK, OFF_P = OFF_V + 64 * PV, OFF_O = OFF_P + 64 * PP,
                         OFF_SEG = OFF_O + 64 * PO, OFF_D = OFF_SEG + NSEG * DK * 4, OFF_E = OFF_D + DK * 4, OFF_END = OFF_E + DK * 4;
    static_assert(OFF_END <= 131072, "recurrence LDS map");
};

__device__ __forceinline__ bf16x8 tr_frag(RLAS unsigned char* img, int pitch, int k0, int n0, int lane) {
    const int g = lane >> 4, q = (lane & 15) >> 2, p = lane & 3;
    RLAS unsigned char* a = img + (k0 + 8 * g + q) * pitch + n0 * 2 + 8 * p;
    const s16x4 lo = __builtin_amdgcn_ds_read_tr16_b64_v4i16((RLAS s16x4*)a);
    const s16x4 hi = __builtin_amdgcn_ds_read_tr16_b64_v4i16((RLAS s16x4*)(a + 4 * pitch));
    return __builtin_shufflevector(lo, hi, 0, 1, 2, 3, 4, 5, 6, 7);
}

struct HeadIo {
    const bf16* P; const float* GA; bf16* MIX;
    int qoff, koff, voff, goff, ooff, gaoff;
    const float* onorm; float lb0, lb1;
};

template <int DK, bool HG, bool DO_OUT>
__device__ __forceinline__ void chunk(RLAS unsigned char* lds, const HeadIo& io, size_t row0, int tvalid, f32x4 (&S)[DK / 16], float& dtot) {
    typedef Lay<DK> L;
    int tid = threadIdx.x; asm volatile("" : "+v"(tid));
    const int lane = tid & 63, wave = tid >> 6, r = lane & 15, g = lane >> 4, e0 = 16 * wave;
    const int dp = tid % L::NP, seg = tid / L::NP;
    unsigned q2[L::TL], k2[L::TL]; f32x2 lg[L::TL];
#pragma unroll
    for (int tt = 0; tt < L::TL; ++tt) {
        const int t = seg * L::TL + tt; const size_t row = row0 + t; const bool ok = t < tvalid;
        q2[tt] = ok ? *(const unsigned*)(io.P + row * PWID + io.qoff + 2 * dp) : 0u;
        k2[tt] = ok ? *(const unsigned*)(io.P + row * PWID + io.koff + 2 * dp) : 0u;
        if (!HG) lg[tt] = ok ? *(const f32x2*)(io.GA + row * 256 + io.gaoff + 2 * dp) : (f32x2){0.f, 0.f};
    }
    {
        const int vr = tid >> 3, vc = (tid & 7) * 16; u32x4 v0 = {0u, 0u, 0u, 0u}, v1 = {0u, 0u, 0u, 0u};
        if (vr < tvalid) { const u32x4* src = (const u32x4*)(io.P + (row0 + vr) * PWID + io.voff + vc); v0 = src[0]; v1 = src[1]; }
        RLAS u32x4* dst = (RLAS u32x4*)(lds + L::OFF_V + vr * L::PV + vc * 2); dst[0] = v0; dst[1] = v1;
    }
    float kx[L::TL], ky[L::TL];
#pragma unroll
    for (int tt = 0; tt < L::TL; ++tt) {
        if (HG) {
            const bool ok = seg * L::TL + tt < tvalid;
            const float zx = fminf(fmaxf(bflo(k2[tt]), -30.f), 30.f), zy = fminf(fmaxf(bfhi(k2[tt]), -30.f), 30.f);
            const float ex = __expf(-zx), ey = __expf(-zy), sx = __builtin_amdgcn_rcpf(1.f + ex), sy = __builtin_amdgcn_rcpf(1.f + ey);
            const float fx = io.lb0 + (1.f - io.lb0) * sx, fy = io.lb1 + (1.f - io.lb1) * sy;
            kx[tt] = ok ? (1.f - io.lb0) * ex * sx : 0.f; ky[tt] = ok ? (1.f - io.lb1) * ey * sy : 0.f;
            lg[tt] = ok ? (f32x2){__logf(fx), __logf(fy)} : (f32x2){0.f, 0.f};
        } else { kx[tt] = bflo(k2[tt]); ky[tt] = bfhi(k2[tt]); }
    }
#pragma unroll
    for (int tt = 1; tt < L::TL; ++tt) lg[tt] += lg[tt - 1];
    *(RLAS f32x2*)(lds + L::OFF_SEG + (seg * DK + 2 * dp) * 4) = lg[L::TL - 1];
    __syncthreads();
    f32x2 off = {0.f, 0.f}, bref = {0.f, 0.f}, blast = {0.f, 0.f};
#pragma unroll
    for (int s = 0; s < L::NSEG; ++s) { const f32x2 v = *(RLAS f32x2*)(lds + L::OFF_SEG + (s * DK + 2 * dp) * 4); if (s < seg) off += v; if (s <= L::SEGREF) bref += v; blast += v; }
#pragma unroll
    for (int tt = 0; tt < L::TL; ++tt) {
        const int t = seg * L::TL + tt; const f32x2 b = off + lg[tt];
        const float qx = bflo(q2[tt]), qy = bfhi(q2[tt]);
        const float eqx = __expf(b.x - bref.x), eqy = __expf(b.y - bref.y), ekx = __expf(bref.x - b.x), eky = __expf(bref.y - b.y), ehx = __expf(blast.x - b.x), ehy = __expf(blast.y - b.y);
        *(RLAS unsigned*)(lds + L::OFF_Q + t * L::PK + 4 * dp) = pkbf(qx * eqx, qy * eqy);
        *(RLAS unsigned*)(lds + L::OFF_K + t * L::PK + 4 * dp) = pkbf(kx[tt] * ekx, ky[tt] * eky);
        *(RLAS unsigned*)(lds + L::OFF_KH + t * L::PK + 4 * dp) = pkbf(kx[tt] * ehx, ky[tt] * ehy);
    }
    if (seg == 0) { *(RLAS f32x2*)(lds + L::OFF_D + 8 * dp) = (f32x2){__expf(blast.x), __expf(blast.y)}; *(RLAS f32x2*)(lds + L::OFF_E + 8 * dp) = (f32x2){__expf(bref.x), __expf(bref.y)}; }
    __syncthreads();
    if (tid < DK) dtot *= *(RLAS float*)(lds + L::OFF_D + 4 * tid);
    f32x4 O[4];
    if (DO_OUT) {
        const int it = wave >> 1;
#pragma unroll
        for (int jj = 0; jj < 2; ++jj) {
            const int jt = 2 * (wave & 1) + jj; f32x4 acc = {0.f, 0.f, 0.f, 0.f};
            if (jt <= it) {
#pragma unroll
                for (int s = 0; s < L::NKS; ++s) {
                    const bf16x8 kf = *(RLAS bf16x8*)(lds + L::OFF_K + (16 * jt + r) * L::PK + (32 * s + 8 * g) * 2);
                    const bf16x8 qf = *(RLAS bf16x8*)(lds + L::OFF_Q + (16 * it + r) * L::PK + (32 * s + 8 * g) * 2);
                    acc = __builtin_amdgcn_mfma_f32_16x16x32_bf16(kf, qf, acc, 0, 0, 0);
                }
            }
            const int i = 16 * it + r, j = 16 * jt + 4 * g;
            u32x2 w; w.x = pkbf(j <= i ? acc[0] : 0.f, j + 1 <= i ? acc[1] : 0.f); w.y = pkbf(j + 2 <= i ? acc[2] : 0.f, j + 3 <= i ? acc[3] : 0.f);
            *(RLAS u32x2*)(lds + L::OFF_P + i * L::PP + j * 2) = w;
        }
#pragma unroll
        for (int m = 0; m < 4; ++m) O[m] = (f32x4){0.f, 0.f, 0.f, 0.f};
#pragma unroll
        for (int s = 0; s < L::NKS; ++s) {
            const f32x4 ea = *(RLAS f32x4*)(lds + L::OFF_E + (32 * s + 4 * g) * 4), eb = *(RLAS f32x4*)(lds + L::OFF_E + (32 * s + 16 + 4 * g) * 4);
            const f32x4 sa = S[2 * s] * ea, sb = S[2 * s + 1] * eb;
            u32x4 sp; sp.x = pkbf(sa[0], sa[1]); sp.y = pkbf(sa[2], sa[3]); sp.z = pkbf(sb[0], sb[1]); sp.w = pkbf(sb[2], sb[3]);
            const bf16x8 sf = __builtin_bit_cast(bf16x8, sp);
#pragma unroll
            for (int m = 0; m < 4; ++m) {
                const s16x4 qlo = *(RLAS s16x4*)(lds + L::OFF_Q + (16 * m + r) * L::PK + (32 * s + 4 * g) * 2), qhi = *(RLAS s16x4*)(lds + L::OFF_Q + (16 * m + r) * L::PK + (32 * s + 16 + 4 * g) * 2);
                const bf16x8 qf = __builtin_shufflevector(qlo, qhi, 0, 1, 2, 3, 4, 5, 6, 7);
                O[m] = __builtin_amdgcn_mfma_f32_16x16x32_bf16(qf, sf, O[m], 0, 0, 0);
            }
        }
        __syncthreads();
    }
    const bf16x8 vf0 = tr_frag(lds + L::OFF_V, L::PV, 0, e0, lane), vf1 = tr_frag(lds + L::OFF_V, L::PV, 32, e0, lane);
    if (DO_OUT) {
#pragma unroll
        for (int m = 0; m < 4; ++m) {
            const bf16x8 p0 = *(RLAS bf16x8*)(lds + L::OFF_P + (16 * m + r) * L::PP + (8 * g) * 2), p1 = *(RLAS bf16x8*)(lds + L::OFF_P + (16 * m + r) * L::PP + (32 + 8 * g) * 2);
            O[m] = __builtin_amdgcn_mfma_f32_16x16x32_bf16(p0, vf0, O[m], 0, 0, 0);
            O[m] = __builtin_amdgcn_mfma_f32_16x16x32_bf16(p1, vf1, O[m], 0, 0, 0);
        }
    }
#pragma unroll
    for (int dt = 0; dt < L::NDT; ++dt) {
        const f32x4 dv = *(RLAS f32x4*)(lds + L::OFF_D + (16 * dt + 4 * g) * 4);
        const bf16x8 k0 = tr_frag(lds + L::OFF_KH, L::PK, 0, 16 * dt, lane), k1 = tr_frag(lds + L::OFF_KH, L::PK, 32, 16 * dt, lane);
        f32x4 acc = S[dt] * dv;
        acc = __builtin_amdgcn_mfma_f32_16x16x32_bf16(k0, vf0, acc, 0, 0, 0);
        acc = __builtin_amdgcn_mfma_f32_16x16x32_bf16(k1, vf1, acc, 0, 0, 0);
        S[dt] = acc;
    }
    if (DO_OUT) {
#pragma unroll
        for (int m = 0; m < 4; ++m)
#pragma unroll
            for (int ii = 0; ii < 4; ++ii) *(RLAS float*)(lds + L::OFF_O + (16 * m + 4 * g + ii) * L::PO + (e0 + r) * 4) = O[m][ii];
        __syncthreads();
        const int orow = tid >> 3, oc = (tid & 7) * 16;
        f32x4 ov[4]; float ss = 0.f;
#pragma unroll
        for (int c = 0; c < 4; ++c) { ov[c] = *(RLAS f32x4*)(lds + L::OFF_O + orow * L::PO + (oc + 4 * c) * 4); ss += (ov[c][0] * ov[c][0] + ov[c][1] * ov[c][1]) + (ov[c][2] * ov[c][2] + ov[c][3] * ov[c][3]); }
        ss += __shfl_xor(ss, 1); ss += __shfl_xor(ss, 2); ss += __shfl_xor(ss, 4);
        const float rs = rsqrtf(ss * (1.0f / 128.0f) + R_EPS);
        if (orow < tvalid) {
            const size_t row = row0 + orow; const u32x4* gp = (const u32x4*)(io.P + row * PWID + io.goff + oc); const u32x4 g0 = gp[0], g1 = gp[1];
            const unsigned gw[8] = {g0.x, g0.y, g0.z, g0.w, g1.x, g1.y, g1.z, g1.w};
            unsigned ow[8];
#pragma unroll
            for (int c = 0; c < 8; ++c) {
                const float ga = bflo(gw[c]), gb = bfhi(gw[c]);
                const float oa = ov[c >> 1][(c & 1) * 2] * rs * io.onorm[oc + 2 * c] * (ga * __builtin_amdgcn_rcpf(1.f + __expf(-ga)));
                const float ob = ov[c >> 1][(c & 1) * 2 + 1] * rs * io.onorm[oc + 2 * c + 1] * (gb * __builtin_amdgcn_rcpf(1.f + __expf(-gb)));
                ow[c] = pkbf(oa, ob);
            }
            u32x4* op = (u32x4*)(io.MIX + row * DM + io.ooff + oc);
            op[0] = (u32x4){ow[0], ow[1], ow[2], ow[3]}; op[1] = (u32x4){ow[4], ow[5], ow[6], ow[7]};
        }
    } else {
        __syncthreads();
    }
}

template <int NDT> __device__ __forceinline__ void load_state(f32x4 (&S)[NDT], const float* mem) {
    const int lane = threadIdx.x & 63, wave = threadIdx.x >> 6, r = lane & 15, g = lane >> 4;
#pragma unroll
    for (int dt = 0; dt < NDT; ++dt)
#pragma unroll
        for (int i = 0; i < 4; ++i) S[dt][i] = mem ? mem[(16 * dt + 4 * g + i) * 128 + 16 * wave + r] : 0.f;
}
template <int NDT> __device__ __forceinline__ void store_state(const f32x4 (&S)[NDT], float* mem) {
    const int lane = threadIdx.x & 63, wave = threadIdx.x >> 6, r = lane & 15, g = lane >> 4;
#pragma unroll
    for (int dt = 0; dt < NDT; ++dt)
#pragma unroll
        for (int i = 0; i < 4; ++i) mem[(16 * dt + 4 * g + i) * 128 + 16 * wave + r] = S[dt][i];
}

struct RecArgs {
    const bf16* P; const float* GA; bf16* MIX; const float* lbl; const float* gla_onorm; const float* hg_onorm;
    const float* st_gla_in; const float* st_hg_in; float* ST; float* DT; float* out_sgp; float* out_shp; float* out_sgs; float* out_shs;
};
constexpr int SC_TOK = 256, NCH = SC_TOK / 64, NSC = 8192 / SC_TOK, ST_PER = 4 * 64 * 128 + 4 * 128 * 128, DT_PER = 4 * 64 + 4 * 128;

template <int DK, bool HG> __device__ __forceinline__ HeadIo make_io(const RecArgs& a, int h) {
    HeadIo io; io.P = a.P; io.GA = a.GA; io.MIX = a.MIX;
    if (HG) { io.qoff = 1536 + h * 128; io.koff = 2048 + h * 128; io.voff = 2560 + h * 128; io.goff = 3072 + h * 128; io.ooff = 512 + h * 128; io.gaoff = 0; io.onorm = a.hg_onorm;
        const int d = 2 * ((int)threadIdx.x % (DK / 2)); const float l0 = a.lbl[h * 128 + d], l1 = a.lbl[512 + h * 128 + d], m0 = a.lbl[h * 128 + d + 1], m1 = a.lbl[512 + h * 128 + d + 1];
        io.lb0 = 1.0f / (1.0f + __expf(l1 - l0)); io.lb1 = 1.0f / (1.0f + __expf(m1 - m0)); }
    else { io.qoff = h * 64; io.koff = 256 + h * 64; io.voff = 512 + h * 128; io.goff = 1024 + h * 128; io.ooff = h * 128; io.gaoff = h * 64; io.onorm = a.gla_onorm; io.lb0 = 0.f; io.lb1 = 0.f; }
    return io;
}

template <int DK, bool HG> __device__ __forceinline__ void r1_unit(RLAS unsigned char* lds, const RecArgs& a, int seq, int sc, int h) {
    const HeadIo io = make_io<DK, HG>(a, h);
    f32x4 S[DK / 16]; load_state<DK / 16>(S, nullptr); float dtot = 1.f;
    for (int c = 0; c < NCH; ++c) chunk<DK, HG, false>(lds, io, (size_t)seq * 8192 + sc * SC_TOK + c * 64, 64, S, dtot);
    const size_t u = (size_t)seq * NSC + sc;
    store_state<DK / 16>(S, a.ST + u * ST_PER + (HG ? 32768 + h * 16384 : h * 8192));
    if ((int)threadIdx.x < DK) a.DT[u * DT_PER + (HG ? 256 + h * 128 : h * 64) + threadIdx.x] = dtot;
}
template <int DK, bool HG> __device__ __forceinline__ void r3_unit(RLAS unsigned char* lds, const RecArgs& a, int seq, int sc, int h) {
    const HeadIo io = make_io<DK, HG>(a, h);
    const size_t u = (size_t)seq * NSC + sc;
    f32x4 S[DK / 16]; load_state<DK / 16>(S, a.ST + u * ST_PER + (HG ? 32768 + h * 16384 : h * 8192)); float dtot = 1.f;
    for (int c = 0; c < NCH; ++c) chunk<DK, HG, true>(lds, io, (size_t)seq * 8192 + sc * SC_TOK + c * 64, 64, S, dtot);
    if (sc == NSC - 1) store_state<DK / 16>(S, (HG ? a.out_shp : a.out_sgp) + (size_t)(seq * 4 + h) * DK * 128);
}
template <int DK, bool HG> __device__ __forceinline__ void rs_unit(RLAS unsigned char* lds, const RecArgs& a, int seq, int h) {
    const HeadIo io = make_io<DK, HG>(a, h);
    f32x4 S[DK / 16]; load_state<DK / 16>(S, (HG ? a.st_hg_in : a.st_gla_in) + (size_t)(seq * 4 + h) * DK * 128); float dtot = 1.f;
    chunk<DK, HG, true>(lds, io, (size_t)32768 + seq * 32, 32, S, dtot);
    store_state<DK / 16>(S, (HG ? a.out_shs : a.out_sgs) + (size_t)(seq * 4 + h) * DK * 128);
}
__device__ __forceinline__ void decode_unit(int u, int& scidx, int& head) { scidx = u >> 3; head = ((u & 7) + 4 * ((u >> 8) & 1)) & 7; }

__device__ __forceinline__ void phase_r1(RLAS unsigned char* lds, const RecArgs& a, int G, int bx) {
    for (int u = bx; u < 4 * NSC * 8; u += G) { int scidx, head; decode_unit(u, scidx, head); const int seq = scidx / NSC, sc = scidx % NSC;
        if (sc == NSC - 1) continue;
        if (head < 4) r1_unit<64, false>(lds, a, seq, sc, head); else r1_unit<128, true>(lds, a, seq, sc, head - 4); }
}
__device__ __forceinline__ void phase_r2(const RecArgs& a, int gtid, int NGT) {
    for (int idx = gtid; idx < 4 * ST_PER; idx += NGT) {
        const int seq = idx / ST_PER, off = idx % ST_PER; int dti;
        if (off < 32768) dti = (off / 8192) * 64 + (off % 8192) / 128; else { const int o2 = off - 32768; dti = 256 + (o2 / 16384) * 128 + (o2 % 16384) / 128; }
        float x = 0.f;
        for (int s0 = 0; s0 < NSC; s0 += 8) {
            float tmp[8], dd[8];
#pragma unroll
            for (int j = 0; j < 8; ++j) { const size_t u = (size_t)seq * NSC + s0 + j; const bool has = (s0 + j) < NSC - 1; tmp[j] = has ? a.ST[u * ST_PER + off] : 0.f; dd[j] = has ? a.DT[u * DT_PER + dti] : 0.f; }
#pragma unroll
            for (int j = 0; j < 8; ++j) { const size_t u = (size_t)seq * NSC + s0 + j; a.ST[u * ST_PER + off] = x; x = dd[j] * x + tmp[j]; }
        }
    }
}
__device__ __forceinline__ void phase_r3(RLAS unsigned char* lds, const RecArgs& a, int G, int bx) {
    for (int u = bx; u < 4 * NSC * 8; u += G) { int scidx, head; decode_unit(u, scidx, head); const int seq = scidx / NSC, sc = scidx % NSC;
        if (head < 4) r3_unit<64, false>(lds, a, seq, sc, head); else r3_unit<128, true>(lds, a, seq, sc, head - 4); }
    for (int u = bx; u < 64; u += G) { const int seq = u >> 3, head = u & 7;
        if (head < 4) rs_unit<64, false>(lds, a, seq, head); else rs_unit<128, true>(lds, a, seq, head - 4); }
}
}
#define GAS __attribute__((address_space(1)))
#define LAS __attribute__((address_space(3)))
typedef unsigned short bf16;
typedef unsigned v4u __attribute__((ext_vector_type(4)));
typedef float f32x4 __attribute__((ext_vector_type(4)));
constexpr int NWAVES = 8;
constexpr int D = 1024, FF = 2816, MP = 32768, MS = 256, M = MP + MS, PW = 3584, NIN = 3840, DINSRC = 3600;
constexpr float EPS = 1e-6f;
constexpr size_t MiB = 1u << 20;
constexpr size_t WS_SSQ = 0, SSQ_STRIDE = (size_t)M * 4;
constexpr size_t WS_WGU1 = 1 * MiB, WS_WD1 = 12 * MiB, WS_WIN = 18 * MiB, WS_WO = 26 * MiB, WS_WGU2 = 28 * MiB, WS_WD2 = 39 * MiB;
constexpr size_t WS_XB = 45 * MiB, WS_MIX = 110 * MiB, WS_P = 175 * MiB, WS_HID = WS_P, WS_GA = 401 * MiB, WS_ST = 434 * MiB, WS_DT = 483 * MiB, WS_END = 512 * MiB;
static_assert(WS_P + (size_t)M * PW * 2 <= WS_GA && WS_GA + (size_t)M * 256 * 4 <= WS_ST && WS_XB + (size_t)M * D * 2 <= WS_MIX && WS_MIX + (size_t)M * D * 2 <= WS_P, "ws map");
constexpr size_t O_Y = 0, O_SGP = (size_t)M * D, O_SHP = O_SGP + 4 * 4 * 64 * 128, O_SGS = O_SHP + 4 * 4 * 128 * 128, O_SHS = O_SGS + 8 * 4 * 64 * 128, O_END = O_SHS + 8 * 4 * 128 * 128;
constexpr int LDS_BYTES = 147456;

__device__ __forceinline__ unsigned f2bf(float f) { unsigned u = __builtin_bit_cast(unsigned, f); return (u + 0x7fffu + ((u >> 16) & 1u)) >> 16; }
__device__ __forceinline__ unsigned pk2(float lo, float hi) { return f2bf(lo) | (f2bf(hi) << 16); }
__device__ __forceinline__ float bf2f(bf16 b) { return __builtin_bit_cast(float, (unsigned)b << 16); }
#define LDS_WAIT() asm volatile("s_waitcnt lgkmcnt(0)" ::: "memory")

#ifndef DUPMASK
#define DUPMASK 0
#endif
struct Args { const float* in[21]; float* out; unsigned char* ws; int ph_lo, ph_hi, dup, pad; };

__device__ __forceinline__ float wave_sum(float v) {
#pragma unroll
    for (int o = 1; o < 64; o <<= 1) v += __shfl_xor(v, o);
    return v;
}
__device__ __forceinline__ void tr_item(const float* W, int ldw, int src_col0, int k0, const float* gain, bf16* WT, int K, int dst_row0, LAS float* scr, int lane) {
    float w[32];
    const float* wp = W + (size_t)(k0 + (lane >> 5)) * ldw + src_col0 + (lane & 31);
#pragma unroll
    for (int i = 0; i < 32; ++i) w[i] = __builtin_nontemporal_load(wp + (size_t)(2 * i) * ldw);
    if (gain) {
#pragma unroll
        for (int i = 0; i < 32; ++i) w[i] *= gain[k0 + 2 * i + (lane >> 5)];
    }
#pragma unroll
    for (int i = 0; i < 32; ++i) scr[(2 * i + (lane >> 5)) * 33 + (lane & 31)] = w[i];
    LDS_WAIT(); asm volatile("" ::: "memory");
    const int c = lane & 7;
#pragma unroll
    for (int j = 0; j < 4; ++j) { const int n = (lane >> 3) + 8 * j; const LAS float* s = scr + (8 * c) * 33 + n;
        v4u o; o.x = pk2(s[0 * 33], s[1 * 33]); o.y = pk2(s[2 * 33], s[3 * 33]); o.z = pk2(s[4 * 33], s[5 * 33]); o.w = pk2(s[6 * 33], s[7 * 33]);
        *(v4u*)(WT + (size_t)(dst_row0 + n) * K + k0 + 8 * c) = o; }
    LDS_WAIT(); asm volatile("" ::: "memory");
}
__device__ __forceinline__ void weff_item(const float* Win, const float* up, int n0, int k0, const float* gain, bf16* WT, LAS float* scr, int lane) {
    float upr[16];
#pragma unroll
    for (int r = 0; r < 16; ++r) upr[r] = up[r * 256 + n0 + (lane & 31)];
#pragma unroll 4
    for (int i = 0; i < 32; ++i) { const int kk = 2 * i + (lane >> 5); const float* wr = Win + (size_t)(k0 + kk) * DINSRC + 1536; float s = 0.f;
#pragma unroll
        for (int r = 0; r < 16; ++r) s += wr[r] * upr[r];
        scr[kk * 33 + (lane & 31)] = s * gain[k0 + kk]; }
    LDS_WAIT(); asm volatile("" ::: "memory");
    const int c = lane & 7;
#pragma unroll
    for (int j = 0; j < 4; ++j) { const int n = (lane >> 3) + 8 * j; const LAS float* s = scr + (8 * c) * 33 + n;
        v4u o; o.x = pk2(s[0 * 33], s[1 * 33]); o.y = pk2(s[2 * 33], s[3 * 33]); o.z = pk2(s[4 * 33], s[5 * 33]); o.w = pk2(s[6 * 33], s[7 * 33]);
        *(v4u*)(WT + (size_t)(3584 + n0 + n) * 1024 + k0 + 8 * c) = o; }
    LDS_WAIT(); asm volatile("" ::: "memory");
}
__device__ __forceinline__ void gu_item(int r, const float* wg, const float* wu, const float* gain, bf16* WT, LAS float* scr, int lane) {
    const int kb = r / 176, nb = r % 176, dst = 32 * nb, tile = dst >> 8, j = dst & 255;
    const float* W = (j < 128) ? wg : wu; const int src = tile * 128 + (j & 127);
    tr_item(W, FF, src, 64 * kb, gain, WT, D, dst, scr, lane);
}

__device__ __forceinline__ int opaque_tid() { int t = threadIdx.x; asm volatile("" : "+v"(t)); return t; }
__device__ __forceinline__ void p0_prologue(const Args& a, LAS unsigned char* lds, int G, int bx) {
    const int tid = opaque_tid(), lane = tid & 63, wave = __builtin_amdgcn_readfirstlane(tid >> 6);
    const int gw = bx * NWAVES + wave, NGW = G * NWAVES, gtid = bx * (NWAVES * 64) + tid, NGT = G * NWAVES * 64;
    LAS float* scr = (LAS float*)(lds + wave * 16384);
    unsigned char* ws = a.ws;
    constexpr int I_GU = 16 * 176, I_D = 44 * 32, I_IN = 16 * 112, I_EFF = 16 * 8, I_O = 16 * 32;
    constexpr int NITEMS = 2 * I_GU + 2 * I_D + I_IN + I_EFF + I_O;
    for (int it = gw; it < NITEMS; it += NGW) {
        int r = it; asm volatile("" : "+s"(ws));
        if (r < I_GU) { gu_item(r, a.in[5], a.in[6], a.in[4], (bf16*)(ws + WS_WGU1), scr, lane); continue; } r -= I_GU;
        if (r < I_D) { tr_item(a.in[7], D, 32 * (r % 32), 64 * (r / 32), nullptr, (bf16*)(ws + WS_WD1), FF, 32 * (r % 32), scr, lane); continue; } r -= I_D;
        if (r < I_IN) { const int kb = r / 112, nb = r % 112, dst = 32 * nb, src = dst < 1536 ? dst : dst + 16;
            tr_item(a.in[9], DINSRC, src, 64 * kb, a.in[8], (bf16*)(ws + WS_WIN), D, dst, scr, lane); continue; } r -= I_IN;
        if (r < I_EFF) { weff_item(a.in[9], a.in[10], 32 * (r % 8), 64 * (r / 8), a.in[8], (bf16*)(ws + WS_WIN), scr, lane); continue; } r -= I_EFF;
        if (r < I_O) { tr_item(a.in[15], D, 32 * (r % 32), 64 * (r / 32), nullptr, (bf16*)(ws + WS_WO), D, 32 * (r % 32), scr, lane); continue; } r -= I_O;
        if (r < I_GU) { gu_item(r, a.in[17], a.in[18], a.in[16], (bf16*)(ws + WS_WGU2), scr, lane); continue; } r -= I_GU;
        tr_item(a.in[19], D, 32 * (r % 32), 64 * (r / 32), nullptr, (bf16*)(ws + WS_WD2), FF, 32 * (r % 32), scr, lane);
    }
    float* ssq1 = (float*)(ws + WS_SSQ); bf16* XB = (bf16*)(ws + WS_XB);
    for (int m0 = 2 * gw; m0 < M; m0 += 2 * NGW) {
        f32x4 v[2][4]; float s[2];
#pragma unroll
        for (int h = 0; h < 2; ++h) { const int m = m0 + h;
            const float* xrow = (m < MP) ? a.in[0] + (size_t)m * D : a.in[1] + (size_t)(m - MP) * D;
            const f32x4* xr = (const f32x4*)xrow + lane;
#pragma unroll
            for (int j = 0; j < 4; ++j) v[h][j] = __builtin_nontemporal_load(xr + 64 * j); }
#pragma unroll
        for (int h = 0; h < 2; ++h) { const int m = m0 + h; float ss = 0.f;
#pragma unroll
            for (int j = 0; j < 4; ++j) ss += (v[h][j].x * v[h][j].x + v[h][j].y * v[h][j].y) + (v[h][j].z * v[h][j].z + v[h][j].w * v[h][j].w);
            s[h] = wave_sum(ss);
            unsigned long long* o8 = (unsigned long long*)(XB + (size_t)m * D) + lane;
#pragma unroll
            for (int j = 0; j < 4; ++j) o8[64 * j] = (unsigned long long)pk2(v[h][j].x, v[h][j].y) | ((unsigned long long)pk2(v[h][j].z, v[h][j].w) << 32);
            if (lane == 0) ssq1[m] = s[h]; }
    }
    for (int i = gtid; i < 3 * M; i += NGT) ssq1[M + i] = 0.f;
}

__device__ __forceinline__ void p8_final(const Args& a, int G, int bx) {
    const int tid = opaque_tid(), lane = tid & 63, wave = __builtin_amdgcn_readfirstlane(tid >> 6);
    const int gw = bx * NWAVES + wave, NGW = G * NWAVES;
    const float* ssq4 = (const float*)(a.ws + WS_SSQ) + 3 * (size_t)M; const f32x4* g = (const f32x4*)a.in[20] + lane;
    f32x4 gv[4];
#pragma unroll
    for (int j = 0; j < 4; ++j) gv[j] = g[64 * j];
    for (int m = gw; m < M; m += NGW) {
        f32x4* xr = (f32x4*)(a.out + (size_t)m * D) + lane; const float rs = rsqrtf(ssq4[m] * (1.0f / 1024.0f) + EPS);
#pragma unroll
        for (int j = 0; j < 4; ++j) xr[64 * j] = xr[64 * j] * rs * gv[j];
    }
}

__global__ void __launch_bounds__(NWAVES * 64, 2) mega_fwd(Args args) {
    extern __shared__ __attribute__((aligned(16))) unsigned char lds_raw[];
    cg::grid_group grid = cg::this_grid();
    LAS unsigned char* lds = (LAS unsigned char*)lds_raw;
    const int G = gridDim.x, bx = blockIdx.x;
    unsigned char* ws = args.ws;
    float* ssq = (float*)(ws + WS_SSQ);
    const int lo = args.ph_lo, hi = args.ph_hi;
#define IN(k) (lo <= (k) && (k) < hi)
#define BOTH(k) (IN(k) && IN((k) + 1))
#define GRID_BAR() grid.sync()
#define REP(k) for (int rep_ = ((args.dup >> (k)) & 1); rep_ >= 0; --rep_)

    if (IN(0)) REP(0) { p0_prologue(args, lds, G, bx); if (BOTH(0)) GRID_BAR(); }
    if (IN(1)) REP(1) {
        pg8::Gemm g{(const bf16*)(ws + WS_XB), (const bf16*)(ws + WS_WGU1), M, 2 * FF, D}; pg8::StaticOrder S; S.init(M, 2 * FF, G, bx);
        pg8::EpiUp E{(bf16*)(ws + WS_HID), FF, ssq};
        pg8::gemm_phase<pg8::EpiUp, pg8::StaticOrder, true, true>(lds, g, S, E);
        if (BOTH(1)) GRID_BAR();
    }
    if (IN(2)) {
        pg8::Gemm g{(const bf16*)(ws + WS_HID), (const bf16*)(ws + WS_WD1), M, D, FF}; pg8::StaticOrder S; S.init(M, D, G, bx);
        pg8::EpiRes E{args.in[0], args.in[1], MP / 256, args.out, (bf16*)(ws + WS_XB), ssq + M, 0.5f};
        pg8::gemm_phase<pg8::EpiRes, pg8::StaticOrder, true, true>(lds, g, S, E);
        if (BOTH(2)) GRID_BAR();
    }
    if (IN(3)) REP(3) {
        pg8::Gemm g{(const bf16*)(ws + WS_XB), (const bf16*)(ws + WS_WIN), M, NIN, D}; pg8::StaticOrder S; S.init(M, NIN, G, bx);
        pg8::EpiWin E{(bf16*)(ws + WS_P), (float*)(ws + WS_GA), ssq + M, args.in[11]};
        pg8::gemm_phase<pg8::EpiWin, pg8::StaticOrder, true, true>(lds, g, S, E);
        if (BOTH(3)) GRID_BAR();
    }
    {
        rec::RecArgs ra{(const bf16*)(ws + WS_P), (const float*)(ws + WS_GA), (bf16*)(ws + WS_MIX), args.in[13], args.in[12], args.in[14], args.in[2], args.in[3],
                        (float*)(ws + WS_ST), (float*)(ws + WS_DT), args.out + O_SGP, args.out + O_SHP, args.out + O_SGS, args.out + O_SHS};
        if (IN(4)) REP(4) { rec::phase_r1(lds, ra, G, bx); if (BOTH(4)) GRID_BAR(); }
        if (IN(5)) { rec::phase_r2(ra, bx * (NWAVES * 64) + opaque_tid(), G * NWAVES * 64); if (BOTH(5)) GRID_BAR(); }
        if (IN(6)) REP(6) { rec::phase_r3(lds, ra, G, bx); if (BOTH(6)) GRID_BAR(); }
    }
    if (IN(7)) {
        pg8::Gemm g{(const bf16*)(ws + WS_MIX), (const bf16*)(ws + WS_WO), M, D, D}; pg8::StaticOrder S; S.init(M, D, G, bx);
        pg8::EpiRes E{args.out, args.out, 1 << 30, args.out, (bf16*)(ws + WS_XB), ssq + 2 * M, 1.0f};
        pg8::gemm_phase<pg8::EpiRes, pg8::StaticOrder, true, true>(lds, g, S, E);
        if (BOTH(7)) GRID_BAR();
    }
    if (IN(8)) REP(8) {
        pg8::Gemm g{(const bf16*)(ws + WS_XB), (const bf16*)(ws + WS_WGU2), M, 2 * FF, D}; pg8::StaticOrder S; S.init(M, 2 * FF, G, bx);
        pg8::EpiUp E{(bf16*)(ws + WS_HID), FF, ssq + 2 * M};
        pg8::gemm_phase<pg8::EpiUp, pg8::StaticOrder, true, true>(lds, g, S, E);
        if (BOTH(8)) GRID_BAR();
    }
    if (IN(9)) {
        pg8::Gemm g{(const bf16*)(ws + WS_HID), (const bf16*)(ws + WS_WD2), M, D, FF}; pg8::StaticOrder S; S.init(M, D, G, bx);
        pg8::EpiRes E{args.out, args.out, 1 << 30, args.out, nullptr, ssq + 3 * M, 0.5f};
        pg8::gemm_phase<pg8::EpiRes, pg8::StaticOrder, true, true>(lds, g, S, E);
        if (BOTH(9)) GRID_BAR();
    }
    if (IN(10)) p8_final(args, G, bx);
#undef IN
#undef BOTH
}

extern "C" void kernel_launch(void* const* d_in, const int* in_sizes, int n_in, void* d_out, int out_size, void* d_ws, size_t ws_size, hipStream_t stream) {
    static int grid = 0;
    if (grid == 0) {
        if (n_in != 21 || out_size != (int)O_END || ws_size < WS_END) { fprintf(stderr, "kernel_launch: unexpected sizes n_in %d out %d ws %zu\n", n_in, out_size, ws_size); grid = -1; return; }
        int dev = 0, cus = 0, per_cu = 0;
        (void)hipGetDevice(&dev); (void)hipDeviceGetAttribute(&cus, hipDeviceAttributeMultiprocessorCount, dev);
        if (hipFuncSetAttribute((const void*)mega_fwd, hipFuncAttributeMaxDynamicSharedMemorySize, LDS_BYTES) != hipSuccess) { fprintf(stderr, "hipFuncSetAttribute failed\n"); grid = -1; return; }
        if (hipOccupancyMaxActiveBlocksPerMultiprocessor(&per_cu, (const void*)mega_fwd, NWAVES * 64, LDS_BYTES) != hipSuccess || per_cu < 1) { fprintf(stderr, "occupancy query: %d\n", per_cu); per_cu = 1; }
        (void)hipGetLastError();
        grid = cus * per_cu;
    }
    if (grid < 0) return;
    Args a{};
    for (int i = 0; i < 21; ++i) a.in[i] = (const float*)d_in[i];
    a.out = (float*)d_out; a.ws = (unsigned char*)d_ws;
    a.ph_lo = 0; a.ph_hi = 11; a.dup = DUPMASK;
    void* kargs[] = {&a};
    hipError_t e = hipLaunchCooperativeKernel((const void*)mega_fwd, dim3(grid), dim3(NWAVES * 64), kargs, LDS_BYTES, stream);
    if (e != hipSuccess) fprintf(stderr, "cooperative launch failed: %s (grid %d)\n", hipGetErrorString(e), grid);
}
```

```cpp
#include <hip/hip_runtime.h>
#include <hip/hip_cooperative_groups.h>
#include <cstdio>
#include <cstdint>
namespace cg = cooperative_groups;
namespace pg8 {
#define PG8_LAS __attribute__((address_space(3)))
typedef unsigned short bf16_t;
typedef short bf16x8 __attribute__((ext_vector_type(8)));
typedef float f32x4 __attribute__((ext_vector_type(4)));
typedef unsigned u32x4 __attribute__((ext_vector_type(4)));
constexpr int BM = 256, BK = 64, HALF = 128, HTB = HALF * BK * 2  , STAGE_BYTES = 8 * HTB, NXCD = 8, WGM = 8;

__host__ __device__ __forceinline__ int lds_byte(int r, int c) { const int st = (r >> 4) * 2 + (c >> 5), rr = r & 15, cc = c & 31, ob = rr * 64 + cc * 2; return st * 1024 + (ob ^ (((ob >> 9) & 1) << 5)); }
__host__ __device__ __forceinline__ void stage_rc(int b, int& R, int& C) { const int st = b / 1024, sb = b % 1024, swz = sb ^ (((sb >> 9) & 1) << 5); R = (st >> 1) * 16 + swz / 64; C = (st & 1) * 32 + (swz % 64) / 2; }
__host__ __device__ __forceinline__ int perm32(int rho) { const int n = rho >> 4, i = rho & 15; return 8 * (i >> 2) + 4 * n + (i & 3); }

struct Unit { int pm, pn; };
struct Gemm { const bf16_t* A; const bf16_t* Bt; int M, N, K; };

struct StaticOrder {
    int nM, nN, nwg, G, c;
    __host__ __device__ void init(int M, int N, int G_, int c_) { nM = M / BM; nN = N / BM; nwg = nM * nN; G = G_; c = c_; }
    __host__ __device__ bool next(int i, Unit& u) const {
        const long L = (long)i * G + c; if (L >= nwg) return false;
        int wgid = (int)L; { const int q = nwg / NXCD, r = nwg % NXCD, xcd = wgid % NXCD, off = wgid / NXCD; wgid = (xcd < r ? xcd * (q + 1) : r * (q + 1) + (xcd - r) * q) + off; }
        const int nig = WGM * nN, gid = wgid / nig, fm = gid * WGM, gsz = (nM - fm) < WGM ? (nM - fm) : WGM;
        u.pm = fm + ((wgid % nig) % gsz); u.pn = (wgid % nig) / gsz; return true;
    }
    __device__ __forceinline__ void a_ready(const Unit&) const {}
    __device__ __forceinline__ void done(const Unit&) const {}
};

__device__ __forceinline__ unsigned cvt_pk_bf16(float lo, float hi) { unsigned r; asm volatile("v_cvt_pk_bf16_f32 %0, %1, %2" : "=v"(r) : "v"(lo), "v"(hi)); return r; }
typedef float f32x2 __attribute__((ext_vector_type(2)));
constexpr float RMS_EPS = 1e-6f;
__device__ __forceinline__ float silu_f(float g) { return g * __builtin_amdgcn_rcpf(1.0f + __expf(-g)); }
__device__ __forceinline__ float rstd_of(const float* ssq, int row) { return rsqrtf(ssq[row] * (1.0f / 1024.0f) + RMS_EPS); }

struct EpiUp {
    static constexpr bool PERM = true, AFTER_DRAIN = false;
    bf16_t* H; int ldh; const float* ssq;
    __device__ __forceinline__ void operator()(const f32x4 (&acc)[2][2][4][2], const Unit& u, int wr, int wc, int fr, int fq) const {
        const int row0 = u.pm * BM + wr * 64 + fr, hcol0 = u.pn * HALF + wc * 32 + 8 * fq;
#pragma unroll
        for (int ai = 0; ai < 2; ++ai)
#pragma unroll
            for (int m = 0; m < 4; ++m) {
                const int row = row0 + ai * HALF + m * 16; const float rs = rstd_of(ssq, row);
                float h[8];
#pragma unroll
                for (int n = 0; n < 2; ++n)
#pragma unroll
                    for (int i = 0; i < 4; ++i) { const float g = acc[ai][0][m][n][i] * rs, uu = acc[ai][1][m][n][i] * rs; h[4 * n + i] = silu_f(g) * uu; }
                u32x4 w; w.x = cvt_pk_bf16(h[0], h[1]); w.y = cvt_pk_bf16(h[2], h[3]); w.z = cvt_pk_bf16(h[4], h[5]); w.w = cvt_pk_bf16(h[6], h[7]);
                *(u32x4*)(H + (size_t)row * ldh + hcol0) = w;
            }
    }
};

struct EpiRes {
    static constexpr bool PERM = true, AFTER_DRAIN = false;
    const float* xf0; const float* xf1; int split_pm;
    bf16_t* xb; float* ssq; float scale;
    __device__ __forceinline__ void operator()(const f32x4 (&acc)[2][2][4][2], const Unit& u, int wr, int wc, int fr, int fq) const {
        const int row0 = u.pm * BM + wr * 64 + fr, col0 = u.pn * BM + wc * 32 + 8 * fq;
        const float* xin = xf0 ? ((u.pm < split_pm) ? xf0 : (xf1 - (size_t)split_pm * BM * 1024)) : nullptr;
#pragma unroll
        for (int ai = 0; ai < 2; ++ai)
#pragma unroll
            for (int m = 0; m < 4; ++m) {
                const int row = row0 + ai * HALF + m * 16; const size_t off = (size_t)row * 1024 + col0; float s = 0.f;
#pragma unroll
                for (int bj = 0; bj < 2; ++bj) {
                    f32x4 r0, r1;
                    if (xin) { r0 = *(const f32x4*)(xin + off + bj * HALF); r1 = *(const f32x4*)(xin + off + bj * HALF + 4); }
                    else { const u32x4 rb = *(const u32x4*)(xb + off + bj * HALF);
                        r0 = (f32x4){__builtin_bit_cast(float, rb.x << 16), __builtin_bit_cast(float, rb.x & 0xffff0000u), __builtin_bit_cast(float, rb.y << 16), __builtin_bit_cast(float, rb.y & 0xffff0000u)};
                        r1 = (f32x4){__builtin_bit_cast(float, rb.z << 16), __builtin_bit_cast(float, rb.z & 0xffff0000u), __builtin_bit_cast(float, rb.w << 16), __builtin_bit_cast(float, rb.w & 0xffff0000u)}; }
                    const f32x4 v0 = r0 + acc[ai][bj][m][0] * scale, v1 = r1 + acc[ai][bj][m][1] * scale;
                    s += ((v0[0] * v0[0] + v0[1] * v0[1]) + (v0[2] * v0[2] + v0[3] * v0[3])) + ((v1[0] * v1[0] + v1[1] * v1[1]) + (v1[2] * v1[2] + v1[3] * v1[3]));
                    u32x4 w; w.x = cvt_pk_bf16(v0[0], v0[1]); w.y = cvt_pk_bf16(v0[2], v0[3]); w.z = cvt_pk_bf16(v1[0], v1[1]); w.w = cvt_pk_bf16(v1[2], v1[3]);
                    *(u32x4*)(xb + off + bj * HALF) = w;
                }
                s += __shfl_xor(s, 16); s += __shfl_xor(s, 32);
                if (fq == 0) __hip_atomic_fetch_add(ssq + row, s, __ATOMIC_RELAXED, __HIP_MEMORY_SCOPE_AGENT);
            }
    }
};

struct EpiWin {
    static constexpr bool PERM = true, AFTER_DRAIN = false;
    bf16_t* P; float* GA; const float* ssq; const float* gbias;
    __device__ __forceinline__ void operator()(const f32x4 (&acc)[2][2][4][2], const Unit& u, int wr, int wc, int fr, int fq) const {
        const int row0 = u.pm * BM + wr * 64 + fr, c0 = wc * 32 + 8 * fq, pn = u.pn;
#pragma unroll
        for (int ai = 0; ai < 2; ++ai)
#pragma unroll
            for (int m = 0; m < 4; ++m) {
                const int row = row0 + ai * HALF + m * 16; const float rs = rstd_of(ssq, row);
#pragma unroll
                for (int bj = 0; bj < 2; ++bj) {
                    float v[8];
#pragma unroll
                    for (int n = 0; n < 2; ++n)
#pragma unroll
                        for (int i = 0; i < 4; ++i) v[4 * n + i] = acc[ai][bj][m][n][i] * rs;
                    const int tc = bj * HALF + c0;
                    if (pn == 14) {
                        f32x4 o0, o1;
#pragma unroll
                        for (int i = 0; i < 8; ++i) { const float x = v[i] + gbias[tc + i]; const float ls = fminf(x, 0.f) - __logf(1.0f + __expf(-fabsf(x))); const float av = __expf(ls * 0.0625f); if (i < 4) o0[i] = av; else o1[i - 4] = av; }
                        *(f32x4*)(GA + (size_t)row * 256 + tc) = o0; *(f32x4*)(GA + (size_t)row * 256 + tc + 4) = o1;
                    } else {
                        if (pn == 0) {
#pragma unroll
                            for (int i = 0; i < 8; ++i) v[i] *= 0.125f;
                        } else if (pn == 6 || pn == 7) {
#pragma unroll
                            for (int i = 0; i < 8; ++i) v[i] = silu_f(v[i]);
                        }
                        u32x4 w; w.x = cvt_pk_bf16(v[0], v[1]); w.y = cvt_pk_bf16(v[2], v[3]); w.z = cvt_pk_bf16(v[4], v[5]); w.w = cvt_pk_bf16(v[6], v[7]);
                        *(u32x4*)(P + (size_t)row * 3584 + pn * BM + tc) = w;
                    }
                }
            }
    }
};
template <class Epi, class Sched, bool ALIGN_EPI = false, bool SP2 = false>
__device__ __forceinline__ void gemm_phase(PG8_LAS unsigned char* lds, const Gemm g, const Sched& S, const Epi& E) {
    const int tid = threadIdx.x, wid = __builtin_amdgcn_readfirstlane(tid >> 6), lane = tid & 63, wr = wid >> 2, wc = wid & 3, fr = lane & 15, fq = lane >> 4;
    const int K = g.K, nt = K / BK;
    unsigned voffA[2], voffB[2];
#pragma unroll
    for (int i = 0; i < 2; ++i) { int R, C; stage_rc(tid * 16 + i * 8192, R, C); const int Rb = Epi::PERM ? ((R & ~31) + perm32(R & 31)) : R;
        voffA[i] = (unsigned)(R * K + C) * 2u; voffB[i] = (unsigned)(Rb * K + C) * 2u; }
    const size_t kstep = (size_t)(BK * 2);
    const size_t hstep = (size_t)HALF * K * 2;
    const size_t tstep = 2 * hstep;
    const unsigned ldsw = (unsigned)wid * 1024u;
    const int aoff = lds_byte(wr * 64 + fr, fq * 8), boff = lds_byte(wc * 32 + fr, fq * 8);
#define PG8_SA(b, h) (((b) * 2 + (h)) * HTB)
#define PG8_SB(b, h) ((4 + (b) * 2 + (h)) * HTB)
#define PG8_STAGE(bufoff, gbase, voff) do { _Pragma("unroll") for (int _i = 0; _i < 2; ++_i) \
        __builtin_amdgcn_global_load_lds((const unsigned*)((const char*)(gbase) + (voff)[_i]), (PG8_LAS unsigned*)(lds + (bufoff) + ldsw + _i * 8192), 16, 0, 0); } while (0)
#define PG8_LDA(dst, b, h) do { _Pragma("unroll") for (int m = 0; m < 4; ++m) _Pragma("unroll") for (int k = 0; k < 2; ++k) dst[m][k] = *(const PG8_LAS bf16x8*)(lds + PG8_SA(b, h) + aoff + m * 2048 + k * 1024); } while (0)
#define PG8_LDB(dst, b, h) do { _Pragma("unroll") for (int n = 0; n < 2; ++n) _Pragma("unroll") for (int k = 0; k < 2; ++k) dst[n][k] = *(const PG8_LAS bf16x8*)(lds + PG8_SB(b, h) + boff + n * 2048 + k * 1024); } while (0)
#define PG8_MMA(ai, bj, At, Bt) do { __builtin_amdgcn_s_setprio(1); _Pragma("unroll") for (int m = 0; m < 4; ++m) _Pragma("unroll") for (int n = 0; n < 2; ++n) _Pragma("unroll") for (int k = 0; k < 2; ++k) \
        acc[ai][bj][m][n] = __builtin_amdgcn_mfma_f32_16x16x32_bf16(Bt[n][k], At[m][k], acc[ai][bj][m][n], 0, 0, 0); __builtin_amdgcn_s_setprio(0); } while (0)
#define PG8_WAIT_V(n) asm volatile("s_waitcnt vmcnt(" #n ")" ::: "memory")
#define PG8_WAIT_L(n) asm volatile("s_waitcnt lgkmcnt(" #n ")" ::: "memory")
#define PG8_BAR __builtin_amdgcn_s_barrier()
#define PG8_SCHED __builtin_amdgcn_sched_barrier(0)
    Unit cur, nxt; int ui = 0;
    if (!S.next(0, cur)) return;
    f32x4 acc[2][2][4][2];
#pragma unroll
    for (int a = 0; a < 2; ++a)
#pragma unroll
        for (int b = 0; b < 2; ++b)
#pragma unroll
            for (int m = 0; m < 4; ++m)
#pragma unroll
                for (int n = 0; n < 2; ++n) acc[a][b][m][n] = (f32x4){0.f, 0.f, 0.f, 0.f};
    bf16x8 At[4][2], B0[2][2], B1[2][2];
    const char* cA = (const char*)g.A + (size_t)cur.pm * tstep; const char* cB = (const char*)g.Bt + (size_t)cur.pn * tstep;
    S.a_ready(cur);
    if constexpr (SP2) {
        PG8_STAGE(PG8_SB(0, 0), cB, voffB); PG8_STAGE(PG8_SB(0, 1), cB + hstep, voffB); PG8_STAGE(PG8_SA(0, 0), cA, voffA); PG8_STAGE(PG8_SA(0, 1), cA + hstep, voffA);
        if (wr == 1) PG8_BAR;
        PG8_WAIT_V(2); PG8_BAR;
        PG8_STAGE(PG8_SB(1, 0), cB + kstep, voffB); PG8_STAGE(PG8_SA(1, 0), cA + kstep, voffA); PG8_STAGE(PG8_SB(1, 1), cB + hstep + kstep, voffB);
        PG8_WAIT_V(6); PG8_BAR;
    } else {
        PG8_STAGE(PG8_SB(0, 0), cB, voffB); PG8_STAGE(PG8_SA(0, 0), cA, voffA); PG8_STAGE(PG8_SB(0, 1), cB + hstep, voffB); PG8_STAGE(PG8_SA(0, 1), cA + hstep, voffA);
        if (wr == 1) PG8_BAR;
        PG8_WAIT_V(4); PG8_BAR;
        PG8_STAGE(PG8_SB(1, 0), cB + kstep, voffB); PG8_STAGE(PG8_SA(1, 0), cA + kstep, voffA); PG8_STAGE(PG8_SB(1, 1), cB + hstep + kstep, voffB);
        PG8_WAIT_V(6); PG8_BAR;
    }
    for (;;) {
        const bool has_next = S.next(ui + 1, nxt);
        const char* nA = has_next ? (const char*)g.A + (size_t)nxt.pm * tstep : cA; const char* nB = has_next ? (const char*)g.Bt + (size_t)nxt.pn * tstep : cB;
        for (int t = 0; t < nt; t += 2) {
            const bool last = (t == nt - 2);
            const char* a1 = cA + (size_t)(t + 1) * kstep;
            const char* a2 = last ? nA : cA + (size_t)(t + 2) * kstep; const char* b2 = last ? nB : cB + (size_t)(t + 2) * kstep;
            const char* a3 = a2 + kstep; const char* b3 = b2 + kstep;
            if (last && has_next) S.a_ready(nxt);
            if constexpr (SP2) {
            PG8_LDB(B0, 0, 0); PG8_LDB(B1, 0, 1); PG8_SCHED; PG8_LDA(At, 0, 0); PG8_STAGE(PG8_SA(1, 1), a1 + hstep, voffA);
            PG8_WAIT_V(8); PG8_WAIT_L(0); PG8_BAR; PG8_MMA(0, 0, At, B0); PG8_MMA(0, 1, At, B1); PG8_BAR; PG8_SCHED;
            PG8_LDA(At, 0, 1); PG8_STAGE(PG8_SB(0, 0), b2, voffB); PG8_STAGE(PG8_SB(0, 1), b2 + hstep, voffB); PG8_STAGE(PG8_SA(0, 0), a2, voffA);
            PG8_WAIT_V(8); PG8_WAIT_L(0); PG8_BAR; PG8_MMA(1, 0, At, B0); PG8_MMA(1, 1, At, B1); PG8_BAR; PG8_SCHED;
            PG8_LDB(B0, 1, 0); PG8_LDB(B1, 1, 1); PG8_SCHED; PG8_LDA(At, 1, 0); PG8_STAGE(PG8_SA(0, 1), a2 + hstep, voffA);
            PG8_WAIT_V(8); PG8_WAIT_L(0); PG8_BAR; PG8_MMA(0, 0, At, B0); PG8_MMA(0, 1, At, B1); PG8_BAR; PG8_SCHED;
            PG8_LDA(At, 1, 1); PG8_STAGE(PG8_SB(1, 0), b3, voffB); PG8_STAGE(PG8_SB(1, 1), b3 + hstep, voffB); PG8_STAGE(PG8_SA(1, 0), a3, voffA);
            PG8_WAIT_V(8); PG8_WAIT_L(0); PG8_BAR; PG8_MMA(1, 0, At, B0); PG8_MMA(1, 1, At, B1); PG8_BAR; PG8_SCHED;
            } else {
            PG8_LDB(B0, 0, 0); PG8_SCHED; PG8_LDA(At, 0, 0); PG8_STAGE(PG8_SA(1, 1), a1 + hstep, voffA);
            PG8_WAIT_L(8); PG8_BAR; PG8_WAIT_L(0); PG8_MMA(0, 0, At, B0); PG8_BAR; PG8_SCHED;
            PG8_LDB(B1, 0, 1); PG8_STAGE(PG8_SB(0, 0), b2, voffB);
            PG8_BAR; PG8_WAIT_L(0); PG8_MMA(0, 1, At, B1); PG8_BAR;
            PG8_LDA(At, 0, 1); PG8_STAGE(PG8_SA(0, 0), a2, voffA);
            PG8_BAR; PG8_WAIT_L(0); PG8_MMA(1, 0, At, B0); PG8_BAR; PG8_SCHED;
            PG8_STAGE(PG8_SB(0, 1), b2 + hstep, voffB);
            PG8_WAIT_V(6); PG8_BAR; PG8_MMA(1, 1, At, B1); PG8_BAR;
            PG8_LDB(B0, 1, 0); PG8_SCHED; PG8_LDA(At, 1, 0); PG8_STAGE(PG8_SA(0, 1), a2 + hstep, voffA);
            PG8_WAIT_L(8); PG8_BAR; PG8_WAIT_L(0); PG8_MMA(0, 0, At, B0); PG8_BAR; PG8_SCHED;
            PG8_LDB(B1, 1, 1); PG8_STAGE(PG8_SB(1, 0), b3, voffB);
            PG8_BAR; PG8_WAIT_L(0); PG8_MMA(0, 1, At, B1); PG8_BAR;
            PG8_LDA(At, 1, 1); PG8_STAGE(PG8_SA(1, 0), a3, voffA);
            PG8_BAR; PG8_WAIT_L(0); PG8_MMA(1, 0, At, B0); PG8_BAR; PG8_SCHED;
            PG8_STAGE(PG8_SB(1, 1), b3 + hstep, voffB);
            PG8_WAIT_V(6); PG8_BAR; PG8_MMA(1, 1, At, B1); PG8_BAR;
            }
        }
        if constexpr (ALIGN_EPI) { if (wr == 0) PG8_BAR; }
        if constexpr (!Epi::AFTER_DRAIN) { E(acc, cur, wr, wc, fr, fq); S.done(cur); }
        if (!has_next) break;
#pragma unroll
        for (int a = 0; a < 2; ++a)
#pragma unroll
            for (int b = 0; b < 2; ++b)
#pragma unroll
                for (int m = 0; m < 4; ++m)
#pragma unroll
                    for (int n = 0; n < 2; ++n) acc[a][b][m][n] = (f32x4){0.f, 0.f, 0.f, 0.f};
        cur = nxt; cA = nA; cB = nB; ++ui;
        if constexpr (ALIGN_EPI) { if (wr == 1) PG8_BAR; }
    }
    PG8_WAIT_V(0);
    if constexpr (!ALIGN_EPI) { if (wr == 0) PG8_BAR; }
    PG8_BAR;
    if constexpr (Epi::AFTER_DRAIN) { E.fused(acc, cur, wr, wc, fr, fq, lds, wid, lane); S.done(cur); }
#undef PG8_SA
#undef PG8_SB
#undef PG8_STAGE
#undef PG8_LDA
#undef PG8_LDB
#undef PG8_MMA
#undef PG8_WAIT_V
#undef PG8_WAIT_L
#undef PG8_BAR
#undef PG8_SCHED
}
}
namespace rec {
#define RLAS __attribute__((address_space(3)))
typedef unsigned short bf16;
typedef short bf16x8 __attribute__((ext_vector_type(8)));
typedef short s16x4 __attribute__((ext_vector_type(4)));
typedef float f32x4 __attribute__((ext_vector_type(4)));
typedef float f32x2 __attribute__((ext_vector_type(2)));
typedef unsigned u32x2 __attribute__((ext_vector_type(2)));
typedef unsigned u32x4 __attribute__((ext_vector_type(4)));
constexpr int PWID = 3584, DM = 1024;
constexpr float R_EPS = 1e-6f;

typedef __bf16 bf16x2_t __attribute__((ext_vector_type(2)));
__device__ __forceinline__ unsigned pkbf(float lo, float hi) { const f32x2 v = {lo, hi}; const bf16x2_t b = __builtin_convertvector(v, bf16x2_t); return __builtin_bit_cast(unsigned, b); }
__device__ __forceinline__ int otid() { int t = threadIdx.x; asm volatile("" : "+v"(t)); return t; }
__device__ __forceinline__ float bflo(unsigned u) { return __builtin_bit_cast(float, u << 16); }
__device__ __forceinline__ float bfhi(unsigned u) { return __builtin_bit_cast(float, u & 0xffff0000u); }

template <int DK> struct Lay {
    static constexpr int NP = DK / 2, NSEG = 512 / NP, TL = 64 / NSEG, SEGREF = 32 / TL - 1, NDT = DK / 16, NKS = DK / 32;
    static constexpr int PK = DK * 2 + 32, PV = 288, PP = 160, PO = 528;
    static constexpr int OFF_Q = 0, OFF_K = OFF_Q + 64 * PK, OFF_KH = OFF_K + 64 * PK, OFF_V = OFF_KH + 64 * PK, OFF_P = OFF_V + 64 * PV, OFF_O = OFF_P + 64 * PP,
                         OFF_SEG = OFF_O + 64 * PO, OFF_D = OFF_SEG + NSEG * DK * 4, OFF_E = OFF_D + DK * 4, OFF_END = OFF_E + DK * 4;
    static_assert(OFF_END <= 131072, "recurrence LDS map");
};

__device__ __forceinline__ bf16x8 tr_frag(RLAS unsigned char* img, int pitch, int k0, int n0, int lane) {
    const int g = lane >> 4, q = (lane & 15) >> 2, p = lane & 3;
    RLAS unsigned char* a = img + (k0 + 8 * g + q) * pitch + n0 * 2 + 8 * p;
    const s16x4 lo = __builtin_amdgcn_ds_read_tr16_b64_v4i16((RLAS s16x4*)a);
    const s16x4 hi = __builtin_amdgcn_ds_read_tr16_b64_v4i16((RLAS s16x4*)(a + 4 * pitch));
    return __builtin_shufflevector(lo, hi, 0, 1, 2, 3, 4, 5, 6, 7);
}

struct HeadIo {
    const bf16* P; const float* GA; bf16* MIX;
    int qoff, koff, voff, goff, ooff, gaoff;
    const float* onorm; float lb0, lb1;
};

#define REC_BAR() do { asm volatile("s_waitcnt lgkmcnt(0)" ::: "memory"); __builtin_amdgcn_s_barrier(); asm volatile("" ::: "memory"); } while (0)

template <int DK, bool HG, bool DO_OUT> struct Raw { unsigned q2[Lay<DK>::TL], k2[Lay<DK>::TL]; f32x2 av[Lay<DK>::TL]; u32x4 v0, v1, g0, g1; };

template <int DK, bool HG, bool DO_OUT>
__device__ __forceinline__ void load_raw(const HeadIo& io, size_t row0, int tvalid, Raw<DK, HG, DO_OUT>& w) {
    typedef Lay<DK> L;
    const int tid = otid(), dp = tid % L::NP, seg = tid / L::NP;
#pragma unroll
    for (int tt = 0; tt < L::TL; ++tt) {
        const int t = seg * L::TL + tt; const size_t row = row0 + t; const bool ok = t < tvalid;
        if (DO_OUT) w.q2[tt] = ok ? *(const unsigned*)(io.P + row * PWID + io.qoff + 2 * dp) : 0u;
        w.k2[tt] = ok ? *(const unsigned*)(io.P + row * PWID + io.koff + 2 * dp) : 0u;
        if (!HG) w.av[tt] = ok ? *(const f32x2*)(io.GA + row * 256 + io.gaoff + 2 * dp) : (f32x2){1.f, 1.f};
    }
    const int vr = tid >> 3, vc = (tid & 7) * 16; const bool vok = vr < tvalid;
    w.v0 = (u32x4){0u, 0u, 0u, 0u}; w.v1 = w.v0; w.g0 = w.v0; w.g1 = w.v0;
    if (vok) { const u32x4* src = (const u32x4*)(io.P + (row0 + vr) * PWID + io.voff + vc); w.v0 = src[0]; w.v1 = src[1];
        if (DO_OUT) { const u32x4* gp = (const u32x4*)(io.P + (row0 + vr) * PWID + io.goff + vc); w.g0 = gp[0]; w.g1 = gp[1]; } }
}

template <int DK, bool HG, bool DO_OUT>
__device__ __forceinline__ void chunk(RLAS unsigned char* lds, const HeadIo& io, const Raw<DK, HG, DO_OUT>& w, size_t row0, int tvalid, f32x4 (&S)[DK / 16], float& dtot) {
    typedef Lay<DK> L;
    const int tid = otid(), lane = tid & 63, wave = tid >> 6, r = lane & 15, g = lane >> 4, e0 = 16 * wave;
    const int dp = tid % L::NP, seg = tid / L::NP;
    {
        const int vr = tid >> 3, vc = (tid & 7) * 16;
        RLAS u32x4* dst = (RLAS u32x4*)(lds + L::OFF_V + vr * L::PV + vc * 2); dst[0] = w.v0; dst[1] = w.v1;
    }
    float kx[L::TL], ky[L::TL]; f32x2 pr[L::TL];
#pragma unroll
    for (int tt = 0; tt < L::TL; ++tt) {
        if (HG) {
            const bool ok = seg * L::TL + tt < tvalid;
            const float zx = fminf(fmaxf(bflo(w.k2[tt]), -30.f), 30.f), zy = fminf(fmaxf(bfhi(w.k2[tt]), -30.f), 30.f);
            const float ex = __expf(-zx), ey = __expf(-zy), sx = __builtin_amdgcn_rcpf(1.f + ex), sy = __builtin_amdgcn_rcpf(1.f + ey);
            kx[tt] = ok ? (1.f - io.lb0) * ex * sx : 0.f; ky[tt] = ok ? (1.f - io.lb1) * ey * sy : 0.f;
            pr[tt] = ok ? (f32x2){io.lb0 + (1.f - io.lb0) * sx, io.lb1 + (1.f - io.lb1) * sy} : (f32x2){1.f, 1.f};
        } else { kx[tt] = bflo(w.k2[tt]); ky[tt] = bfhi(w.k2[tt]); pr[tt] = w.av[tt]; }
    }
#pragma unroll
    for (int tt = 1; tt < L::TL; ++tt) pr[tt] *= pr[tt - 1];
    *(RLAS f32x2*)(lds + L::OFF_SEG + (seg * DK + 2 * dp) * 4) = pr[L::TL - 1];
    REC_BAR();
    f32x2 off = {1.f, 1.f}, aref = {1.f, 1.f}, alast = {1.f, 1.f};
#pragma unroll
    for (int s = 0; s < L::NSEG; ++s) { const f32x2 v = *(RLAS f32x2*)(lds + L::OFF_SEG + (s * DK + 2 * dp) * 4); if (s < seg) off *= v; if (s <= L::SEGREF) aref *= v; alast *= v; }
    const float irx = __builtin_amdgcn_rcpf(aref.x), iry = __builtin_amdgcn_rcpf(aref.y);
#pragma unroll
    for (int tt = 0; tt < L::TL; ++tt) {
        const int t = seg * L::TL + tt; const f32x2 at = off * pr[tt];
        const float ix = __builtin_amdgcn_rcpf(at.x), iy = __builtin_amdgcn_rcpf(at.y);
        if (DO_OUT) {
            *(RLAS unsigned*)(lds + L::OFF_Q + t * L::PK + 4 * dp) = pkbf(bflo(w.q2[tt]) * (at.x * irx), bfhi(w.q2[tt]) * (at.y * iry));
            *(RLAS unsigned*)(lds + L::OFF_K + t * L::PK + 4 * dp) = pkbf(kx[tt] * (ix * aref.x), ky[tt] * (iy * aref.y));
        }
        *(RLAS unsigned*)(lds + L::OFF_KH + t * L::PK + 4 * dp) = pkbf(kx[tt] * (ix * alast.x), ky[tt] * (iy * alast.y));
    }
    if (seg == 0) { *(RLAS f32x2*)(lds + L::OFF_D + 8 * dp) = alast; *(RLAS f32x2*)(lds + L::OFF_E + 8 * dp) = aref; }
    REC_BAR();
    if (tid < DK) dtot *= *(RLAS float*)(lds + L::OFF_D + 4 * tid);
    f32x4 O[4];
    if (DO_OUT) {
        const int it = wave >> 1;
#pragma unroll
        for (int jj = 0; jj < 2; ++jj) {
            const int jt = 2 * (wave & 1) + jj; f32x4 acc = {0.f, 0.f, 0.f, 0.f};
            if (jt <= it) {
#pragma unroll
                for (int s = 0; s < L::NKS; ++s) {
                    const bf16x8 kf = *(RLAS bf16x8*)(lds + L::OFF_K + (16 * jt + r) * L::PK + (32 * s + 8 * g) * 2);
                    const bf16x8 qf = *(RLAS bf16x8*)(lds + L::OFF_Q + (16 * it + r) * L::PK + (32 * s + 8 * g) * 2);
                    acc = __builtin_amdgcn_mfma_f32_16x16x32_bf16(kf, qf, acc, 0, 0, 0);
                }
            }
            const int i = 16 * it + r, j = 16 * jt + 4 * g;
            u32x2 pw; pw.x = pkbf(j <= i ? acc[0] : 0.f, j + 1 <= i ? acc[1] : 0.f); pw.y = pkbf(j + 2 <= i ? acc[2] : 0.f, j + 3 <= i ? acc[3] : 0.f);
            *(RLAS u32x2*)(lds + L::OFF_P + i * L::PP + j * 2) = pw;
        }
#pragma unroll
        for (int m = 0; m < 4; ++m) O[m] = (f32x4){0.f, 0.f, 0.f, 0.f};
#pragma unroll
        for (int s = 0; s < L::NKS; ++s) {
            const f32x4 ea = *(RLAS f32x4*)(lds + L::OFF_E + (32 * s + 4 * g) * 4), eb = *(RLAS f32x4*)(lds + L::OFF_E + (32 * s + 16 + 4 * g) * 4);
            const f32x4 sa = S[2 * s] * ea, sb = S[2 * s + 1] * eb;
            u32x4 sp; sp.x = pkbf(sa[0], sa[1]); sp.y = pkbf(sa[2], sa[3]); sp.z = pkbf(sb[0], sb[1]); sp.w = pkbf(sb[2], sb[3]);
            const bf16x8 sf = __builtin_bit_cast(bf16x8, sp);
#pragma unroll
            for (int m = 0; m < 4; ++m) {
                const s16x4 qlo = *(RLAS s16x4*)(lds + L::OFF_Q + (16 * m + r) * L::PK + (32 * s + 4 * g) * 2), qhi = *(RLAS s16x4*)(lds + L::OFF_Q + (16 * m + r) * L::PK + (32 * s + 16 + 4 * g) * 2);
                const bf16x8 qf = __builtin_shufflevector(qlo, qhi, 0, 1, 2, 3, 4, 5, 6, 7);
                O[m] = __builtin_amdgcn_mfma_f32_16x16x32_bf16(qf, sf, O[m], 0, 0, 0);
            }
        }
        REC_BAR();
    }
    const bf16x8 vf0 = tr_frag(lds + L::OFF_V, L::PV, 0, e0, lane), vf1 = tr_frag(lds + L::OFF_V, L::PV, 32, e0, lane);
    if (DO_OUT) {
#pragma unroll
        for (int m = 0; m < 4; ++m) {
            const bf16x8 p0 = *(RLAS bf16x8*)(lds + L::OFF_P + (16 * m + r) * L::PP + (8 * g) * 2), p1 = *(RLAS bf16x8*)(lds + L::OFF_P + (16 * m + r) * L::PP + (32 + 8 * g) * 2);
            O[m] = __builtin_amdgcn_mfma_f32_16x16x32_bf16(p0, vf0, O[m], 0, 0, 0);
            O[m] = __builtin_amdgcn_mfma_f32_16x16x32_bf16(p1, vf1, O[m], 0, 0, 0);
        }
    }
#pragma unroll
    for (int dt = 0; dt < L::NDT; ++dt) {
        const f32x4 dv = *(RLAS f32x4*)(lds + L::OFF_D + (16 * dt + 4 * g) * 4);
        const bf16x8 k0 = tr_frag(lds + L::OFF_KH, L::PK, 0, 16 * dt, lane), k1 = tr_frag(lds + L::OFF_KH, L::PK, 32, 16 * dt, lane);
        f32x4 acc = S[dt] * dv;
        acc = __builtin_amdgcn_mfma_f32_16x16x32_bf16(k0, vf0, acc, 0, 0, 0);
        acc = __builtin_amdgcn_mfma_f32_16x16x32_bf16(k1, vf1, acc, 0, 0, 0);
        S[dt] = acc;
    }
    if (DO_OUT) {
#pragma unroll
        for (int m = 0; m < 4; ++m)
#pragma unroll
            for (int ii = 0; ii < 4; ++ii) *(RLAS float*)(lds + L::OFF_O + (16 * m + 4 * g + ii) * L::PO + (e0 + r) * 4) = O[m][ii];
        REC_BAR();
        const int orow = tid >> 3, oc = (tid & 7) * 16;
        f32x4 ov[4]; float ss = 0.f;
#pragma unroll
        for (int c = 0; c < 4; ++c) { ov[c] = *(RLAS f32x4*)(lds + L::OFF_O + orow * L::PO + (oc + 4 * c) * 4); ss += (ov[c][0] * ov[c][0] + ov[c][1] * ov[c][1]) + (ov[c][2] * ov[c][2] + ov[c][3] * ov[c][3]); }
        ss += __shfl_xor(ss, 1); ss += __shfl_xor(ss, 2); ss += __shfl_xor(ss, 4);
        const float rs = rsqrtf(ss * (1.0f / 128.0f) + R_EPS);
        if (orow < tvalid) {
            const size_t row = row0 + orow;
            const unsigned gw[8] = {w.g0.x, w.g0.y, w.g0.z, w.g0.w, w.g1.x, w.g1.y, w.g1.z, w.g1.w};
            unsigned ow[8];
#pragma unroll
            for (int c = 0; c < 8; ++c) {
                const float ga = bflo(gw[c]), gb = bfhi(gw[c]);
                const float oa = ov[c >> 1][(c & 1) * 2] * rs * io.onorm[oc + 2 * c] * (ga * __builtin_amdgcn_rcpf(1.f + __expf(-ga)));
                const float ob = ov[c >> 1][(c & 1) * 2 + 1] * rs * io.onorm[oc + 2 * c + 1] * (gb * __builtin_amdgcn_rcpf(1.f + __expf(-gb)));
                ow[c] = pkbf(oa, ob);
            }
            u32x4* op = (u32x4*)(io.MIX + row * DM + io.ooff + oc);
            op[0] = (u32x4){ow[0], ow[1], ow[2], ow[3]}; op[1] = (u32x4){ow[4], ow[5], ow[6], ow[7]};
        }
    } else {
        REC_BAR();
    }
}

template <int NDT> __device__ __forceinline__ void load_state(f32x4 (&S)[NDT], const float* mem) {
    const int tid_ = otid(), lane = tid_ & 63, wave = tid_ >> 6, r = lane & 15, g = lane >> 4;
#pragma unroll
    for (int dt = 0; dt < NDT; ++dt)
#pragma unroll
        for (int i = 0; i < 4; ++i) S[dt][i] = mem ? mem[(16 * dt + 4 * g + i) * 128 + 16 * wave + r] : 0.f;
}
template <int NDT> __device__ __forceinline__ void store_state(const f32x4 (&S)[NDT], float* mem) {
    const int tid_ = otid(), lane = tid_ & 63, wave = tid_ >> 6, r = lane & 15, g = lane >> 4;
#pragma unroll
    for (int dt = 0; dt < NDT; ++dt)
#pragma unroll
        for (int i = 0; i < 4; ++i) mem[(16 * dt + 4 * g + i) * 128 + 16 * wave + r] = S[dt][i];
}

struct RecArgs {
    const bf16* P; const float* GA; bf16* MIX; const float* lbl; const float* gla_onorm; const float* hg_onorm;
    const float* st_gla_in; const float* st_hg_in; float* ST; float* DT; float* out_sgp; float* out_shp; float* out_sgs; float* out_shs;
};
constexpr int SC_TOK = 256, NCH = SC_TOK / 64, NSC = 8192 / SC_TOK, ST_PER = 4 * 64 * 128 + 4 * 128 * 128, DT_PER = 4 * 64 + 4 * 128;

template <int DK, bool HG> __device__ __forceinline__ HeadIo make_io(const RecArgs& a, int h) {
    HeadIo io; io.P = a.P; io.GA = a.GA; io.MIX = a.MIX;
    if (HG) { io.qoff = 1536 + h * 128; io.koff = 2048 + h * 128; io.voff = 2560 + h * 128; io.goff = 3072 + h * 128; io.ooff = 512 + h * 128; io.gaoff = 0; io.onorm = a.hg_onorm;
        const int d = 2 * (otid() % (DK / 2)); const float l0 = a.lbl[h * 128 + d], l1 = a.lbl[512 + h * 128 + d], m0 = a.lbl[h * 128 + d + 1], m1 = a.lbl[512 + h * 128 + d + 1];
        io.lb0 = 1.0f / (1.0f + __expf(l1 - l0)); io.lb1 = 1.0f / (1.0f + __expf(m1 - m0)); }
    else { io.qoff = h * 64; io.koff = 256 + h * 64; io.voff = 512 + h * 128; io.goff = 1024 + h * 128; io.ooff = h * 128; io.gaoff = h * 64; io.onorm = a.gla_onorm; io.lb0 = 0.f; io.lb1 = 0.f; }
    return io;
}

template <int DK, bool HG> __device__ __forceinline__ void r1_unit(RLAS unsigned char* lds, const RecArgs& a, int seq, int sc, int h) {
    const HeadIo io = make_io<DK, HG>(a, h);
    f32x4 S[DK / 16]; load_state<DK / 16>(S, nullptr); float dtot = 1.f;
    const size_t rb = (size_t)seq * 8192 + sc * SC_TOK;
    Raw<DK, HG, false> cur, nxt; load_raw<DK, HG, false>(io, rb, 64, cur);
#pragma unroll 1
    for (int c = 0; c < NCH; ++c) { if (c + 1 < NCH) load_raw<DK, HG, false>(io, rb + (c + 1) * 64, 64, nxt); chunk<DK, HG, false>(lds, io, cur, rb + c * 64, 64, S, dtot); cur = nxt; }
    const size_t u = (size_t)seq * NSC + sc;
    store_state<DK / 16>(S, a.ST + u * ST_PER + (HG ? 32768 + h * 16384 : h * 8192));
    { const int t_ = otid(); if (t_ < DK) a.DT[u * DT_PER + (HG ? 256 + h * 128 : h * 64) + t_] = dtot; }
}
template <int DK, bool HG> __device__ __forceinline__ void r3_unit(RLAS unsigned char* lds, const RecArgs& a, int seq, int sc, int h) {
    const HeadIo io = make_io<DK, HG>(a, h);
    const size_t u = (size_t)seq * NSC + sc;
    f32x4 S[DK / 16]; load_state<DK / 16>(S, a.ST + u * ST_PER + (HG ? 32768 + h * 16384 : h * 8192)); float dtot = 1.f;
    const size_t rb = (size_t)seq * 8192 + sc * SC_TOK;
    Raw<DK, HG, true> cur, nxt; load_raw<DK, HG, true>(io, rb, 64, cur);
#pragma unroll 1
    for (int c = 0; c < NCH; ++c) { if (c + 1 < NCH) load_raw<DK, HG, true>(io, rb + (c + 1) * 64, 64, nxt); chunk<DK, HG, true>(lds, io, cur, rb + c * 64, 64, S, dtot); cur = nxt; }
    if (sc == NSC - 1) store_state<DK / 16>(S, (HG ? a.out_shp : a.out_sgp) + (size_t)(seq * 4 + h) * DK * 128);
}
template <int DK, bool HG> __device__ __forceinline__ void rs_unit(RLAS unsigned char* lds, const RecArgs& a, int seq, int h) {
    const HeadIo io = make_io<DK, HG>(a, h);
    f32x4 S[DK / 16]; load_state<DK / 16>(S, (HG ? a.st_hg_in : a.st_gla_in) + (size_t)(seq * 4 + h) * DK * 128); float dtot = 1.f;
    Raw<DK, HG, true> cur; load_raw<DK, HG, true>(io, (size_t)32768 + seq * 32, 32, cur);
    chunk<DK, HG, true>(lds, io, cur, (size_t)32768 + seq * 32, 32, S, dtot);
    store_state<DK / 16>(S, (HG ? a.out_shs : a.out_sgs) + (size_t)(seq * 4 + h) * DK * 128);
}
__device__ __forceinline__ void decode_unit(int u, int& scidx, int& head) { scidx = u >> 3; head = ((u & 7) + 4 * ((u >> 8) & 1)) & 7; }

__device__ __forceinline__ void phase_r1(RLAS unsigned char* lds, const RecArgs& a, int G, int bx) {
    for (int u = bx; u < 4 * NSC * 8; u += G) { int scidx, head; decode_unit(u, scidx, head); const int seq = scidx / NSC, sc = scidx % NSC;
        if (sc == NSC - 1) continue;
        if (head < 4) r1_unit<64, false>(lds, a, seq, sc, head); else r1_unit<128, true>(lds, a, seq, sc, head - 4); }
}
__device__ __forceinline__ void phase_r2(const RecArgs& a, int gtid, int NGT) {
    for (int idx = gtid; idx < 4 * ST_PER; idx += NGT) {
        const int seq = idx / ST_PER, off = idx % ST_PER; int dti;
        if (off < 32768) dti = (off / 8192) * 64 + (off % 8192) / 128; else { const int o2 = off - 32768; dti = 256 + (o2 / 16384) * 128 + (o2 % 16384) / 128; }
        float x = 0.f;
        for (int s0 = 0; s0 < NSC; s0 += 8) {
            float tmp[8], dd[8];
#pragma unroll
            for (int j = 0; j < 8; ++j) { const size_t u = (size_t)seq * NSC + s0 + j; const bool has = (s0 + j) < NSC - 1; tmp[j] = has ? a.ST[u * ST_PER + off] : 0.f; dd[j] = has ? a.DT[u * DT_PER + dti] : 0.f; }
#pragma unroll
            for (int j = 0; j < 8; ++j) { const size_t u = (size_t)seq * NSC + s0 + j; a.ST[u * ST_PER + off] = x; x = dd[j] * x + tmp[j]; }
        }
    }
}
__device__ __forceinline__ void phase_r3(RLAS unsigned char* lds, const RecArgs& a, int G, int bx) {
    for (int u = bx; u < 4 * NSC * 8; u += G) { int scidx, head; decode_unit(u, scidx, head); const int seq = scidx / NSC, sc = scidx % NSC;
        if (head < 4) r3_unit<64, false>(lds, a, seq, sc, head); else r3_unit<128, true>(lds, a, seq, sc, head - 4); }
    for (int u = bx; u < 64; u += G) { const int seq = u >> 3, head = u & 7;
        if (head < 4) rs_unit<64, false>(lds, a, seq, head); else rs_unit<128, true>(lds, a, seq, head - 4); }
}
}
#define GAS __attribute__((address_space(1)))
#define LAS __attribute__((address_space(3)))
typedef unsigned short bf16;
typedef unsigned v4u __attribute__((ext_vector_type(4)));
typedef float f32x4 __attribute__((ext_vector_type(4)));
constexpr int NWAVES = 8;
constexpr int D = 1024, FF = 2816, MP = 32768, MS = 256, M = MP + MS, PW = 3584, NIN = 3840, DINSRC = 3600;
constexpr float EPS = 1e-6f;
constexpr size_t MiB = 1u << 20;
constexpr size_t WS_SSQ = 0, SSQ_STRIDE = (size_t)M * 4;
constexpr size_t WS_WGU1 = 1 * MiB, WS_WD1 = 12 * MiB, WS_WIN = 18 * MiB, WS_WO = 26 * MiB, WS_WGU2 = 28 * MiB, WS_WD2 = 39 * MiB;
constexpr size_t WS_XB = 45 * MiB, WS_MIX = 110 * MiB, WS_P = 175 * MiB, WS_HID = WS_P, WS_GA = 401 * MiB, WS_ST = 434 * MiB, WS_DT = 483 * MiB, WS_DUMMY = 484 * MiB, WS_END = 512 * MiB;
static_assert(WS_P + (size_t)M * PW * 2 <= WS_GA && WS_GA + (size_t)M * 256 * 4 <= WS_ST && WS_XB + (size_t)M * D * 2 <= WS_MIX && WS_MIX + (size_t)M * D * 2 <= WS_P, "ws map");
constexpr size_t O_Y = 0, O_SGP = (size_t)M * D, O_SHP = O_SGP + 4 * 4 * 64 * 128, O_SGS = O_SHP + 4 * 4 * 128 * 128, O_SHS = O_SGS + 8 * 4 * 64 * 128, O_END = O_SHS + 8 * 4 * 128 * 128;
constexpr int LDS_BYTES = 147456;

__device__ __forceinline__ unsigned f2bf(float f) { unsigned u = __builtin_bit_cast(unsigned, f); return (u + 0x7fffu + ((u >> 16) & 1u)) >> 16; }
__device__ __forceinline__ unsigned pk2(float lo, float hi) { return f2bf(lo) | (f2bf(hi) << 16); }
__device__ __forceinline__ float bf2f(bf16 b) { return __builtin_bit_cast(float, (unsigned)b << 16); }
#define LDS_WAIT() asm volatile("s_waitcnt lgkmcnt(0)" ::: "memory")

#ifndef DUPMASK
#define DUPMASK 0
#endif
struct Args { const float* in[21]; float* out; unsigned char* ws; int ph_lo, ph_hi, dup, pad; };
typedef const Args __attribute__((address_space(4))) CArgs;

__device__ __forceinline__ float wave_sum(float v) {
#pragma unroll
    for (int o = 1; o < 64; o <<= 1) v += __shfl_xor(v, o);
    return v;
}
__device__ __forceinline__ void tr_item(const float* W, int ldw, int src_col0, int k0, const float* gain, bf16* WT, int K, int dst_row0, LAS float* scr, int lane) {
    float w[32];
    const float* wp = W + (size_t)(k0 + (lane >> 5)) * ldw + src_col0 + (lane & 31);
#pragma unroll
    for (int i = 0; i < 32; ++i) w[i] = __builtin_nontemporal_load(wp + (size_t)(2 * i) * ldw);
    if (gain) {
#pragma unroll
        for (int i = 0; i < 32; ++i) w[i] *= gain[k0 + 2 * i + (lane >> 5)];
    }
#pragma unroll
    for (int i = 0; i < 32; ++i) scr[(2 * i + (lane >> 5)) * 33 + (lane & 31)] = w[i];
    LDS_WAIT(); asm volatile("" ::: "memory");
    const int c = lane & 7;
#pragma unroll
    for (int j = 0; j < 4; ++j) { const int n = (lane >> 3) + 8 * j; const LAS float* s = scr + (8 * c) * 33 + n;
        v4u o; o.x = pk2(s[0 * 33], s[1 * 33]); o.y = pk2(s[2 * 33], s[3 * 33]); o.z = pk2(s[4 * 33], s[5 * 33]); o.w = pk2(s[6 * 33], s[7 * 33]);
        *(v4u*)(WT + (size_t)(dst_row0 + n) * K + k0 + 8 * c) = o; }
    LDS_WAIT(); asm volatile("" ::: "memory");
}
__device__ __forceinline__ void weff_item(const float* Win, const float* up, int n0, int k0, const float* gain, bf16* WT, LAS float* scr, int lane) {
    float upr[16];
#pragma unroll
    for (int r = 0; r < 16; ++r) upr[r] = up[r * 256 + n0 + (lane & 31)];
#pragma unroll 4
    for (int i = 0; i < 32; ++i) { const int kk = 2 * i + (lane >> 5); const float* wr = Win + (size_t)(k0 + kk) * DINSRC + 1536; float s = 0.f;
#pragma unroll
        for (int r = 0; r < 16; ++r) s += wr[r] * upr[r];
        scr[kk * 33 + (lane & 31)] = s * gain[k0 + kk]; }
    LDS_WAIT(); asm volatile("" ::: "memory");
    const int c = lane & 7;
#pragma unroll
    for (int j = 0; j < 4; ++j) { const int n = (lane >> 3) + 8 * j; const LAS float* s = scr + (8 * c) * 33 + n;
        v4u o; o.x = pk2(s[0 * 33], s[1 * 33]); o.y = pk2(s[2 * 33], s[3 * 33]); o.z = pk2(s[4 * 33], s[5 * 33]); o.w = pk2(s[6 * 33], s[7 * 33]);
        *(v4u*)(WT + (size_t)(3584 + n0 + n) * 1024 + k0 + 8 * c) = o; }
    LDS_WAIT(); asm volatile("" ::: "memory");
}
__device__ __forceinline__ void gu_item(int r, const float* wg, const float* wu, const float* gain, bf16* WT, LAS float* scr, int lane) {
    const int kb = r / 176, nb = r % 176, dst = 32 * nb, tile = dst >> 8, j = dst & 255;
    const float* W = (j < 128) ? wg : wu; const int src = tile * 128 + (j & 127);
    tr_item(W, FF, src, 64 * kb, gain, WT, D, dst, scr, lane);
}

__device__ __forceinline__ int opaque_tid() { int t = threadIdx.x; asm volatile("" : "+v"(t)); return t; }
__device__ __forceinline__ void p0_prologue(CArgs& a, LAS unsigned char* lds, int G, int bx) {
    const int tid = opaque_tid(), lane = tid & 63, wave = __builtin_amdgcn_readfirstlane(tid >> 6);
    const int gw = bx * NWAVES + wave, NGW = G * NWAVES, gtid = bx * (NWAVES * 64) + tid, NGT = G * NWAVES * 64;
    LAS float* scr = (LAS float*)(lds + wave * 16384);
    unsigned char* ws = a.ws;
    constexpr int I_GU = 16 * 176, I_D = 44 * 32, I_IN = 16 * 112, I_EFF = 16 * 8, I_O = 16 * 32;
    constexpr int NITEMS = 2 * I_GU + 2 * I_D + I_IN + I_EFF + I_O;
    for (int it = gw; it < NITEMS; it += NGW) {
        int r = it; asm volatile("" : "+s"(ws));
        if (r < I_GU) { gu_item(r, a.in[5], a.in[6], a.in[4], (bf16*)(ws + WS_WGU1), scr, lane); continue; } r -= I_GU;
        if (r < I_D) { tr_item(a.in[7], D, 32 * (r % 32), 64 * (r / 32), nullptr, (bf16*)(ws + WS_WD1), FF, 32 * (r % 32), scr, lane); continue; } r -= I_D;
        if (r < I_IN) { const int kb = r / 112, nb = r % 112, dst = 32 * nb, src = dst < 1536 ? dst : dst + 16;
            tr_item(a.in[9], DINSRC, src, 64 * kb, a.in[8], (bf16*)(ws + WS_WIN), D, dst, scr, lane); continue; } r -= I_IN;
        if (r < I_EFF) { weff_item(a.in[9], a.in[10], 32 * (r % 8), 64 * (r / 8), a.in[8], (bf16*)(ws + WS_WIN), scr, lane); continue; } r -= I_EFF;
        if (r < I_O) { tr_item(a.in[15], D, 32 * (r % 32), 64 * (r / 32), nullptr, (bf16*)(ws + WS_WO), D, 32 * (r % 32), scr, lane); continue; } r -= I_O;
        if (r < I_GU) { gu_item(r, a.in[17], a.in[18], a.in[16], (bf16*)(ws + WS_WGU2), scr, lane); continue; } r -= I_GU;
        tr_item(a.in[19], D, 32 * (r % 32), 64 * (r / 32), nullptr, (bf16*)(ws + WS_WD2), FF, 32 * (r % 32), scr, lane);
    }
    float* ssq1 = (float*)(ws + WS_SSQ); bf16* XB = (bf16*)(ws + WS_XB);
    for (int m0 = 2 * gw; m0 < M; m0 += 2 * NGW) {
        f32x4 v[2][4]; float s[2];
#pragma unroll
        for (int h = 0; h < 2; ++h) { const int m = m0 + h;
            const float* xrow = (m < MP) ? a.in[0] + (size_t)m * D : a.in[1] + (size_t)(m - MP) * D;
            const f32x4* xr = (const f32x4*)xrow + lane;
#pragma unroll
            for (int j = 0; j < 4; ++j) v[h][j] = __builtin_nontemporal_load(xr + 64 * j); }
#pragma unroll
        for (int h = 0; h < 2; ++h) { const int m = m0 + h; float ss = 0.f;
#pragma unroll
            for (int j = 0; j < 4; ++j) ss += (v[h][j].x * v[h][j].x + v[h][j].y * v[h][j].y) + (v[h][j].z * v[h][j].z + v[h][j].w * v[h][j].w);
            s[h] = wave_sum(ss);
            unsigned long long* o8 = (unsigned long long*)(XB + (size_t)m * D) + lane;
#pragma unroll
            for (int j = 0; j < 4; ++j) o8[64 * j] = (unsigned long long)pk2(v[h][j].x, v[h][j].y) | ((unsigned long long)pk2(v[h][j].z, v[h][j].w) << 32);
            if (lane == 0) ssq1[m] = s[h]; }
    }
    for (int i = gtid; i < 3 * M; i += NGT) ssq1[M + i] = 0.f;
}

__device__ __forceinline__ void p8_final(CArgs& a, int G, int bx) {
    const int tid = opaque_tid(), lane = tid & 63, wave = __builtin_amdgcn_readfirstlane(tid >> 6);
    const int gw = bx * NWAVES + wave, NGW = G * NWAVES;
    const float* ssq4 = (const float*)(a.ws + WS_SSQ) + 3 * (size_t)M; const bf16* XB = (const bf16*)(a.ws + WS_XB);
    const f32x4* g = (const f32x4*)a.in[20] + 2 * lane;
    f32x4 gv[2][2];
#pragma unroll
    for (int j = 0; j < 2; ++j) { gv[j][0] = g[128 * j]; gv[j][1] = g[128 * j + 1]; }
    for (int m0 = 2 * gw; m0 < M; m0 += 2 * NGW) {
        v4u xv[2][2];
#pragma unroll
        for (int h = 0; h < 2; ++h)
#pragma unroll
            for (int j = 0; j < 2; ++j) xv[h][j] = __builtin_nontemporal_load((const v4u*)(XB + (size_t)(m0 + h) * D) + lane + 64 * j);
#pragma unroll
        for (int h = 0; h < 2; ++h) { const float rs = rsqrtf(ssq4[m0 + h] * (1.0f / 1024.0f) + EPS); f32x4* yr = (f32x4*)(a.out + (size_t)(m0 + h) * D) + 2 * lane;
#pragma unroll
            for (int j = 0; j < 2; ++j) { const v4u x = xv[h][j];
                const f32x4 lo = {__builtin_bit_cast(float, x.x << 16), __builtin_bit_cast(float, x.x & 0xffff0000u), __builtin_bit_cast(float, x.y << 16), __builtin_bit_cast(float, x.y & 0xffff0000u)};
                const f32x4 hi = {__builtin_bit_cast(float, x.z << 16), __builtin_bit_cast(float, x.z & 0xffff0000u), __builtin_bit_cast(float, x.w << 16), __builtin_bit_cast(float, x.w & 0xffff0000u)};
                __builtin_nontemporal_store(lo * rs * gv[j][0], yr + 128 * j); __builtin_nontemporal_store(hi * rs * gv[j][1], yr + 128 * j + 1); } }
    }
}

__device__ __forceinline__ CArgs& kargs() { CArgs* p = (CArgs*)__builtin_amdgcn_kernarg_segment_ptr(); asm volatile("" : "+s"(p)); return *p; }
__global__ void __launch_bounds__(NWAVES * 64, 2) mega_fwd(Args args_unused) {
    extern __shared__ __attribute__((aligned(16))) unsigned char lds_raw[];
    cg::grid_group grid = cg::this_grid();
    LAS unsigned char* lds = (LAS unsigned char*)lds_raw;
    const int G = gridDim.x, bx = blockIdx.x;
    const int lo = kargs().ph_lo, hi = kargs().ph_hi, dup = kargs().dup;
#define IN(k) (lo <= (k) && (k) < hi)
#define BOTH(k) (IN(k) && IN((k) + 1))
#define GRID_BAR() grid.sync()
#define REP(k) for (int rep_ = ((dup >> (k)) & 1); rep_ >= 0; --rep_)
#define SSQ(a, i) ((float*)((a).ws + WS_SSQ) + (size_t)(i) * M)

    if (IN(0)) REP(0) { p0_prologue(kargs(), lds, G, bx); if (BOTH(0)) GRID_BAR(); }
    if (IN(1)) REP(1) {
        CArgs& a = kargs(); unsigned char* ws = a.ws;
        pg8::Gemm g{(const bf16*)(ws + WS_XB), (const bf16*)(ws + WS_WGU1), M, 2 * FF, D}; pg8::StaticOrder S; S.init(M, 2 * FF, G, bx);
        pg8::EpiUp E{(bf16*)(ws + WS_HID), FF, SSQ(a, 0)};
        pg8::gemm_phase<pg8::EpiUp, pg8::StaticOrder, true, true>(lds, g, S, E);
        if (BOTH(1)) GRID_BAR();
    }
    if (IN(2)) REP(2) {
        CArgs& a = kargs(); unsigned char* ws = a.ws;
        pg8::Gemm g{(const bf16*)(ws + WS_HID), (const bf16*)(ws + WS_WD1), M, D, FF}; pg8::StaticOrder S; S.init(M, D, G, bx);
        pg8::EpiRes E{a.in[0], a.in[1], MP / 256, (bf16*)(ws + WS_XB), rep_ ? (float*)(ws + WS_DUMMY) : SSQ(a, 1), rep_ ? 0.f : 0.5f};
        pg8::gemm_phase<pg8::EpiRes, pg8::StaticOrder, true, true>(lds, g, S, E);
        if (BOTH(2)) GRID_BAR();
    }
    if (IN(3)) REP(3) {
        CArgs& a = kargs(); unsigned char* ws = a.ws;
        pg8::Gemm g{(const bf16*)(ws + WS_XB), (const bf16*)(ws + WS_WIN), M, NIN, D}; pg8::StaticOrder S; S.init(M, NIN, G, bx);
        pg8::EpiWin E{(bf16*)(ws + WS_P), (float*)(ws + WS_GA), SSQ(a, 1), a.in[11]};
        pg8::gemm_phase<pg8::EpiWin, pg8::StaticOrder, true, true>(lds, g, S, E);
        if (BOTH(3)) GRID_BAR();
    }
#define MAKE_RA(a) rec::RecArgs ra{(const bf16*)((a).ws + WS_P), (const float*)((a).ws + WS_GA), (bf16*)((a).ws + WS_MIX), (a).in[13], (a).in[12], (a).in[14], (a).in[2], (a).in[3], \
                        (float*)((a).ws + WS_ST), (float*)((a).ws + WS_DT), (a).out + O_SGP, (a).out + O_SHP, (a).out + O_SGS, (a).out + O_SHS}
    if (IN(4)) REP(4) { CArgs& a = kargs(); MAKE_RA(a); rec::phase_r1(lds, ra, G, bx); if (BOTH(4)) GRID_BAR(); }
    if (IN(5)) { CArgs& a = kargs(); MAKE_RA(a); rec::phase_r2(ra, bx * (NWAVES * 64) + opaque_tid(), G * NWAVES * 64); if (BOTH(5)) GRID_BAR(); }
    if (IN(6)) REP(6) { CArgs& a = kargs(); MAKE_RA(a); rec::phase_r3(lds, ra, G, bx); if (BOTH(6)) GRID_BAR(); }
    if (IN(7)) REP(7) {
        CArgs& a = kargs(); unsigned char* ws = a.ws;
        pg8::Gemm g{(const bf16*)(ws + WS_MIX), (const bf16*)(ws + WS_WO), M, D, D}; pg8::StaticOrder S; S.init(M, D, G, bx);
        pg8::EpiRes E{nullptr, nullptr, 1 << 30, (bf16*)(ws + WS_XB), rep_ ? (float*)(ws + WS_DUMMY) : SSQ(a, 2), rep_ ? 0.f : 1.0f};
        pg8::gemm_phase<pg8::EpiRes, pg8::StaticOrder, true, true>(lds, g, S, E);
        if (BOTH(7)) GRID_BAR();
    }
    if (IN(8)) REP(8) {
        CArgs& a = kargs(); unsigned char* ws = a.ws;
        pg8::Gemm g{(const bf16*)(ws + WS_XB), (const bf16*)(ws + WS_WGU2), M, 2 * FF, D}; pg8::StaticOrder S; S.init(M, 2 * FF, G, bx);
        pg8::EpiUp E{(bf16*)(ws + WS_HID), FF, SSQ(a, 2)};
        pg8::gemm_phase<pg8::EpiUp, pg8::StaticOrder, true, true>(lds, g, S, E);
        if (BOTH(8)) GRID_BAR();
    }
    if (IN(9)) REP(9) {
        CArgs& a = kargs(); unsigned char* ws = a.ws;
        pg8::Gemm g{(const bf16*)(ws + WS_HID), (const bf16*)(ws + WS_WD2), M, D, FF}; pg8::StaticOrder S; S.init(M, D, G, bx);
        pg8::EpiRes E{nullptr, nullptr, 1 << 30, (bf16*)(ws + WS_XB), rep_ ? (float*)(ws + WS_DUMMY) : SSQ(a, 3), rep_ ? 0.f : 0.5f};
        pg8::gemm_phase<pg8::EpiRes, pg8::StaticOrder, true, true>(lds, g, S, E);
        if (BOTH(9)) GRID_BAR();
    }
    if (IN(10)) p8_final(kargs(), G, bx);
#undef IN
#undef BOTH
}

extern "C" void kernel_launch(void* const* d_in, const int* in_sizes, int n_in, void* d_out, int out_size, void* d_ws, size_t ws_size, hipStream_t stream) {
    static int grid = 0;
    if (grid == 0) {
        if (n_in != 21 || out_size != (int)O_END || ws_size < WS_END) { fprintf(stderr, "kernel_launch: unexpected sizes n_in %d out %d ws %zu\n", n_in, out_size, ws_size); grid = -1; return; }
        int dev = 0, cus = 0, per_cu = 0;
        (void)hipGetDevice(&dev); (void)hipDeviceGetAttribute(&cus, hipDeviceAttributeMultiprocessorCount, dev);
        if (hipFuncSetAttribute((const void*)mega_fwd, hipFuncAttributeMaxDynamicSharedMemorySize, LDS_BYTES) != hipSuccess) { fprintf(stderr, "hipFuncSetAttribute failed\n"); grid = -1; return; }
        if (hipOccupancyMaxActiveBlocksPerMultiprocessor(&per_cu, (const void*)mega_fwd, NWAVES * 64, LDS_BYTES) != hipSuccess || per_cu < 1) { fprintf(stderr, "occupancy query: %d\n", per_cu); per_cu = 1; }
        (void)hipGetLastError();
        grid = cus * per_cu;
    }
    if (grid < 0) return;
    Args a{};
    for (int i = 0; i < 21; ++i) a.in[i] = (const float*)d_in[i];
    a.out = (float*)d_out; a.ws = (unsigned char*)d_ws;
    a.ph_lo = 0; a.ph_hi = 11; a.dup = DUPMASK;
    void* kargs[] = {&a};
    hipError_t e = hipLaunchCooperativeKernel((const void*)mega_fwd, dim3(grid), dim3(NWAVES * 64), kargs, LDS_BYTES, stream);
    if (e != hipSuccess) fprintf(stderr, "cooperative launch failed: %s (grid %d)\n", hipGetErrorString(e), grid);
}
```

```cpp
#include <hip/hip_runtime.h>
#include <hip/hip_cooperative_groups.h>
#include <cstdio>
#include <cstdint>
namespace cg = cooperative_groups;
namespace pg8 {
#define PG8_LAS __attribute__((address_space(3)))
typedef unsigned short bf16_t;
typedef short bf16x8 __attribute__((ext_vector_type(8)));
typedef float f32x4 __attribute__((ext_vector_type(4)));
typedef unsigned u32x4 __attribute__((ext_vector_type(4)));
constexpr int BM = 256, BK = 64, HALF = 128, HTB = HALF * BK * 2  , STAGE_BYTES = 8 * HTB, NXCD = 8, WGM = 8;

__host__ __device__ __forceinline__ int lds_byte(int r, int c) { const int st = (r >> 4) * 2 + (c >> 5), rr = r & 15, cc = c & 31, ob = rr * 64 + cc * 2; return st * 1024 + (ob ^ (((ob >> 9) & 1) << 5)); }
__host__ __device__ __forceinline__ void stage_rc(int b, int& R, int& C) { const int st = b / 1024, sb = b % 1024, swz = sb ^ (((sb >> 9) & 1) << 5); R = (st >> 1) * 16 + swz / 64; C = (st & 1) * 32 + (swz % 64) / 2; }
__host__ __device__ __forceinline__ int perm32(int rho) { const int n = rho >> 4, i = rho & 15; return 8 * (i >> 2) + 4 * n + (i & 3); }

struct Unit { int pm, pn; };
struct Gemm { const bf16_t* A; const bf16_t* Bt; int M, N, K; };

struct StaticOrder {
    int nM, nN, nwg, G, c;
    __host__ __device__ void init(int M, int N, int G_, int c_) { nM = M / BM; nN = N / BM; nwg = nM * nN; G = G_; c = c_; }
    __host__ __device__ bool next(int i, Unit& u) const {
        const long L = (long)i * G + c; if (L >= nwg) return false;
        int wgid = (int)L; { const int q = nwg / NXCD, r = nwg % NXCD, xcd = wgid % NXCD, off = wgid / NXCD; wgid = (xcd < r ? xcd * (q + 1) : r * (q + 1) + (xcd - r) * q) + off; }
        const int nig = WGM * nN, gid = wgid / nig, fm = gid * WGM, gsz = (nM - fm) < WGM ? (nM - fm) : WGM;
        u.pm = fm + ((wgid % nig) % gsz); u.pn = (wgid % nig) / gsz; return true;
    }
    __device__ __forceinline__ void a_ready(const Unit&) const {}
    __device__ __forceinline__ void done(const Unit&) const {}
};

__device__ __forceinline__ unsigned cvt_pk_bf16(float lo, float hi) { unsigned r; asm volatile("v_cvt_pk_bf16_f32 %0, %1, %2" : "=v"(r) : "v"(lo), "v"(hi)); return r; }
typedef float f32x2 __attribute__((ext_vector_type(2)));
constexpr float RMS_EPS = 1e-6f;
__device__ __forceinline__ float silu_f(float g) { return g * __builtin_amdgcn_rcpf(1.0f + __expf(-g)); }
__device__ __forceinline__ float rstd_of(const float* ssq, int row) { return rsqrtf(ssq[row] * (1.0f / 1024.0f) + RMS_EPS); }

struct EpiUp {
    static constexpr bool PERM = true, AFTER_DRAIN = false;
    bf16_t* H; int ldh; const float* ssq;
    __device__ __forceinline__ void operator()(const f32x4 (&acc)[2][2][4][2], const Unit& u, int wr, int wc, int fr, int fq) const {
        const int row0 = u.pm * BM + wr * 64 + fr, hcol0 = u.pn * HALF + wc * 32 + 8 * fq;
#pragma unroll
        for (int ai = 0; ai < 2; ++ai)
#pragma unroll
            for (int m = 0; m < 4; ++m) {
                const int row = row0 + ai * HALF + m * 16; const float rs = rstd_of(ssq, row);
                float h[8];
#pragma unroll
                for (int n = 0; n < 2; ++n)
#pragma unroll
                    for (int i = 0; i < 4; ++i) { const float g = acc[ai][0][m][n][i] * rs, uu = acc[ai][1][m][n][i] * rs; h[4 * n + i] = silu_f(g) * uu; }
                u32x4 w; w.x = cvt_pk_bf16(h[0], h[1]); w.y = cvt_pk_bf16(h[2], h[3]); w.z = cvt_pk_bf16(h[4], h[5]); w.w = cvt_pk_bf16(h[6], h[7]);
                *(u32x4*)(H + (size_t)row * ldh + hcol0) = w;
            }
    }
};

struct EpiRes {
    static constexpr bool PERM = true, AFTER_DRAIN = false;
    const float* xf0; const float* xf1; int split_pm;
    bf16_t* xb; float* ssq; float scale;
    __device__ __forceinline__ void operator()(const f32x4 (&acc)[2][2][4][2], const Unit& u, int wr, int wc, int fr, int fq) const {
        const int row0 = u.pm * BM + wr * 64 + fr, col0 = u.pn * BM + wc * 32 + 8 * fq;
        const float* xin = xf0 ? ((u.pm < split_pm) ? xf0 : (xf1 - (size_t)split_pm * BM * 1024)) : nullptr;
#pragma unroll
        for (int ai = 0; ai < 2; ++ai)
#pragma unroll
            for (int m = 0; m < 4; ++m) {
                const int row = row0 + ai * HALF + m * 16; const size_t off = (size_t)row * 1024 + col0; float s = 0.f;
#pragma unroll
                for (int bj = 0; bj < 2; ++bj) {
                    f32x4 r0, r1;
                    if (xin) { r0 = *(const f32x4*)(xin + off + bj * HALF); r1 = *(const f32x4*)(xin + off + bj * HALF + 4); }
                    else { const u32x4 rb = *(const u32x4*)(xb + off + bj * HALF);
                        r0 = (f32x4){__builtin_bit_cast(float, rb.x << 16), __builtin_bit_cast(float, rb.x & 0xffff0000u), __builtin_bit_cast(float, rb.y << 16), __builtin_bit_cast(float, rb.y & 0xffff0000u)};
                        r1 = (f32x4){__builtin_bit_cast(float, rb.z << 16), __builtin_bit_cast(float, rb.z & 0xffff0000u), __builtin_bit_cast(float, rb.w << 16), __builtin_bit_cast(float, rb.w & 0xffff0000u)}; }
                    const f32x4 v0 = r0 + acc[ai][bj][m][0] * scale, v1 = r1 + acc[ai][bj][m][1] * scale;
                    s += ((v0[0] * v0[0] + v0[1] * v0[1]) + (v0[2] * v0[2] + v0[3] * v0[3])) + ((v1[0] * v1[0] + v1[1] * v1[1]) + (v1[2] * v1[2] + v1[3] * v1[3]));
                    u32x4 w; w.x = cvt_pk_bf16(v0[0], v0[1]); w.y = cvt_pk_bf16(v0[2], v0[3]); w.z = cvt_pk_bf16(v1[0], v1[1]); w.w = cvt_pk_bf16(v1[2], v1[3]);
                    *(u32x4*)(xb + off + bj * HALF) = w;
                }
                s += __shfl_xor(s, 16); s += __shfl_xor(s, 32);
                if (fq == 0) __hip_atomic_fetch_add(ssq + row, s, __ATOMIC_RELAXED, __HIP_MEMORY_SCOPE_AGENT);
            }
    }
};

struct EpiWin {
    static constexpr bool PERM = true, AFTER_DRAIN = false;
    bf16_t* P; float* GA; const float* ssq; const float* gbias;
    __device__ __forceinline__ void operator()(const f32x4 (&acc)[2][2][4][2], const Unit& u, int wr, int wc, int fr, int fq) const {
        const int row0 = u.pm * BM + wr * 64 + fr, c0 = wc * 32 + 8 * fq, pn = u.pn;
#pragma unroll
        for (int ai = 0; ai < 2; ++ai)
#pragma unroll
            for (int m = 0; m < 4; ++m) {
                const int row = row0 + ai * HALF + m * 16; const float rs = rstd_of(ssq, row);
#pragma unroll
                for (int bj = 0; bj < 2; ++bj) {
                    float v[8];
#pragma unroll
                    for (int n = 0; n < 2; ++n)
#pragma unroll
                        for (int i = 0; i < 4; ++i) v[4 * n + i] = acc[ai][bj][m][n][i] * rs;
                    const int tc = bj * HALF + c0;
                    if (pn == 14) {
                        f32x4 o0, o1;
#pragma unroll
                        for (int i = 0; i < 8; ++i) { const float x = v[i] + gbias[tc + i]; const float ls = fminf(x, 0.f) - __logf(1.0f + __expf(-fabsf(x))); const float av = __expf(ls * 0.0625f); if (i < 4) o0[i] = av; else o1[i - 4] = av; }
                        *(f32x4*)(GA + (size_t)row * 256 + tc) = o0; *(f32x4*)(GA + (size_t)row * 256 + tc + 4) = o1;
                    } else {
                        if (pn == 0) {
#pragma unroll
                            for (int i = 0; i < 8; ++i) v[i] *= 0.125f;
                        } else if (pn == 6 || pn == 7) {
#pragma unroll
                            for (int i = 0; i < 8; ++i) v[i] = silu_f(v[i]);
                        }
                        u32x4 w; w.x = cvt_pk_bf16(v[0], v[1]); w.y = cvt_pk_bf16(v[2], v[3]); w.z = cvt_pk_bf16(v[4], v[5]); w.w = cvt_pk_bf16(v[6], v[7]);
                        *(u32x4*)(P + (size_t)row * 3584 + pn * BM + tc) = w;
                    }
                }
            }
    }
};
template <class Epi, class Sched, bool ALIGN_EPI = false, bool SP2 = false>
__device__ __forceinline__ void gemm_phase(PG8_LAS unsigned char* lds, const Gemm g, const Sched& S, const Epi& E) {
    const int tid = threadIdx.x, wid = __builtin_amdgcn_readfirstlane(tid >> 6), lane = tid & 63, wr = wid >> 2, wc = wid & 3, fr = lane & 15, fq = lane >> 4;
    const int K = g.K, nt = K / BK;
    unsigned voffA[2], voffB[2];
#pragma unroll
    for (int i = 0; i < 2; ++i) { int R, C; stage_rc(tid * 16 + i * 8192, R, C); const int Rb = Epi::PERM ? ((R & ~31) + perm32(R & 31)) : R;
        voffA[i] = (unsigned)(R * K + C) * 2u; voffB[i] = (unsigned)(Rb * K + C) * 2u; }
    const size_t kstep = (size_t)(BK * 2);
    const size_t hstep = (size_t)HALF * K * 2;
    const size_t tstep = 2 * hstep;
    const unsigned ldsw = (unsigned)wid * 1024u;
    const int aoff = lds_byte(wr * 64 + fr, fq * 8), boff = lds_byte(wc * 32 + fr, fq * 8);
#define PG8_SA(b, h) (((b) * 2 + (h)) * HTB)
#define PG8_SB(b, h) ((4 + (b) * 2 + (h)) * HTB)
#define PG8_STAGE(bufoff, gbase, voff) do { _Pragma("unroll") for (int _i = 0; _i < 2; ++_i) \
        __builtin_amdgcn_global_load_lds((const unsigned*)((const char*)(gbase) + (voff)[_i]), (PG8_LAS unsigned*)(lds + (bufoff) + ldsw + _i * 8192), 16, 0, 0); } while (0)
#define PG8_LDA(dst, b, h) do { _Pragma("unroll") for (int m = 0; m < 4; ++m) _Pragma("unroll") for (int k = 0; k < 2; ++k) dst[m][k] = *(const PG8_LAS bf16x8*)(lds + PG8_SA(b, h) + aoff + m * 2048 + k * 1024); } while (0)
#define PG8_LDB(dst, b, h) do { _Pragma("unroll") for (int n = 0; n < 2; ++n) _Pragma("unroll") for (int k = 0; k < 2; ++k) dst[n][k] = *(const PG8_LAS bf16x8*)(lds + PG8_SB(b, h) + boff + n * 2048 + k * 1024); } while (0)
#define PG8_MMA(ai, bj, At, Bt) do { __builtin_amdgcn_s_setprio(1); _Pragma("unroll") for (int m = 0; m < 4; ++m) _Pragma("unroll") for (int n = 0; n < 2; ++n) _Pragma("unroll") for (int k = 0; k < 2; ++k) \
        acc[ai][bj][m][n] = __builtin_amdgcn_mfma_f32_16x16x32_bf16(Bt[n][k], At[m][k], acc[ai][bj][m][n], 0, 0, 0); __builtin_amdgcn_s_setprio(0); } while (0)
#define PG8_WAIT_V(n) asm volatile("s_waitcnt vmcnt(" #n ")" ::: "memory")
#define PG8_WAIT_L(n) asm volatile("s_waitcnt lgkmcnt(" #n ")" ::: "memory")
#define PG8_BAR __builtin_amdgcn_s_barrier()
#define PG8_SCHED __builtin_amdgcn_sched_barrier(0)
    Unit cur, nxt; int ui = 0;
    if (!S.next(0, cur)) return;
    f32x4 acc[2][2][4][2];
#pragma unroll
    for (int a = 0; a < 2; ++a)
#pragma unroll
        for (int b = 0; b < 2; ++b)
#pragma unroll
            for (int m = 0; m < 4; ++m)
#pragma unroll
                for (int n = 0; n < 2; ++n) acc[a][b][m][n] = (f32x4){0.f, 0.f, 0.f, 0.f};
    bf16x8 At[4][2], B0[2][2], B1[2][2];
    const char* cA = (const char*)g.A + (size_t)cur.pm * tstep; const char* cB = (const char*)g.Bt + (size_t)cur.pn * tstep;
    S.a_ready(cur);
    if constexpr (SP2) {
        PG8_STAGE(PG8_SB(0, 0), cB, voffB); PG8_STAGE(PG8_SB(0, 1), cB + hstep, voffB); PG8_STAGE(PG8_SA(0, 0), cA, voffA); PG8_STAGE(PG8_SA(0, 1), cA + hstep, voffA);
        if (wr == 1) PG8_BAR;
        PG8_WAIT_V(2); PG8_BAR;
        PG8_STAGE(PG8_SB(1, 0), cB + kstep, voffB); PG8_STAGE(PG8_SA(1, 0), cA + kstep, voffA); PG8_STAGE(PG8_SB(1, 1), cB + hstep + kstep, voffB);
        PG8_WAIT_V(6); PG8_BAR;
    } else {
        PG8_STAGE(PG8_SB(0, 0), cB, voffB); PG8_STAGE(PG8_SA(0, 0), cA, voffA); PG8_STAGE(PG8_SB(0, 1), cB + hstep, voffB); PG8_STAGE(PG8_SA(0, 1), cA + hstep, voffA);
        if (wr == 1) PG8_BAR;
        PG8_WAIT_V(4); PG8_BAR;
        PG8_STAGE(PG8_SB(1, 0), cB + kstep, voffB); PG8_STAGE(PG8_SA(1, 0), cA + kstep, voffA); PG8_STAGE(PG8_SB(1, 1), cB + hstep + kstep, voffB);
        PG8_WAIT_V(6); PG8_BAR;
    }
    for (;;) {
        const bool has_next = S.next(ui + 1, nxt);
        const char* nA = has_next ? (const char*)g.A + (size_t)nxt.pm * tstep : cA; const char* nB = has_next ? (const char*)g.Bt + (size_t)nxt.pn * tstep : cB;
        for (int t = 0; t < nt; t += 2) {
            const bool last = (t == nt - 2);
            const char* a1 = cA + (size_t)(t + 1) * kstep;
            const char* a2 = last ? nA : cA + (size_t)(t + 2) * kstep; const char* b2 = last ? nB : cB + (size_t)(t + 2) * kstep;
            const char* a3 = a2 + kstep; const char* b3 = b2 + kstep;
            if (last && has_next) S.a_ready(nxt);
            if constexpr (SP2) {
            PG8_LDB(B0, 0, 0); PG8_LDB(B1, 0, 1); PG8_SCHED; PG8_LDA(At, 0, 0); PG8_STAGE(PG8_SA(1, 1), a1 + hstep, voffA);
            PG8_WAIT_V(8); PG8_WAIT_L(0); PG8_BAR; PG8_MMA(0, 0, At, B0); PG8_MMA(0, 1, At, B1); PG8_BAR; PG8_SCHED;
            PG8_LDA(At, 0, 1); PG8_STAGE(PG8_SB(0, 0), b2, voffB); PG8_STAGE(PG8_SB(0, 1), b2 + hstep, voffB); PG8_STAGE(PG8_SA(0, 0), a2, voffA);
            PG8_WAIT_V(8); PG8_WAIT_L(0); PG8_BAR; PG8_MMA(1, 0, At, B0); PG8_MMA(1, 1, At, B1); PG8_BAR; PG8_SCHED;
            PG8_LDB(B0, 1, 0); PG8_LDB(B1, 1, 1); PG8_SCHED; PG8_LDA(At, 1, 0); PG8_STAGE(PG8_SA(0, 1), a2 + hstep, voffA);
            PG8_WAIT_V(8); PG8_WAIT_L(0); PG8_BAR; PG8_MMA(0, 0, At, B0); PG8_MMA(0, 1, At, B1); PG8_BAR; PG8_SCHED;
            PG8_LDA(At, 1, 1); PG8_STAGE(PG8_SB(1, 0), b3, voffB); PG8_STAGE(PG8_SB(1, 1), b3 + hstep, voffB); PG8_STAGE(PG8_SA(1, 0), a3, voffA);
            PG8_WAIT_V(8); PG8_WAIT_L(0); PG8_BAR; PG8_MMA(1, 0, At, B0); PG8_MMA(1, 1, At, B1); PG8_BAR; PG8_SCHED;
            } else {
            PG8_LDB(B0, 0, 0); PG8_SCHED; PG8_LDA(At, 0, 0); PG8_STAGE(PG8_SA(1, 1), a1 + hstep, voffA);
            PG8_WAIT_L(8); PG8_BAR; PG8_WAIT_L(0); PG8_MMA(0, 0, At, B0); PG8_BAR; PG8_SCHED;
            PG8_LDB(B1, 0, 1); PG8_STAGE(PG8_SB(0, 0), b2, voffB);
            PG8_BAR; PG8_WAIT_L(0); PG8_MMA(0, 1, At, B1); PG8_BAR;
            PG8_LDA(At, 0, 1); PG8_STAGE(PG8_SA(0, 0), a2, voffA);
            PG8_BAR; PG8_WAIT_L(0); PG8_MMA(1, 0, At, B0); PG8_BAR; PG8_SCHED;
            PG8_STAGE(PG8_SB(0, 1), b2 + hstep, voffB);
            PG8_WAIT_V(6); PG8_BAR; PG8_MMA(1, 1, At, B1); PG8_BAR;
            PG8_LDB(B0, 1, 0); PG8_SCHED; PG8_LDA(At, 1, 0); PG8_STAGE(PG8_SA(0, 1), a2 + hstep, voffA);
            PG8_WAIT_L(8); PG8_BAR; PG8_WAIT_L(0); PG8_MMA(0, 0, At, B0); PG8_BAR; PG8_SCHED;
            PG8_LDB(B1, 1, 1); PG8_STAGE(PG8_SB(1, 0), b3, voffB);
            PG8_BAR; PG8_WAIT_L(0); PG8_MMA(0, 1, At, B1); PG8_BAR;
            PG8_LDA(At, 1, 1); PG8_STAGE(PG8_SA(1, 0), a3, voffA);
            PG8_BAR; PG8_WAIT_L(0); PG8_MMA(1, 0, At, B0); PG8_BAR; PG8_SCHED;
            PG8_STAGE(PG8_SB(1, 1), b3 + hstep, voffB);
            PG8_WAIT_V(6); PG8_BAR; PG8_MMA(1, 1, At, B1); PG8_BAR;
            }
        }
        if constexpr (ALIGN_EPI) { if (wr == 0) PG8_BAR; }
        if constexpr (!Epi::AFTER_DRAIN) { E(acc, cur, wr, wc, fr, fq); S.done(cur); }
        if (!has_next) break;
#pragma unroll
        for (int a = 0; a < 2; ++a)
#pragma unroll
            for (int b = 0; b < 2; ++b)
#pragma unroll
                for (int m = 0; m < 4; ++m)
#pragma unroll
                    for (int n = 0; n < 2; ++n) acc[a][b][m][n] = (f32x4){0.f, 0.f, 0.f, 0.f};
        cur = nxt; cA = nA; cB = nB; ++ui;
        if constexpr (ALIGN_EPI) { if (wr == 1) PG8_BAR; }
    }
    PG8_WAIT_V(0);
    if constexpr (!ALIGN_EPI) { if (wr == 0) PG8_BAR; }
    PG8_BAR;
    if constexpr (Epi::AFTER_DRAIN) { E.fused(acc, cur, wr, wc, fr, fq, lds, wid, lane); S.done(cur); }
#undef PG8_SA
#undef PG8_SB
#undef PG8_STAGE
#undef PG8_LDA
#undef PG8_LDB
#undef PG8_MMA
#undef PG8_WAIT_V
#undef PG8_WAIT_L
#undef PG8_BAR
#undef PG8_SCHED
}
}
namespace rec {
#define RLAS __attribute__((address_space(3)))
typedef unsigned short bf16;
typedef short bf16x8 __attribute__((ext_vector_type(8)));
typedef short s16x4 __attribute__((ext_vector_type(4)));
typedef float f32x4 __attribute__((ext_vector_type(4)));
typedef float f32x2 __attribute__((ext_vector_type(2)));
typedef unsigned u32x2 __attribute__((ext_vector_type(2)));
typedef unsigned u32x4 __attribute__((ext_vector_type(4)));
constexpr int PWID = 3584, DM = 1024;
constexpr float R_EPS = 1e-6f;

typedef __bf16 bf16x2_t __attribute__((ext_vector_type(2)));
__device__ __forceinline__ unsigned pkbf(float lo, float hi) { const f32x2 v = {lo, hi}; const bf16x2_t b = __builtin_convertvector(v, bf16x2_t); return __builtin_bit_cast(unsigned, b); }
__device__ __forceinline__ int otid() { int t = threadIdx.x; asm volatile("" : "+v"(t)); return t; }
__device__ __forceinline__ float bflo(unsigned u) { return __builtin_bit_cast(float, u << 16); }
__device__ __forceinline__ float bfhi(unsigned u) { return __builtin_bit_cast(float, u & 0xffff0000u); }

template <int DK> struct Lay {
    static constexpr int NP = DK / 2, NSEG = 512 / NP, TL = 64 / NSEG, SEGREF = 32 / TL - 1, NDT = DK / 16, NKS = DK / 32;
    static constexpr int PK = DK * 2 + 32, PV = 288, PP = 160, PO = 528;
    static constexpr int OFF_Q = 0, OFF_K = OFF_Q + 64 * PK, OFF_KH = OFF_K + 64 * PK, OFF_V = OFF_KH + 64 * PK, OFF_P = OFF_V + 64 * PV, OFF_O = OFF_P + 64 * PP,
                         OFF_SEG = OFF_O + 64 * PO, OFF_D = OFF_SEG + NSEG * DK * 4, OFF_E = OFF_D + DK * 4, OFF_END = OFF_E + DK * 4;
    static_assert(OFF_END <= 131072, "recurrence LDS map");
};

__device__ __forceinline__ bf16x8 tr_frag(RLAS unsigned char* img, int pitch, int k0, int n0, int lane) {
    const int g = lane >> 4, q = (lane & 15) >> 2, p = lane & 3;
    RLAS unsigned char* a = img + (k0 + 8 * g + q) * pitch + n0 * 2 + 8 * p;
    const s16x4 lo = __builtin_amdgcn_ds_read_tr16_b64_v4i16((RLAS s16x4*)a);
    const s16x4 hi = __builtin_amdgcn_ds_read_tr16_b64_v4i16((RLAS s16x4*)(a + 4 * pitch));
    return __builtin_shufflevector(lo, hi, 0, 1, 2, 3, 4, 5, 6, 7);
}

struct HeadIo {
    const bf16* P; const float* GA; bf16* MIX;
    int qoff, koff, voff, goff, ooff, gaoff;
    const float* onorm; float lb0, lb1;
};

#define REC_BAR() do { asm volatile("s_waitcnt lgkmcnt(0)" ::: "memory"); __builtin_amdgcn_s_barrier(); asm volatile("" ::: "memory"); } while (0)

template <int DK, bool HG, bool DO_OUT> struct Raw { unsigned q2[Lay<DK>::TL], k2[Lay<DK>::TL]; f32x2 av[Lay<DK>::TL]; u32x4 v0, v1, g0, g1; };

template <int DK, bool HG, bool DO_OUT>
__device__ __forceinline__ void load_raw(const HeadIo& io, size_t row0, int tvalid, Raw<DK, HG, DO_OUT>& w) {
    typedef Lay<DK> L;
    const int tid = otid(), dp = tid % L::NP, seg = tid / L::NP;
#pragma unroll
    for (int tt = 0; tt < L::TL; ++tt) {
        const int t = seg * L::TL + tt; const size_t row = row0 + t; const bool ok = t < tvalid;
        if (DO_OUT) w.q2[tt] = ok ? *(const unsigned*)(io.P + row * PWID + io.qoff + 2 * dp) : 0u;
        w.k2[tt] = ok ? *(const unsigned*)(io.P + row * PWID + io.koff + 2 * dp) : 0u;
        if (!HG) w.av[tt] = ok ? *(const f32x2*)(io.GA + row * 256 + io.gaoff + 2 * dp) : (f32x2){1.f, 1.f};
    }
    const int vr = tid >> 3, vc = (tid & 7) * 16; const bool vok = vr < tvalid;
    w.v0 = (u32x4){0u, 0u, 0u, 0u}; w.v1 = w.v0; w.g0 = w.v0; w.g1 = w.v0;
    if (vok) { const u32x4* src = (const u32x4*)(io.P + (row0 + vr) * PWID + io.voff + vc); w.v0 = src[0]; w.v1 = src[1];
        if (DO_OUT) { const u32x4* gp = (const u32x4*)(io.P + (row0 + vr) * PWID + io.goff + vc); w.g0 = gp[0]; w.g1 = gp[1]; } }
}

template <int DK, bool HG, bool DO_OUT>
__device__ __forceinline__ void chunk(RLAS unsigned char* lds, const HeadIo& io, const Raw<DK, HG, DO_OUT>& w, size_t row0, int tvalid, f32x4 (&S)[DK / 16], float& dtot) {
    typedef Lay<DK> L;
    const int tid = otid(), lane = tid & 63, wave = tid >> 6, r = lane & 15, g = lane >> 4, e0 = 16 * wave;
    const int dp = tid % L::NP, seg = tid / L::NP;
    {
        const int vr = tid >> 3, vc = (tid & 7) * 16;
        RLAS u32x4* dst = (RLAS u32x4*)(lds + L::OFF_V + vr * L::PV + vc * 2); dst[0] = w.v0; dst[1] = w.v1;
    }
    float kx[L::TL], ky[L::TL]; f32x2 pr[L::TL];
#pragma unroll
    for (int tt = 0; tt < L::TL; ++tt) {
        if (HG) {
            const bool ok = seg * L::TL + tt < tvalid;
            const float zx = fminf(fmaxf(bflo(w.k2[tt]), -30.f), 30.f), zy = fminf(fmaxf(bfhi(w.k2[tt]), -30.f), 30.f);
            const float ex = __expf(-zx), ey = __expf(-zy), sx = __builtin_amdgcn_rcpf(1.f + ex), sy = __builtin_amdgcn_rcpf(1.f + ey);
            kx[tt] = ok ? (1.f - io.lb0) * ex * sx : 0.f; ky[tt] = ok ? (1.f - io.lb1) * ey * sy : 0.f;
            pr[tt] = ok ? (f32x2){io.lb0 + (1.f - io.lb0) * sx, io.lb1 + (1.f - io.lb1) * sy} : (f32x2){1.f, 1.f};
        } else { kx[tt] = bflo(w.k2[tt]); ky[tt] = bfhi(w.k2[tt]); pr[tt] = w.av[tt]; }
    }
#pragma unroll
    for (int tt = 1; tt < L::TL; ++tt) pr[tt] *= pr[tt - 1];
    *(RLAS f32x2*)(lds + L::OFF_SEG + (seg * DK + 2 * dp) * 4) = pr[L::TL - 1];
    REC_BAR();
    f32x2 off = {1.f, 1.f}, aref = {1.f, 1.f}, alast = {1.f, 1.f};
#pragma unroll
    for (int s = 0; s < L::NSEG; ++s) { const f32x2 v = *(RLAS f32x2*)(lds + L::OFF_SEG + (s * DK + 2 * dp) * 4); if (s < seg) off *= v; if (s <= L::SEGREF) aref *= v; alast *= v; }
    const float irx = __builtin_amdgcn_rcpf(aref.x), iry = __builtin_amdgcn_rcpf(aref.y);
#pragma unroll
    for (int tt = 0; tt < L::TL; ++tt) {
        const int t = seg * L::TL + tt; const f32x2 at = off * pr[tt];
        const float ix = __builtin_amdgcn_rcpf(at.x), iy = __builtin_amdgcn_rcpf(at.y);
        if (DO_OUT) {
            *(RLAS unsigned*)(lds + L::OFF_Q + t * L::PK + 4 * dp) = pkbf(bflo(w.q2[tt]) * (at.x * irx), bfhi(w.q2[tt]) * (at.y * iry));
            *(RLAS unsigned*)(lds + L::OFF_K + t * L::PK + 4 * dp) = pkbf(kx[tt] * (ix * aref.x), ky[tt] * (iy * aref.y));
        }
        *(RLAS unsigned*)(lds + L::OFF_KH + t * L::PK + 4 * dp) = pkbf(kx[tt] * (ix * alast.x), ky[tt] * (iy * alast.y));
    }
    if (seg == 0) { *(RLAS f32x2*)(lds + L::OFF_D + 8 * dp) = alast; *(RLAS f32x2*)(lds + L::OFF_E + 8 * dp) = aref; }
    REC_BAR();
    if (tid < DK) dtot *= *(RLAS float*)(lds + L::OFF_D + 4 * tid);
    f32x4 O[4];
    if (DO_OUT) {
        const int it = wave >> 1;
#pragma unroll
        for (int jj = 0; jj < 2; ++jj) {
            const int jt = 2 * (wave & 1) + jj; f32x4 acc = {0.f, 0.f, 0.f, 0.f};
            if (jt <= it) {
#pragma unroll
                for (int s = 0; s < L::NKS; ++s) {
                    const bf16x8 kf = *(RLAS bf16x8*)(lds + L::OFF_K + (16 * jt + r) * L::PK + (32 * s + 8 * g) * 2);
                    const bf16x8 qf = *(RLAS bf16x8*)(lds + L::OFF_Q + (16 * it + r) * L::PK + (32 * s + 8 * g) * 2);
                    acc = __builtin_amdgcn_mfma_f32_16x16x32_bf16(kf, qf, acc, 0, 0, 0);
                }
            }
            const int i = 16 * it + r, j = 16 * jt + 4 * g;
            u32x2 pw; pw.x = pkbf(j <= i ? acc[0] : 0.f, j + 1 <= i ? acc[1] : 0.f); pw.y = pkbf(j + 2 <= i ? acc[2] : 0.f, j + 3 <= i ? acc[3] : 0.f);
            *(RLAS u32x2*)(lds + L::OFF_P + i * L::PP + j * 2) = pw;
        }
#pragma unroll
        for (int m = 0; m < 4; ++m) O[m] = (f32x4){0.f, 0.f, 0.f, 0.f};
#pragma unroll
        for (int s = 0; s < L::NKS; ++s) {
            const f32x4 ea = *(RLAS f32x4*)(lds + L::OFF_E + (32 * s + 4 * g) * 4), eb = *(RLAS f32x4*)(lds + L::OFF_E + (32 * s + 16 + 4 * g) * 4);
            const f32x4 sa = S[2 * s] * ea, sb = S[2 * s + 1] * eb;
            u32x4 sp; sp.x = pkbf(sa[0], sa[1]); sp.y = pkbf(sa[2], sa[3]); sp.z = pkbf(sb[0], sb[1]); sp.w = pkbf(sb[2], sb[3]);
            const bf16x8 sf = __builtin_bit_cast(bf16x8, sp);
#pragma unroll
            for (int m = 0; m < 4; ++m) {
                const s16x4 qlo = *(RLAS s16x4*)(lds + L::OFF_Q + (16 * m + r) * L::PK + (32 * s + 4 * g) * 2), qhi = *(RLAS s16x4*)(lds + L::OFF_Q + (16 * m + r) * L::PK + (32 * s + 16 + 4 * g) * 2);
                const bf16x8 qf = __builtin_shufflevector(qlo, qhi, 0, 1, 2, 3, 4, 5, 6, 7);
                O[m] = __builtin_amdgcn_mfma_f32_16x16x32_bf16(qf, sf, O[m], 0, 0, 0);
            }
        }
        REC_BAR();
    }
    const bf16x8 vf0 = tr_frag(lds + L::OFF_V, L::PV, 0, e0, lane), vf1 = tr_frag(lds + L::OFF_V, L::PV, 32, e0, lane);
    if (DO_OUT) {
#pragma unroll
        for (int m = 0; m < 4; ++m) {
            const bf16x8 p0 = *(RLAS bf16x8*)(lds + L::OFF_P + (16 * m + r) * L::PP + (8 * g) * 2), p1 = *(RLAS bf16x8*)(lds + L::OFF_P + (16 * m + r) * L::PP + (32 + 8 * g) * 2);
            O[m] = __builtin_amdgcn_mfma_f32_16x16x32_bf16(p0, vf0, O[m], 0, 0, 0);
            O[m] = __builtin_amdgcn_mfma_f32_16x16x32_bf16(p1, vf1, O[m], 0, 0, 0);
        }
    }
#pragma unroll
    for (int dt = 0; dt < L::NDT; ++dt) {
        const f32x4 dv = *(RLAS f32x4*)(lds + L::OFF_D + (16 * dt + 4 * g) * 4);
        const bf16x8 k0 = tr_frag(lds + L::OFF_KH, L::PK, 0, 16 * dt, lane), k1 = tr_frag(lds + L::OFF_KH, L::PK, 32, 16 * dt, lane);
        f32x4 acc = S[dt] * dv;
        acc = __builtin_amdgcn_mfma_f32_16x16x32_bf16(k0, vf0, acc, 0, 0, 0);
        acc = __builtin_amdgcn_mfma_f32_16x16x32_bf16(k1, vf1, acc, 0, 0, 0);
        S[dt] = acc;
    }
    if (DO_OUT) {
#pragma unroll
        for (int m = 0; m < 4; ++m)
#pragma unroll
            for (int ii = 0; ii < 4; ++ii) *(RLAS float*)(lds + L::OFF_O + (16 * m + 4 * g + ii) * L::PO + (e0 + r) * 4) = O[m][ii];
        REC_BAR();
        const int orow = tid >> 3, oc = (tid & 7) * 16;
        f32x4 ov[4]; float ss = 0.f;
#pragma unroll
        for (int c = 0; c < 4; ++c) { ov[c] = *(RLAS f32x4*)(lds + L::OFF_O + orow * L::PO + (oc + 4 * c) * 4); ss += (ov[c][0] * ov[c][0] + ov[c][1] * ov[c][1]) + (ov[c][2] * ov[c][2] + ov[c][3] * ov[c][3]); }
        ss += __shfl_xor(ss, 1); ss += __shfl_xor(ss, 2); ss += __shfl_xor(ss, 4);
        const float rs = rsqrtf(ss * (1.0f / 128.0f) + R_EPS);
        if (orow < tvalid) {
            const size_t row = row0 + orow;
            const unsigned gw[8] = {w.g0.x, w.g0.y, w.g0.z, w.g0.w, w.g1.x, w.g1.y, w.g1.z, w.g1.w};
            unsigned ow[8];
#pragma unroll
            for (int c = 0; c < 8; ++c) {
                const float ga = bflo(gw[c]), gb = bfhi(gw[c]);
                const float oa = ov[c >> 1][(c & 1) * 2] * rs * io.onorm[oc + 2 * c] * (ga * __builtin_amdgcn_rcpf(1.f + __expf(-ga)));
                const float ob = ov[c >> 1][(c & 1) * 2 + 1] * rs * io.onorm[oc + 2 * c + 1] * (gb * __builtin_amdgcn_rcpf(1.f + __expf(-gb)));
                ow[c] = pkbf(oa, ob);
            }
            u32x4* op = (u32x4*)(io.MIX + row * DM + io.ooff + oc);
            op[0] = (u32x4){ow[0], ow[1], ow[2], ow[3]}; op[1] = (u32x4){ow[4], ow[5], ow[6], ow[7]};
        }
    } else {
        REC_BAR();
    }
}

template <int NDT> __device__ __forceinline__ void load_state(f32x4 (&S)[NDT], const float* mem) {
    const int tid_ = otid(), lane = tid_ & 63, wave = tid_ >> 6, r = lane & 15, g = lane >> 4;
#pragma unroll
    for (int dt = 0; dt < NDT; ++dt)
#pragma unroll
        for (int i = 0; i < 4; ++i) S[dt][i] = mem ? mem[(16 * dt + 4 * g + i) * 128 + 16 * wave + r] : 0.f;
}
template <int NDT> __device__ __forceinline__ void store_state(const f32x4 (&S)[NDT], float* mem) {
    const int tid_ = otid(), lane = tid_ & 63, wave = tid_ >> 6, r = lane & 15, g = lane >> 4;
#pragma unroll
    for (int dt = 0; dt < NDT; ++dt)
#pragma unroll
        for (int i = 0; i < 4; ++i) mem[(16 * dt + 4 * g + i) * 128 + 16 * wave + r] = S[dt][i];
}

struct RecArgs {
    const bf16* P; const float* GA; bf16* MIX; const float* lbl; const float* gla_onorm; const float* hg_onorm;
    const float* st_gla_in; const float* st_hg_in; float* ST; float* DT; float* out_sgp; float* out_shp; float* out_sgs; float* out_shs;
};
constexpr int SC_TOK = 256, NCH = SC_TOK / 64, NSC = 8192 / SC_TOK, ST_PER = 4 * 64 * 128 + 4 * 128 * 128, DT_PER = 4 * 64 + 4 * 128;

template <int DK, bool HG> __device__ __forceinline__ HeadIo make_io(const RecArgs& a, int h) {
    HeadIo io; io.P = a.P; io.GA = a.GA; io.MIX = a.MIX;
    if (HG) { io.qoff = 1536 + h * 128; io.koff = 2048 + h * 128; io.voff = 2560 + h * 128; io.goff = 3072 + h * 128; io.ooff = 512 + h * 128; io.gaoff = 0; io.onorm = a.hg_onorm;
        const int d = 2 * (otid() % (DK / 2)); const float l0 = a.lbl[h * 128 + d], l1 = a.lbl[512 + h * 128 + d], m0 = a.lbl[h * 128 + d + 1], m1 = a.lbl[512 + h * 128 + d + 1];
        io.lb0 = 1.0f / (1.0f + __expf(l1 - l0)); io.lb1 = 1.0f / (1.0f + __expf(m1 - m0)); }
    else { io.qoff = h * 64; io.koff = 256 + h * 64; io.voff = 512 + h * 128; io.goff = 1024 + h * 128; io.ooff = h * 128; io.gaoff = h * 64; io.onorm = a.gla_onorm; io.lb0 = 0.f; io.lb1 = 0.f; }
    return io;
}

template <int DK, bool HG> __device__ __forceinline__ void r1_unit(RLAS unsigned char* lds, const RecArgs& a, int seq, int sc, int h) {
    const HeadIo io = make_io<DK, HG>(a, h);
    f32x4 S[DK / 16]; load_state<DK / 16>(S, nullptr); float dtot = 1.f;
    const size_t rb = (size_t)seq * 8192 + sc * SC_TOK;
    Raw<DK, HG, false> cur, nxt; load_raw<DK, HG, false>(io, rb, 64, cur);
#pragma unroll 1
    for (int c = 0; c < NCH; ++c) { if (c + 1 < NCH) load_raw<DK, HG, false>(io, rb + (c + 1) * 64, 64, nxt); chunk<DK, HG, false>(lds, io, cur, rb + c * 64, 64, S, dtot); cur = nxt; }
    const size_t u = (size_t)seq * NSC + sc;
    store_state<DK / 16>(S, a.ST + u * ST_PER + (HG ? 32768 + h * 16384 : h * 8192));
    { const int t_ = otid(); if (t_ < DK) a.DT[u * DT_PER + (HG ? 256 + h * 128 : h * 64) + t_] = dtot; }
}
template <int DK, bool HG> __device__ __forceinline__ void r3_unit(RLAS unsigned char* lds, const RecArgs& a, int seq, int sc, int h) {
    const HeadIo io = make_io<DK, HG>(a, h);
    const size_t u = (size_t)seq * NSC + sc;
    f32x4 S[DK / 16]; load_state<DK / 16>(S, a.ST + u * ST_PER + (HG ? 32768 + h * 16384 : h * 8192)); float dtot = 1.f;
    const size_t rb = (size_t)seq * 8192 + sc * SC_TOK;
    Raw<DK, HG, true> cur, nxt; load_raw<DK, HG, true>(io, rb, 64, cur);
#pragma unroll 1
    for (int c = 0; c < NCH; ++c) { if (c + 1 < NCH) load_raw<DK, HG, true>(io, rb + (c + 1) * 64, 64, nxt); chunk<DK, HG, true>(lds, io, cur, rb + c * 64, 64, S, dtot); cur = nxt; }
    if (sc == NSC - 1) store_state<DK / 16>(S, (HG ? a.out_shp : a.out_sgp) + (size_t)(seq * 4 + h) * DK * 128);
}
template <int DK, bool HG> __device__ __forceinline__ void rs_unit(RLAS unsigned char* lds, const RecArgs& a, int seq, int h) {
    const HeadIo io = make_io<DK, HG>(a, h);
    f32x4 S[DK / 16]; load_state<DK / 16>(S, (HG ? a.st_hg_in : a.st_gla_in) + (size_t)(seq * 4 + h) * DK * 128); float dtot = 1.f;
    Raw<DK, HG, true> cur; load_raw<DK, HG, true>(io, (size_t)32768 + seq * 32, 32, cur);
    chunk<DK, HG, true>(lds, io, cur, (size_t)32768 + seq * 32, 32, S, dtot);
    store_state<DK / 16>(S, (HG ? a.out_shs : a.out_sgs) + (size_t)(seq * 4 + h) * DK * 128);
}
__device__ __forceinline__ void decode_unit(int u, int& scidx, int& head) { scidx = u >> 3; head = ((u & 7) + 4 * ((u >> 8) & 1)) & 7; }

__device__ __forceinline__ void phase_r1(RLAS unsigned char* lds, const RecArgs& a, int G, int bx) {
    for (int u = bx; u < 4 * NSC * 8; u += G) { int scidx, head; decode_unit(u, scidx, head); const int seq = scidx / NSC, sc = scidx % NSC;
        if (sc == NSC - 1) continue;
        if (head < 4) r1_unit<64, false>(lds, a, seq, sc, head); else r1_unit<128, true>(lds, a, seq, sc, head - 4); }
}
__device__ __forceinline__ void phase_r2(const RecArgs& a, int gtid, int NGT) {
    for (int idx = gtid; idx < 4 * ST_PER; idx += NGT) {
        const int seq = idx / ST_PER, off = idx % ST_PER; int dti;
        if (off < 32768) dti = (off / 8192) * 64 + (off % 8192) / 128; else { const int o2 = off - 32768; dti = 256 + (o2 / 16384) * 128 + (o2 % 16384) / 128; }
        float x = 0.f;
        for (int s0 = 0; s0 < NSC; s0 += 8) {
            float tmp[8], dd[8];
#pragma unroll
            for (int j = 0; j < 8; ++j) { const size_t u = (size_t)seq * NSC + s0 + j; const bool has = (s0 + j) < NSC - 1; tmp[j] = has ? a.ST[u * ST_PER + off] : 0.f; dd[j] = has ? a.DT[u * DT_PER + dti] : 0.f; }
#pragma unroll
            for (int j = 0; j < 8; ++j) { const size_t u = (size_t)seq * NSC + s0 + j; a.ST[u * ST_PER + off] = x; x = dd[j] * x + tmp[j]; }
        }
    }
}
__device__ __forceinline__ void phase_r3(RLAS unsigned char* lds, const RecArgs& a, int G, int bx) {
    for (int u = bx; u < 4 * NSC * 8; u += G) { int scidx, head; decode_unit(u, scidx, head); const int seq = scidx / NSC, sc = scidx % NSC;
        if (head < 4) r3_unit<64, false>(lds, a, seq, sc, head); else r3_unit<128, true>(lds, a, seq, sc, head - 4); }
    for (int u = bx; u < 64; u += G) { const int seq = u >> 3, head = u & 7;
        if (head < 4) rs_unit<64, false>(lds, a, seq, head); else rs_unit<128, true>(lds, a, seq, head - 4); }
}
}
namespace sg {
typedef unsigned short bf16;
typedef short bf16x8 __attribute__((ext_vector_type(8)));
typedef float f32x4 __attribute__((ext_vector_type(4)));
typedef unsigned u32x2 __attribute__((ext_vector_type(2)));
typedef unsigned u32x4 __attribute__((ext_vector_type(4)));
__device__ __forceinline__ int otid() { int t = threadIdx.x; asm volatile("" : "+v"(t)); return t; }
__device__ __forceinline__ unsigned pkbf(float lo, float hi) { return rec::pkbf(lo, hi); }
__device__ __forceinline__ float silu_f(float g) { return g * __builtin_amdgcn_rcpf(1.0f + __expf(-g)); }

constexpr int SPITCH = 272, WREG = 64 * SPITCH;
template <int NT, class Epi>
__device__ __forceinline__ void unit(__attribute__((address_space(3))) unsigned char* lds, const bf16* A, int K, const bf16* bt0, const bf16* bt1, const Epi& E) {
    typedef __attribute__((address_space(3))) unsigned char* lptr;
    const int tid = otid(), lane = tid & 63, wave = tid >> 6, r = lane & 15, g = lane >> 4;
    constexpr int NL = 8 + 4 * NT;
    const lptr img = lds + wave * WREG;
    const bf16* gp[NL];
#pragma unroll
    for (int j = 0; j < NL; ++j) { const int row = 4 * j + g;
        const bf16* base = (j < 8) ? A + (size_t)(32 * wave + row) * K : (j < 12 ? bt0 + (size_t)(row - 32) * K : bt1 + (size_t)(row - 48) * K);
        gp[j] = base + 8 * r; }
    const lptr wp = img + g * SPITCH + 16 * r;
    f32x4 acc[2][NT];
#pragma unroll
    for (int mt = 0; mt < 2; ++mt)
#pragma unroll
        for (int nt = 0; nt < NT; ++nt) acc[mt][nt] = (f32x4){0.f, 0.f, 0.f, 0.f};
    u32x4 st[NL];
    const int nb = K / 128;
#pragma unroll
    for (int j = 0; j < NL; ++j) st[j] = *(const u32x4*)(gp[j]);
#pragma unroll 1
    for (int b = 0; b < nb; ++b) {
#pragma unroll
        for (int j = 0; j < NL; ++j) *(__attribute__((address_space(3))) u32x4*)(wp + 4 * j * SPITCH) = st[j];
        if (b + 1 < nb) {
#pragma unroll
            for (int j = 0; j < NL; ++j) st[j] = *(const u32x4*)(gp[j] + (size_t)(b + 1) * 128);
        }
        asm volatile("s_waitcnt lgkmcnt(0)" ::: "memory");
#pragma unroll
        for (int u = 0; u < 4; ++u) {
            bf16x8 af[2], bfr[NT];
#pragma unroll
            for (int mt = 0; mt < 2; ++mt) af[mt] = *(const __attribute__((address_space(3))) bf16x8*)(img + (16 * mt + r) * SPITCH + (4 * u + g) * 16);
#pragma unroll
            for (int nt = 0; nt < NT; ++nt) bfr[nt] = *(const __attribute__((address_space(3))) bf16x8*)(img + (32 + 16 * nt + r) * SPITCH + (4 * u + g) * 16);
#pragma unroll
            for (int mt = 0; mt < 2; ++mt)
#pragma unroll
                for (int nt = 0; nt < NT; ++nt) acc[mt][nt] = __builtin_amdgcn_mfma_f32_16x16x32_bf16(bfr[nt], af[mt], acc[mt][nt], 0, 0, 0);
        }
        asm volatile("s_waitcnt lgkmcnt(0)" ::: "memory");
    }
    E(acc, wave, r, g);
}

struct EpiUpS {
    bf16* H; int ldh; const float* ssq; int hc0;
    __device__ __forceinline__ void operator()(const f32x4 (&acc)[2][2], int wave, int r, int g) const {
#pragma unroll
        for (int mt = 0; mt < 2; ++mt) { const int row = 32 * wave + 16 * mt + r; const float rs = rsqrtf(ssq[row] * (1.0f / 1024.0f) + 1e-6f);
            float h[4];
#pragma unroll
            for (int i = 0; i < 4; ++i) h[i] = silu_f(acc[mt][0][i] * rs) * (acc[mt][1][i] * rs);
            *(u32x2*)(H + (size_t)row * ldh + hc0 + 4 * g) = (u32x2){pkbf(h[0], h[1]), pkbf(h[2], h[3])}; }
    }
};
struct EpiResS {
    const float* xf; bf16* xb; float* ssq; float scale; int c0;
    __device__ __forceinline__ void operator()(const f32x4 (&acc)[2][1], int wave, int r, int g) const {
#pragma unroll
        for (int mt = 0; mt < 2; ++mt) { const int row = 32 * wave + 16 * mt + r; const size_t off = (size_t)row * 1024 + c0 + 4 * g; f32x4 res;
            if (xf) res = *(const f32x4*)(xf + off);
            else { const u32x2 rb = *(const u32x2*)(xb + off); res = (f32x4){__builtin_bit_cast(float, rb.x << 16), __builtin_bit_cast(float, rb.x & 0xffff0000u), __builtin_bit_cast(float, rb.y << 16), __builtin_bit_cast(float, rb.y & 0xffff0000u)}; }
            const f32x4 v = res + acc[mt][0] * scale;
            float s = (v[0] * v[0] + v[1] * v[1]) + (v[2] * v[2] + v[3] * v[3]);
            s += __shfl_xor(s, 16); s += __shfl_xor(s, 32);
            if (g == 0) __hip_atomic_fetch_add(ssq + row, s, __ATOMIC_RELAXED, __HIP_MEMORY_SCOPE_AGENT);
            *(u32x2*)(xb + off) = (u32x2){pkbf(v[0], v[1]), pkbf(v[2], v[3])}; }
    }
};
struct EpiWinS {
    bf16* P; float* GA; const float* ssq; const float* gbias; int c0;
    __device__ __forceinline__ void operator()(const f32x4 (&acc)[2][2], int wave, int r, int g) const {
        const int pn = c0 >> 8;
#pragma unroll
        for (int mt = 0; mt < 2; ++mt) { const int row = 32 * wave + 16 * mt + r; const float rs = rsqrtf(ssq[row] * (1.0f / 1024.0f) + 1e-6f);
#pragma unroll
            for (int nt = 0; nt < 2; ++nt) { const int col = c0 + 16 * nt + 4 * g; f32x4 v = acc[mt][nt] * rs;
                if (pn == 14) { const int tc = col & 255; f32x4 o;
#pragma unroll
                    for (int i = 0; i < 4; ++i) { const float x = v[i] + gbias[tc + i]; const float ls = fminf(x, 0.f) - __logf(1.0f + __expf(-fabsf(x))); o[i] = __expf(ls * 0.0625f); }
                    *(f32x4*)(GA + (size_t)row * 256 + tc) = o;
                } else {
                    if (pn == 0) v = v * 0.125f;
                    else if (pn == 6 || pn == 7) { v[0] = silu_f(v[0]); v[1] = silu_f(v[1]); v[2] = silu_f(v[2]); v[3] = silu_f(v[3]); }
                    *(u32x2*)(P + (size_t)row * 3584 + col) = (u32x2){pkbf(v[0], v[1]), pkbf(v[2], v[3])};
                } } }
    }
};
}
#define GAS __attribute__((address_space(1)))
#define LAS __attribute__((address_space(3)))
typedef unsigned short bf16;
typedef unsigned v4u __attribute__((ext_vector_type(4)));
typedef float f32x4 __attribute__((ext_vector_type(4)));
constexpr int NWAVES = 8;
constexpr int D = 1024, FF = 2816, MP = 32768, MS = 256, M = MP + MS, PW = 3584, NIN = 3840, DINSRC = 3600;
constexpr float EPS = 1e-6f;
constexpr size_t MiB = 1u << 20;
constexpr size_t WS_SSQ = 0, SSQ_STRIDE = (size_t)M * 4;
constexpr size_t WS_WGU1 = 1 * MiB, WS_WD1 = 12 * MiB, WS_WIN = 18 * MiB, WS_WO = 26 * MiB, WS_WGU2 = 28 * MiB, WS_WD2 = 39 * MiB;
constexpr size_t WS_XB = 45 * MiB, WS_MIX = 110 * MiB, WS_P = 175 * MiB, WS_HID = WS_P, WS_GA = 401 * MiB, WS_ST = 434 * MiB, WS_DT = 483 * MiB, WS_DUMMY = 484 * MiB, WS_END = 512 * MiB;
static_assert(WS_P + (size_t)M * PW * 2 <= WS_GA && WS_GA + (size_t)M * 256 * 4 <= WS_ST && WS_XB + (size_t)M * D * 2 <= WS_MIX && WS_MIX + (size_t)M * D * 2 <= WS_P, "ws map");
constexpr size_t O_Y = 0, O_SGP = (size_t)M * D, O_SHP = O_SGP + 4 * 4 * 64 * 128, O_SGS = O_SHP + 4 * 4 * 128 * 128, O_SHS = O_SGS + 8 * 4 * 64 * 128, O_END = O_SHS + 8 * 4 * 128 * 128;
constexpr int LDS_BYTES = 147456;

__device__ __forceinline__ unsigned f2bf(float f) { unsigned u = __builtin_bit_cast(unsigned, f); return (u + 0x7fffu + ((u >> 16) & 1u)) >> 16; }
__device__ __forceinline__ unsigned pk2(float lo, float hi) { return f2bf(lo) | (f2bf(hi) << 16); }
__device__ __forceinline__ float bf2f(bf16 b) { return __builtin_bit_cast(float, (unsigned)b << 16); }
#define LDS_WAIT() asm volatile("s_waitcnt lgkmcnt(0)" ::: "memory")

#ifndef DUPMASK
#define DUPMASK 0
#endif
struct Args { const float* in[21]; float* out; unsigned char* ws; int ph_lo, ph_hi, dup, pad; };
typedef const Args __attribute__((address_space(4))) CArgs;

__device__ __forceinline__ float wave_sum(float v) {
#pragma unroll
    for (int o = 1; o < 64; o <<= 1) v += __shfl_xor(v, o);
    return v;
}
__device__ __forceinline__ void tr_item(const float* W, int ldw, int src_col0, int k0, const float* gain, bf16* WT, int K, int dst_row0, LAS float* scr, int lane) {
    float w[32];
    const float* wp = W + (size_t)(k0 + (lane >> 5)) * ldw + src_col0 + (lane & 31);
#pragma unroll
    for (int i = 0; i < 32; ++i) w[i] = __builtin_nontemporal_load(wp + (size_t)(2 * i) * ldw);
    if (gain) {
#pragma unroll
        for (int i = 0; i < 32; ++i) w[i] *= gain[k0 + 2 * i + (lane >> 5)];
    }
#pragma unroll
    for (int i = 0; i < 32; ++i) scr[(2 * i + (lane >> 5)) * 33 + (lane & 31)] = w[i];
    LDS_WAIT(); asm volatile("" ::: "memory");
    const int c = lane & 7;
#pragma unroll
    for (int j = 0; j < 4; ++j) { const int n = (lane >> 3) + 8 * j; const LAS float* s = scr + (8 * c) * 33 + n;
        v4u o; o.x = pk2(s[0 * 33], s[1 * 33]); o.y = pk2(s[2 * 33], s[3 * 33]); o.z = pk2(s[4 * 33], s[5 * 33]); o.w = pk2(s[6 * 33], s[7 * 33]);
        *(v4u*)(WT + (size_t)(dst_row0 + n) * K + k0 + 8 * c) = o; }
    LDS_WAIT(); asm volatile("" ::: "memory");
}
__device__ __forceinline__ void weff_item(const float* Win, const float* up, int n0, int k0, const float* gain, bf16* WT, LAS float* scr, int lane) {
    float upr[16];
#pragma unroll
    for (int r = 0; r < 16; ++r) upr[r] = up[r * 256 + n0 + (lane & 31)];
#pragma unroll 4
    for (int i = 0; i < 32; ++i) { const int kk = 2 * i + (lane >> 5); const float* wr = Win + (size_t)(k0 + kk) * DINSRC + 1536; float s = 0.f;
#pragma unroll
        for (int r = 0; r < 16; ++r) s += wr[r] * upr[r];
        scr[kk * 33 + (lane & 31)] = s * gain[k0 + kk]; }
    LDS_WAIT(); asm volatile("" ::: "memory");
    const int c = lane & 7;
#pragma unroll
    for (int j = 0; j < 4; ++j) { const int n = (lane >> 3) + 8 * j; const LAS float* s = scr + (8 * c) * 33 + n;
        v4u o; o.x = pk2(s[0 * 33], s[1 * 33]); o.y = pk2(s[2 * 33], s[3 * 33]); o.z = pk2(s[4 * 33], s[5 * 33]); o.w = pk2(s[6 * 33], s[7 * 33]);
        *(v4u*)(WT + (size_t)(3584 + n0 + n) * 1024 + k0 + 8 * c) = o; }
    LDS_WAIT(); asm volatile("" ::: "memory");
}
__device__ __forceinline__ void gu_item(int r, const float* wg, const float* wu, const float* gain, bf16* WT, LAS float* scr, int lane) {
    const int kb = r / 176, nb = r % 176, dst = 32 * nb, tile = dst >> 8, j = dst & 255;
    const float* W = (j < 128) ? wg : wu; const int src = tile * 128 + (j & 127);
    tr_item(W, FF, src, 64 * kb, gain, WT, D, dst, scr, lane);
}

__device__ __forceinline__ int opaque_tid() { int t = threadIdx.x; asm volatile("" : "+v"(t)); return t; }
__device__ __forceinline__ void p0_prologue(CArgs& a, LAS unsigned char* lds, int G, int bx) {
    const int tid = opaque_tid(), lane = tid & 63, wave = __builtin_amdgcn_readfirstlane(tid >> 6);
    const int gw = bx * NWAVES + wave, NGW = G * NWAVES, gtid = bx * (NWAVES * 64) + tid, NGT = G * NWAVES * 64;
    LAS float* scr = (LAS float*)(lds + wave * 16384);
    unsigned char* ws = a.ws;
    constexpr int I_GU = 16 * 176, I_D = 44 * 32, I_IN = 16 * 112, I_EFF = 16 * 8, I_O = 16 * 32;
    constexpr int NITEMS = 2 * I_GU + 2 * I_D + I_IN + I_EFF + I_O;
    for (int it = gw; it < NITEMS; it += NGW) {
        int r = it; asm volatile("" : "+s"(ws));
        if (r < I_GU) { gu_item(r, a.in[5], a.in[6], a.in[4], (bf16*)(ws + WS_WGU1), scr, lane); continue; } r -= I_GU;
        if (r < I_D) { tr_item(a.in[7], D, 32 * (r % 32), 64 * (r / 32), nullptr, (bf16*)(ws + WS_WD1), FF, 32 * (r % 32), scr, lane); continue; } r -= I_D;
        if (r < I_IN) { const int kb = r / 112, nb = r % 112, dst = 32 * nb, src = dst < 1536 ? dst : dst + 16;
            tr_item(a.in[9], DINSRC, src, 64 * kb, a.in[8], (bf16*)(ws + WS_WIN), D, dst, scr, lane); continue; } r -= I_IN;
        if (r < I_EFF) { weff_item(a.in[9], a.in[10], 32 * (r % 8), 64 * (r / 8), a.in[8], (bf16*)(ws + WS_WIN), scr, lane); continue; } r -= I_EFF;
        if (r < I_O) { tr_item(a.in[15], D, 32 * (r % 32), 64 * (r / 32), nullptr, (bf16*)(ws + WS_WO), D, 32 * (r % 32), scr, lane); continue; } r -= I_O;
        if (r < I_GU) { gu_item(r, a.in[17], a.in[18], a.in[16], (bf16*)(ws + WS_WGU2), scr, lane); continue; } r -= I_GU;
        tr_item(a.in[19], D, 32 * (r % 32), 64 * (r / 32), nullptr, (bf16*)(ws + WS_WD2), FF, 32 * (r % 32), scr, lane);
    }
    float* ssq1 = (float*)(ws + WS_SSQ); bf16* XB = (bf16*)(ws + WS_XB);
    for (int m0 = 2 * gw; m0 < M; m0 += 2 * NGW) {
        f32x4 v[2][4]; float s[2];
#pragma unroll
        for (int h = 0; h < 2; ++h) { const int m = m0 + h;
            const float* xrow = (m < MP) ? a.in[0] + (size_t)m * D : a.in[1] + (size_t)(m - MP) * D;
            const f32x4* xr = (const f32x4*)xrow + lane;
#pragma unroll
            for (int j = 0; j < 4; ++j) v[h][j] = __builtin_nontemporal_load(xr + 64 * j); }
#pragma unroll
        for (int h = 0; h < 2; ++h) { const int m = m0 + h; float ss = 0.f;
#pragma unroll
            for (int j = 0; j < 4; ++j) ss += (v[h][j].x * v[h][j].x + v[h][j].y * v[h][j].y) + (v[h][j].z * v[h][j].z + v[h][j].w * v[h][j].w);
            s[h] = wave_sum(ss);
            unsigned long long* o8 = (unsigned long long*)(XB + (size_t)m * D) + lane;
#pragma unroll
            for (int j = 0; j < 4; ++j) o8[64 * j] = (unsigned long long)pk2(v[h][j].x, v[h][j].y) | ((unsigned long long)pk2(v[h][j].z, v[h][j].w) << 32);
            if (lane == 0) ssq1[m] = s[h]; }
    }
    for (int i = gtid; i < 3 * M; i += NGT) ssq1[M + i] = 0.f;
}

__device__ __forceinline__ void p8_final(CArgs& a, int G, int bx) {
    const int tid = opaque_tid(), lane = tid & 63, wave = __builtin_amdgcn_readfirstlane(tid >> 6);
    const int gw = bx * NWAVES + wave, NGW = G * NWAVES;
    const float* ssq4 = (const float*)(a.ws + WS_SSQ) + 3 * (size_t)M; const bf16* XB = (const bf16*)(a.ws + WS_XB);
    const f32x4* g = (const f32x4*)a.in[20] + 2 * lane;
    f32x4 gv[2][2];
#pragma unroll
    for (int j = 0; j < 2; ++j) { gv[j][0] = g[128 * j]; gv[j][1] = g[128 * j + 1]; }
    for (int m0 = 2 * gw; m0 < M; m0 += 2 * NGW) {
        v4u xv[2][2];
#pragma unroll
        for (int h = 0; h < 2; ++h)
#pragma unroll
            for (int j = 0; j < 2; ++j) xv[h][j] = __builtin_nontemporal_load((const v4u*)(XB + (size_t)(m0 + h) * D) + lane + 64 * j);
#pragma unroll
        for (int h = 0; h < 2; ++h) { const float rs = rsqrtf(ssq4[m0 + h] * (1.0f / 1024.0f) + EPS); f32x4* yr = (f32x4*)(a.out + (size_t)(m0 + h) * D) + 2 * lane;
#pragma unroll
            for (int j = 0; j < 2; ++j) { const v4u x = xv[h][j];
                const f32x4 lo = {__builtin_bit_cast(float, x.x << 16), __builtin_bit_cast(float, x.x & 0xffff0000u), __builtin_bit_cast(float, x.y << 16), __builtin_bit_cast(float, x.y & 0xffff0000u)};
                const f32x4 hi = {__builtin_bit_cast(float, x.z << 16), __builtin_bit_cast(float, x.z & 0xffff0000u), __builtin_bit_cast(float, x.w << 16), __builtin_bit_cast(float, x.w & 0xffff0000u)};
                __builtin_nontemporal_store(lo * rs * gv[j][0], yr + 128 * j); __builtin_nontemporal_store(hi * rs * gv[j][1], yr + 128 * j + 1); } }
    }
}

__device__ __forceinline__ CArgs& kargs() { CArgs* p = (CArgs*)__builtin_amdgcn_kernarg_segment_ptr(); asm volatile("" : "+s"(p)); return *p; }
__global__ void __launch_bounds__(NWAVES * 64, 2) mega_fwd(Args args_unused) {
    extern __shared__ __attribute__((aligned(16))) unsigned char lds_raw[];
    cg::grid_group grid = cg::this_grid();
    LAS unsigned char* lds = (LAS unsigned char*)lds_raw;
    const int G = gridDim.x, bx = blockIdx.x;
    const int lo = kargs().ph_lo, hi = kargs().ph_hi, dup = kargs().dup;
#define IN(k) (lo <= (k) && (k) < hi)
#define BOTH(k) (IN(k) && IN((k) + 1))
#define GRID_BAR() grid.sync()
#define REP(k) for (int rep_ = ((dup >> (k)) & 1); rep_ >= 0; --rep_)
#define SSQ(a, i) ((float*)((a).ws + WS_SSQ) + (size_t)(i) * M)

    if (IN(0)) REP(0) { p0_prologue(kargs(), lds, G, bx); if (BOTH(0)) GRID_BAR(); }
    if (IN(1)) REP(1) {
        CArgs& a = kargs(); unsigned char* ws = a.ws;
        pg8::Gemm g{(const bf16*)(ws + WS_XB), (const bf16*)(ws + WS_WGU1), MP, 2 * FF, D}; pg8::StaticOrder S; S.init(MP, 2 * FF, G, bx);
        pg8::EpiUp E{(bf16*)(ws + WS_HID), FF, SSQ(a, 0)};
        pg8::gemm_phase<pg8::EpiUp, pg8::StaticOrder, true, true>(lds, g, S, E);
        for (int u = bx; u < FF / 16; u += G) { const int hc0 = 16 * u; const bf16* W = (const bf16*)(ws + WS_WGU1) + (size_t)((hc0 >> 7) * 256 + (hc0 & 127)) * D;
            sg::EpiUpS Es{(bf16*)(ws + WS_HID) + (size_t)MP * FF, FF, SSQ(a, 0) + MP, hc0}; sg::unit<2>(lds, (const bf16*)(ws + WS_XB) + (size_t)MP * D, D, W, W + (size_t)128 * D, Es); }
        if (BOTH(1)) GRID_BAR();
    }
    if (IN(2)) REP(2) {
        CArgs& a = kargs(); unsigned char* ws = a.ws;
        pg8::Gemm g{(const bf16*)(ws + WS_HID), (const bf16*)(ws + WS_WD1), MP, D, FF}; pg8::StaticOrder S; S.init(MP, D, G, bx);
        pg8::EpiRes E{a.in[0], a.in[1], MP / 256, (bf16*)(ws + WS_XB), rep_ ? (float*)(ws + WS_DUMMY) : SSQ(a, 1), rep_ ? 0.f : 0.5f};
        pg8::gemm_phase<pg8::EpiRes, pg8::StaticOrder, true, true>(lds, g, S, E);
        for (int u = bx; u < D / 16; u += G) { const int c0 = 16 * u; const bf16* W = (const bf16*)(ws + WS_WD1) + (size_t)c0 * FF;
            sg::EpiResS Es{a.in[1], (bf16*)(ws + WS_XB) + (size_t)MP * D, (rep_ ? (float*)(ws + WS_DUMMY) : SSQ(a, 1)) + MP, rep_ ? 0.f : 0.5f, c0}; sg::unit<1>(lds, (const bf16*)(ws + WS_HID) + (size_t)MP * FF, FF, W, W, Es); }
        if (BOTH(2)) GRID_BAR();
    }
    if (IN(3)) REP(3) {
        CArgs& a = kargs(); unsigned char* ws = a.ws;
        pg8::Gemm g{(const bf16*)(ws + WS_XB), (const bf16*)(ws + WS_WIN), MP, NIN, D}; pg8::StaticOrder S; S.init(MP, NIN, G, bx);
        pg8::EpiWin E{(bf16*)(ws + WS_P), (float*)(ws + WS_GA), SSQ(a, 1), a.in[11]};
        pg8::gemm_phase<pg8::EpiWin, pg8::StaticOrder, true, true>(lds, g, S, E);
        for (int u = (bx + G / 2) % G; u < NIN / 32; u += G) { const int c0 = 32 * u; const bf16* W = (const bf16*)(ws + WS_WIN) + (size_t)c0 * D;
            sg::EpiWinS Es{(bf16*)(ws + WS_P) + (size_t)MP * PW, (float*)(ws + WS_GA) + (size_t)MP * 256, SSQ(a, 1) + MP, a.in[11], c0}; sg::unit<2>(lds, (const bf16*)(ws + WS_XB) + (size_t)MP * D, D, W, W + (size_t)16 * D, Es); }
        if (BOTH(3)) GRID_BAR();
    }
#define MAKE_RA(a) rec::RecArgs ra{(const bf16*)((a).ws + WS_P), (const float*)((a).ws + WS_GA), (bf16*)((a).ws + WS_MIX), (a).in[13], (a).in[12], (a).in[14], (a).in[2], (a).in[3], \
                        (float*)((a).ws + WS_ST), (float*)((a).ws + WS_DT), (a).out + O_SGP, (a).out + O_SHP, (a).out + O_SGS, (a).out + O_SHS}
    if (IN(4)) REP(4) { CArgs& a = kargs(); MAKE_RA(a); rec::phase_r1(lds, ra, G, bx); if (BOTH(4)) GRID_BAR(); }
    if (IN(5)) { CArgs& a = kargs(); MAKE_RA(a); rec::phase_r2(ra, bx * (NWAVES * 64) + opaque_tid(), G * NWAVES * 64); if (BOTH(5)) GRID_BAR(); }
    if (IN(6)) REP(6) { CArgs& a = kargs(); MAKE_RA(a); rec::phase_r3(lds, ra, G, bx); if (BOTH(6)) GRID_BAR(); }
    if (IN(7)) REP(7) {
        CArgs& a = kargs(); unsigned char* ws = a.ws;
        pg8::Gemm g{(const bf16*)(ws + WS_MIX), (const bf16*)(ws + WS_WO), MP, D, D}; pg8::StaticOrder S; S.init(MP, D, G, bx);
        pg8::EpiRes E{nullptr, nullptr, 1 << 30, (bf16*)(ws + WS_XB), rep_ ? (float*)(ws + WS_DUMMY) : SSQ(a, 2), rep_ ? 0.f : 1.0f};
        pg8::gemm_phase<pg8::EpiRes, pg8::StaticOrder, true, true>(lds, g, S, E);
        for (int u = bx; u < D / 16; u += G) { const int c0 = 16 * u; const bf16* W = (const bf16*)(ws + WS_WO) + (size_t)c0 * D;
            sg::EpiResS Es{nullptr, (bf16*)(ws + WS_XB) + (size_t)MP * D, (rep_ ? (float*)(ws + WS_DUMMY) : SSQ(a, 2)) + MP, rep_ ? 0.f : 1.0f, c0}; sg::unit<1>(lds, (const bf16*)(ws + WS_MIX) + (size_t)MP * D, D, W, W, Es); }
        if (BOTH(7)) GRID_BAR();
    }
    if (IN(8)) REP(8) {
        CArgs& a = kargs(); unsigned char* ws = a.ws;
        pg8::Gemm g{(const bf16*)(ws + WS_XB), (const bf16*)(ws + WS_WGU2), MP, 2 * FF, D}; pg8::StaticOrder S; S.init(MP, 2 * FF, G, bx);
        pg8::EpiUp E{(bf16*)(ws + WS_HID), FF, SSQ(a, 2)};
        pg8::gemm_phase<pg8::EpiUp, pg8::StaticOrder, true, true>(lds, g, S, E);
        for (int u = bx; u < FF / 16; u += G) { const int hc0 = 16 * u; const bf16* W = (const bf16*)(ws + WS_WGU2) + (size_t)((hc0 >> 7) * 256 + (hc0 & 127)) * D;
            sg::EpiUpS Es{(bf16*)(ws + WS_HID) + (size_t)MP * FF, FF, SSQ(a, 2) + MP, hc0}; sg::unit<2>(lds, (const bf16*)(ws + WS_XB) + (size_t)MP * D, D, W, W + (size_t)128 * D, Es); }
        if (BOTH(8)) GRID_BAR();
    }
    if (IN(9)) REP(9) {
        CArgs& a = kargs(); unsigned char* ws = a.ws;
        pg8::Gemm g{(const bf16*)(ws + WS_HID), (const bf16*)(ws + WS_WD2), MP, D, FF}; pg8::StaticOrder S; S.init(MP, D, G, bx);
        pg8::EpiRes E{nullptr, nullptr, 1 << 30, (bf16*)(ws + WS_XB), rep_ ? (float*)(ws + WS_DUMMY) : SSQ(a, 3), rep_ ? 0.f : 0.5f};
        pg8::gemm_phase<pg8::EpiRes, pg8::StaticOrder, true, true>(lds, g, S, E);
        for (int u = bx; u < D / 16; u += G) { const int c0 = 16 * u; const bf16* W = (const bf16*)(ws + WS_WD2) + (size_t)c0 * FF;
            sg::EpiResS Es{nullptr, (bf16*)(ws + WS_XB) + (size_t)MP * D, (rep_ ? (float*)(ws + WS_DUMMY) : SSQ(a, 3)) + MP, rep_ ? 0.f : 0.5f, c0}; sg::unit<1>(lds, (const bf16*)(ws + WS_HID) + (size_t)MP * FF, FF, W, W, Es); }
        if (BOTH(9)) GRID_BAR();
    }
    if (IN(10)) p8_final(kargs(), G, bx);
#undef IN
#undef BOTH
}

extern "C" void kernel_launch(void* const* d_in, const int* in_sizes, int n_in, void* d_out, int out_size, void* d_ws, size_t ws_size, hipStream_t stream) {
    static int grid = 0;
    if (grid == 0) {
        if (n_in != 21 || out_size != (int)O_END || ws_size < WS_END) { fprintf(stderr, "kernel_launch: unexpected sizes n_in %d out %d ws %zu\n", n_in, out_size, ws_size); grid = -1; return; }
        int dev = 0, cus = 0, per_cu = 0;
        (void)hipGetDevice(&dev); (void)hipDeviceGetAttribute(&cus, hipDeviceAttributeMultiprocessorCount, dev);
        if (hipFuncSetAttribute((const void*)mega_fwd, hipFuncAttributeMaxDynamicSharedMemorySize, LDS_BYTES) != hipSuccess) { fprintf(stderr, "hipFuncSetAttribute failed\n"); grid = -1; return; }
        if (hipOccupancyMaxActiveBlocksPerMultiprocessor(&per_cu, (const void*)mega_fwd, NWAVES * 64, LDS_BYTES) != hipSuccess || per_cu < 1) { fprintf(stderr, "occupancy query: %d\n", per_cu); per_cu = 1; }
        (void)hipGetLastError();
        grid = cus * per_cu;
    }
    if (grid < 0) return;
    Args a{};
    for (int i = 0; i < 21; ++i) a.in[i] = (const float*)d_in[i];
    a.out = (float*)d_out; a.ws = (unsigned char*)d_ws;
    a.ph_lo = 0; a.ph_hi = 11; a.dup = DUPMASK;
    void* kargs[] = {&a};
    hipError_t e = hipLaunchCooperativeKernel((const void*)mega_fwd, dim3(grid), dim3(NWAVES * 64), kargs, LDS_BYTES, stream);
    if (e != hipSuccess) fprintf(stderr, "cooperative launch failed: %s (grid %d)\n", hipGetErrorString(e), grid);
}
```

```cpp
#include <hip/hip_runtime.h>
#include <hip/hip_cooperative_groups.h>
#include <cstdio>
#include <cstdint>
namespace cg = cooperative_groups;
namespace pg8 {
#define PG8_LAS __attribute__((address_space(3)))
typedef unsigned short bf16_t;
typedef short bf16x8 __attribute__((ext_vector_type(8)));
typedef float f32x4 __attribute__((ext_vector_type(4)));
typedef unsigned u32x4 __attribute__((ext_vector_type(4)));
constexpr int BM = 256, BK = 64, HALF = 128, HTB = HALF * BK * 2  , STAGE_BYTES = 8 * HTB, NXCD = 8, WGM = 8;

__host__ __device__ __forceinline__ int lds_byte(int r, int c) { const int st = (r >> 4) * 2 + (c >> 5), rr = r & 15, cc = c & 31, ob = rr * 64 + cc * 2; return st * 1024 + (ob ^ (((ob >> 9) & 1) << 5)); }
__host__ __device__ __forceinline__ void stage_rc(int b, int& R, int& C) { const int st = b / 1024, sb = b % 1024, swz = sb ^ (((sb >> 9) & 1) << 5); R = (st >> 1) * 16 + swz / 64; C = (st & 1) * 32 + (swz % 64) / 2; }
__host__ __device__ __forceinline__ int perm32(int rho) { const int n = rho >> 4, i = rho & 15; return 8 * (i >> 2) + 4 * n + (i & 3); }

struct Unit { int pm, pn; };
struct Gemm { const bf16_t* A; const bf16_t* Bt; int M, N, K; };

struct StaticOrder {
    int nM, nN, nwg, G, c;
    __host__ __device__ void init(int M, int N, int G_, int c_) { nM = M / BM; nN = N / BM; nwg = nM * nN; G = G_; c = c_; }
    __host__ __device__ bool next(int i, Unit& u) const {
        const long L = (long)i * G + c; if (L >= nwg) return false;
        int wgid = (int)L; { const int q = nwg / NXCD, r = nwg % NXCD, xcd = wgid % NXCD, off = wgid / NXCD; wgid = (xcd < r ? xcd * (q + 1) : r * (q + 1) + (xcd - r) * q) + off; }
        const int nig = WGM * nN, gid = wgid / nig, fm = gid * WGM, gsz = (nM - fm) < WGM ? (nM - fm) : WGM;
        u.pm = fm + ((wgid % nig) % gsz); u.pn = (wgid % nig) / gsz; return true;
    }
    __device__ __forceinline__ void a_ready(const Unit&) const {}
    __device__ __forceinline__ void done(const Unit&) const {}
};

__device__ __forceinline__ unsigned cvt_pk_bf16(float lo, float hi) { unsigned r; asm volatile("v_cvt_pk_bf16_f32 %0, %1, %2" : "=v"(r) : "v"(lo), "v"(hi)); return r; }
typedef float f32x2 __attribute__((ext_vector_type(2)));
constexpr float RMS_EPS = 1e-6f;
__device__ __forceinline__ float silu_f(float g) { return g * __builtin_amdgcn_rcpf(1.0f + __expf(-g)); }
__device__ __forceinline__ float rstd_of(const float* ssq, int row) { return rsqrtf(ssq[row] * (1.0f / 1024.0f) + RMS_EPS); }

struct EpiUp {
    static constexpr bool PERM = true, AFTER_DRAIN = false;
    bf16_t* H; int ldh; const float* ssq;
    __device__ __forceinline__ void operator()(const f32x4 (&acc)[2][2][4][2], const Unit& u, int wr, int wc, int fr, int fq) const {
        const int row0 = u.pm * BM + wr * 64 + fr, hcol0 = u.pn * HALF + wc * 32 + 8 * fq;
#pragma unroll
        for (int ai = 0; ai < 2; ++ai)
#pragma unroll
            for (int m = 0; m < 4; ++m) {
                const int row = row0 + ai * HALF + m * 16; const float rs = rstd_of(ssq, row);
                float h[8];
#pragma unroll
                for (int n = 0; n < 2; ++n)
#pragma unroll
                    for (int i = 0; i < 4; ++i) { const float g = acc[ai][0][m][n][i] * rs, uu = acc[ai][1][m][n][i] * rs; h[4 * n + i] = silu_f(g) * uu; }
                u32x4 w; w.x = cvt_pk_bf16(h[0], h[1]); w.y = cvt_pk_bf16(h[2], h[3]); w.z = cvt_pk_bf16(h[4], h[5]); w.w = cvt_pk_bf16(h[6], h[7]);
                *(u32x4*)(H + (size_t)row * ldh + hcol0) = w;
            }
    }
};

struct EpiRes {
    static constexpr bool PERM = true, AFTER_DRAIN = false;
    const float* xf0; const float* xf1; int split_pm;
    bf16_t* xb; float* ssq; float scale;
    __device__ __forceinline__ void operator()(const f32x4 (&acc)[2][2][4][2], const Unit& u, int wr, int wc, int fr, int fq) const {
        const int row0 = u.pm * BM + wr * 64 + fr, col0 = u.pn * BM + wc * 32 + 8 * fq;
        const float* xin = xf0 ? ((u.pm < split_pm) ? xf0 : (xf1 - (size_t)split_pm * BM * 1024)) : nullptr;
#pragma unroll
        for (int ai = 0; ai < 2; ++ai)
#pragma unroll
            for (int m = 0; m < 4; ++m) {
                const int row = row0 + ai * HALF + m * 16; const size_t off = (size_t)row * 1024 + col0; float s = 0.f;
#pragma unroll
                for (int bj = 0; bj < 2; ++bj) {
                    f32x4 r0, r1;
                    if (xin) { r0 = *(const f32x4*)(xin + off + bj * HALF); r1 = *(const f32x4*)(xin + off + bj * HALF + 4); }
                    else { const u32x4 rb = *(const u32x4*)(xb + off + bj * HALF);
                        r0 = (f32x4){__builtin_bit_cast(float, rb.x << 16), __builtin_bit_cast(float, rb.x & 0xffff0000u), __builtin_bit_cast(float, rb.y << 16), __builtin_bit_cast(float, rb.y & 0xffff0000u)};
                        r1 = (f32x4){__builtin_bit_cast(float, rb.z << 16), __builtin_bit_cast(float, rb.z & 0xffff0000u), __builtin_bit_cast(float, rb.w << 16), __builtin_bit_cast(float, rb.w & 0xffff0000u)}; }
                    const f32x4 v0 = r0 + acc[ai][bj][m][0] * scale, v1 = r1 + acc[ai][bj][m][1] * scale;
                    s += ((v0[0] * v0[0] + v0[1] * v0[1]) + (v0[2] * v0[2] + v0[3] * v0[3])) + ((v1[0] * v1[0] + v1[1] * v1[1]) + (v1[2] * v1[2] + v1[3] * v1[3]));
                    u32x4 w; w.x = cvt_pk_bf16(v0[0], v0[1]); w.y = cvt_pk_bf16(v0[2], v0[3]); w.z = cvt_pk_bf16(v1[0], v1[1]); w.w = cvt_pk_bf16(v1[2], v1[3]);
                    *(u32x4*)(xb + off + bj * HALF) = w;
                }
                s += __shfl_xor(s, 16); s += __shfl_xor(s, 32);
                if (fq == 0) __hip_atomic_fetch_add(ssq + row, s, __ATOMIC_RELAXED, __HIP_MEMORY_SCOPE_AGENT);
            }
    }
};

struct EpiWin {
    static constexpr bool PERM = true, AFTER_DRAIN = false;
    bf16_t* P; float* GA; const float* ssq; const float* gbias;
    __device__ __forceinline__ void operator()(const f32x4 (&acc)[2][2][4][2], const Unit& u, int wr, int wc, int fr, int fq) const {
        const int row0 = u.pm * BM + wr * 64 + fr, c0 = wc * 32 + 8 * fq, pn = u.pn;
#pragma unroll
        for (int ai = 0; ai < 2; ++ai)
#pragma unroll
            for (int m = 0; m < 4; ++m) {
                const int row = row0 + ai * HALF + m * 16; const float rs = rstd_of(ssq, row);
#pragma unroll
                for (int bj = 0; bj < 2; ++bj) {
                    float v[8];
#pragma unroll
                    for (int n = 0; n < 2; ++n)
#pragma unroll
                        for (int i = 0; i < 4; ++i) v[4 * n + i] = acc[ai][bj][m][n][i] * rs;
                    const int tc = bj * HALF + c0;
                    if (pn == 14) {
                        f32x4 o0, o1;
#pragma unroll
                        for (int i = 0; i < 8; ++i) { const float x = v[i] + gbias[tc + i]; const float ls = fminf(x, 0.f) - __logf(1.0f + __expf(-fabsf(x))); const float av = __expf(ls * 0.0625f); if (i < 4) o0[i] = av; else o1[i - 4] = av; }
                        *(f32x4*)(GA + (size_t)row * 256 + tc) = o0; *(f32x4*)(GA + (size_t)row * 256 + tc + 4) = o1;
                    } else {
                        if (pn == 0) {
#pragma unroll
                            for (int i = 0; i < 8; ++i) v[i] *= 0.125f;
                        } else if (pn == 6 || pn == 7) {
#pragma unroll
                            for (int i = 0; i < 8; ++i) v[i] = silu_f(v[i]);
                        }
                        u32x4 w; w.x = cvt_pk_bf16(v[0], v[1]); w.y = cvt_pk_bf16(v[2], v[3]); w.z = cvt_pk_bf16(v[4], v[5]); w.w = cvt_pk_bf16(v[6], v[7]);
                        *(u32x4*)(P + (size_t)row * 3584 + pn * BM + tc) = w;
                    }
                }
            }
    }
};
template <class Epi, class Sched, bool ALIGN_EPI = false, bool SP2 = false>
__device__ __forceinline__ void gemm_phase(PG8_LAS unsigned char* lds, const Gemm g, const Sched& S, const Epi& E) {
    const int tid = threadIdx.x, wid = __builtin_amdgcn_readfirstlane(tid >> 6), lane = tid & 63, wr = wid >> 2, wc = wid & 3, fr = lane & 15, fq = lane >> 4;
    const int K = g.K, nt = K / BK;
    unsigned voffA[2], voffB[2];
#pragma unroll
    for (int i = 0; i < 2; ++i) { int R, C; stage_rc(tid * 16 + i * 8192, R, C); const int Rb = Epi::PERM ? ((R & ~31) + perm32(R & 31)) : R;
        voffA[i] = (unsigned)(R * K + C) * 2u; voffB[i] = (unsigned)(Rb * K + C) * 2u; }
    const size_t kstep = (size_t)(BK * 2);
    const size_t hstep = (size_t)HALF * K * 2;
    const size_t tstep = 2 * hstep;
    const unsigned ldsw = (unsigned)wid * 1024u;
    const int aoff = lds_byte(wr * 64 + fr, fq * 8), boff = lds_byte(wc * 32 + fr, fq * 8);
#define PG8_SA(b, h) (((b) * 2 + (h)) * HTB)
#define PG8_SB(b, h) ((4 + (b) * 2 + (h)) * HTB)
#define PG8_STAGE(bufoff, gbase, voff) do { _Pragma("unroll") for (int _i = 0; _i < 2; ++_i) \
        __builtin_amdgcn_global_load_lds((const unsigned*)((const char*)(gbase) + (voff)[_i]), (PG8_LAS unsigned*)(lds + (bufoff) + ldsw + _i * 8192), 16, 0, 0); } while (0)
#define PG8_LDA(dst, b, h) do { _Pragma("unroll") for (int m = 0; m < 4; ++m) _Pragma("unroll") for (int k = 0; k < 2; ++k) dst[m][k] = *(const PG8_LAS bf16x8*)(lds + PG8_SA(b, h) + aoff + m * 2048 + k * 1024); } while (0)
#define PG8_LDB(dst, b, h) do { _Pragma("unroll") for (int n = 0; n < 2; ++n) _Pragma("unroll") for (int k = 0; k < 2; ++k) dst[n][k] = *(const PG8_LAS bf16x8*)(lds + PG8_SB(b, h) + boff + n * 2048 + k * 1024); } while (0)
#define PG8_MMA(ai, bj, At, Bt) do { __builtin_amdgcn_s_setprio(1); _Pragma("unroll") for (int m = 0; m < 4; ++m) _Pragma("unroll") for (int n = 0; n < 2; ++n) _Pragma("unroll") for (int k = 0; k < 2; ++k) \
        acc[ai][bj][m][n] = __builtin_amdgcn_mfma_f32_16x16x32_bf16(Bt[n][k], At[m][k], acc[ai][bj][m][n], 0, 0, 0); __builtin_amdgcn_s_setprio(0); } while (0)
#define PG8_WAIT_V(n) asm volatile("s_waitcnt vmcnt(" #n ")" ::: "memory")
#define PG8_WAIT_L(n) asm volatile("s_waitcnt lgkmcnt(" #n ")" ::: "memory")
#define PG8_BAR __builtin_amdgcn_s_barrier()
#define PG8_SCHED __builtin_amdgcn_sched_barrier(0)
    Unit cur, nxt; int ui = 0;
    if (!S.next(0, cur)) return;
    f32x4 acc[2][2][4][2];
#pragma unroll
    for (int a = 0; a < 2; ++a)
#pragma unroll
        for (int b = 0; b < 2; ++b)
#pragma unroll
            for (int m = 0; m < 4; ++m)
#pragma unroll
                for (int n = 0; n < 2; ++n) acc[a][b][m][n] = (f32x4){0.f, 0.f, 0.f, 0.f};
    bf16x8 At[4][2], B0[2][2], B1[2][2];
    const char* cA = (const char*)g.A + (size_t)cur.pm * tstep; const char* cB = (const char*)g.Bt + (size_t)cur.pn * tstep;
    S.a_ready(cur);
    if constexpr (SP2) {
        PG8_STAGE(PG8_SB(0, 0), cB, voffB); PG8_STAGE(PG8_SB(0, 1), cB + hstep, voffB); PG8_STAGE(PG8_SA(0, 0), cA, voffA); PG8_STAGE(PG8_SA(0, 1), cA + hstep, voffA);
        if (wr == 1) PG8_BAR;
        PG8_WAIT_V(2); PG8_BAR;
        PG8_STAGE(PG8_SB(1, 0), cB + kstep, voffB); PG8_STAGE(PG8_SA(1, 0), cA + kstep, voffA); PG8_STAGE(PG8_SB(1, 1), cB + hstep + kstep, voffB);
        PG8_WAIT_V(6); PG8_BAR;
    } else {
        PG8_STAGE(PG8_SB(0, 0), cB, voffB); PG8_STAGE(PG8_SA(0, 0), cA, voffA); PG8_STAGE(PG8_SB(0, 1), cB + hstep, voffB); PG8_STAGE(PG8_SA(0, 1), cA + hstep, voffA);
        if (wr == 1) PG8_BAR;
        PG8_WAIT_V(4); PG8_BAR;
        PG8_STAGE(PG8_SB(1, 0), cB + kstep, voffB); PG8_STAGE(PG8_SA(1, 0), cA + kstep, voffA); PG8_STAGE(PG8_SB(1, 1), cB + hstep + kstep, voffB);
        PG8_WAIT_V(6); PG8_BAR;
    }
    for (;;) {
        const bool has_next = S.next(ui + 1, nxt);
        const char* nA = has_next ? (const char*)g.A + (size_t)nxt.pm * tstep : cA; const char* nB = has_next ? (const char*)g.Bt + (size_t)nxt.pn * tstep : cB;
        for (int t = 0; t < nt; t += 2) {
            const bool last = (t == nt - 2);
            const char* a1 = cA + (size_t)(t + 1) * kstep;
            const char* a2 = last ? nA : cA + (size_t)(t + 2) * kstep; const char* b2 = last ? nB : cB + (size_t)(t + 2) * kstep;
            const char* a3 = a2 + kstep; const char* b3 = b2 + kstep;
            if (last && has_next) S.a_ready(nxt);
            if constexpr (SP2) {
            PG8_LDB(B0, 0, 0); PG8_LDB(B1, 0, 1); PG8_SCHED; PG8_LDA(At, 0, 0); PG8_STAGE(PG8_SA(1, 1), a1 + hstep, voffA);
            PG8_WAIT_V(8); PG8_WAIT_L(0); PG8_BAR; PG8_MMA(0, 0, At, B0); PG8_MMA(0, 1, At, B1); PG8_BAR; PG8_SCHED;
            PG8_LDA(At, 0, 1); PG8_STAGE(PG8_SB(0, 0), b2, voffB); PG8_STAGE(PG8_SB(0, 1), b2 + hstep, voffB); PG8_STAGE(PG8_SA(0, 0), a2, voffA);
            PG8_WAIT_V(8); PG8_WAIT_L(0); PG8_BAR; PG8_MMA(1, 0, At, B0); PG8_MMA(1, 1, At, B1); PG8_BAR; PG8_SCHED;
            PG8_LDB(B0, 1, 0); PG8_LDB(B1, 1, 1); PG8_SCHED; PG8_LDA(At, 1, 0); PG8_STAGE(PG8_SA(0, 1), a2 + hstep, voffA);
            PG8_WAIT_V(8); PG8_WAIT_L(0); PG8_BAR; PG8_MMA(0, 0, At, B0); PG8_MMA(0, 1, At, B1); PG8_BAR; PG8_SCHED;
            PG8_LDA(At, 1, 1); PG8_STAGE(PG8_SB(1, 0), b3, voffB); PG8_STAGE(PG8_SB(1, 1), b3 + hstep, voffB); PG8_STAGE(PG8_SA(1, 0), a3, voffA);
            PG8_WAIT_V(8); PG8_WAIT_L(0); PG8_BAR; PG8_MMA(1, 0, At, B0); PG8_MMA(1, 1, At, B1); PG8_BAR; PG8_SCHED;
            } else {
            PG8_LDB(B0, 0, 0); PG8_SCHED; PG8_LDA(At, 0, 0); PG8_STAGE(PG8_SA(1, 1), a1 + hstep, voffA);
            PG8_WAIT_L(8); PG8_BAR; PG8_WAIT_L(0); PG8_MMA(0, 0, At, B0); PG8_BAR; PG8_SCHED;
            PG8_LDB(B1, 0, 1); PG8_STAGE(PG8_SB(0, 0), b2, voffB);
            PG8_BAR; PG8_WAIT_L(0); PG8_MMA(0, 1, At, B1); PG8_BAR;
            PG8_LDA(At, 0, 1); PG8_STAGE(PG8_SA(0, 0), a2, voffA);
            PG8_BAR; PG8_WAIT_L(0); PG8_MMA(1, 0, At, B0); PG8_BAR; PG8_SCHED;
            PG8_STAGE(PG8_SB(0, 1), b2 + hstep, voffB);
            PG8_WAIT_V(6); PG8_BAR; PG8_MMA(1, 1, At, B1); PG8_BAR;
            PG8_LDB(B0, 1, 0); PG8_SCHED; PG8_LDA(At, 1, 0); PG8_STAGE(PG8_SA(0, 1), a2 + hstep, voffA);
            PG8_WAIT_L(8); PG8_BAR; PG8_WAIT_L(0); PG8_MMA(0, 0, At, B0); PG8_BAR; PG8_SCHED;
            PG8_LDB(B1, 1, 1); PG8_STAGE(PG8_SB(1, 0), b3, voffB);
            PG8_BAR; PG8_WAIT_L(0); PG8_MMA(0, 1, At, B1); PG8_BAR;
            PG8_LDA(At, 1, 1); PG8_STAGE(PG8_SA(1, 0), a3, voffA);
            PG8_BAR; PG8_WAIT_L(0); PG8_MMA(1, 0, At, B0); PG8_BAR; PG8_SCHED;
            PG8_STAGE(PG8_SB(1, 1), b3 + hstep, voffB);
            PG8_WAIT_V(6); PG8_BAR; PG8_MMA(1, 1, At, B1); PG8_BAR;
            }
        }
        if constexpr (ALIGN_EPI) { if (wr == 0) PG8_BAR; }
        if constexpr (!Epi::AFTER_DRAIN) { E(acc, cur, wr, wc, fr, fq); S.done(cur); }
        if (!has_next) break;
#pragma unroll
        for (int a = 0; a < 2; ++a)
#pragma unroll
            for (int b = 0; b < 2; ++b)
#pragma unroll
                for (int m = 0; m < 4; ++m)
#pragma unroll
                    for (int n = 0; n < 2; ++n) acc[a][b][m][n] = (f32x4){0.f, 0.f, 0.f, 0.f};
        cur = nxt; cA = nA; cB = nB; ++ui;
        if constexpr (ALIGN_EPI) { if (wr == 1) PG8_BAR; }
    }
    PG8_WAIT_V(0);
    if constexpr (!ALIGN_EPI) { if (wr == 0) PG8_BAR; }
    PG8_BAR;
    if constexpr (Epi::AFTER_DRAIN) { E.fused(acc, cur, wr, wc, fr, fq, lds, wid, lane); S.done(cur); }
#undef PG8_SA
#undef PG8_SB
#undef PG8_STAGE
#undef PG8_LDA
#undef PG8_LDB
#undef PG8_MMA
#undef PG8_WAIT_V
#undef PG8_WAIT_L
#undef PG8_BAR
#undef PG8_SCHED
}
}
namespace rec {
#define RLAS __attribute__((address_space(3)))
typedef unsigned short bf16;
typedef short bf16x8 __attribute__((ext_vector_type(8)));
typedef short s16x4 __attribute__((ext_vector_type(4)));
typedef float f32x4 __attribute__((ext_vector_type(4)));
typedef float f32x2 __attribute__((ext_vector_type(2)));
typedef unsigned u32x2 __attribute__((ext_vector_type(2)));
typedef unsigned u32x4 __attribute__((ext_vector_type(4)));
constexpr int PWID = 3584, DM = 1024;
constexpr float R_EPS = 1e-6f;

typedef __bf16 bf16x2_t __attribute__((ext_vector_type(2)));
__device__ __forceinline__ unsigned pkbf(float lo, float hi) { const f32x2 v = {lo, hi}; const bf16x2_t b = __builtin_convertvector(v, bf16x2_t); return __builtin_bit_cast(unsigned, b); }
__device__ __forceinline__ int otid() { int t = threadIdx.x; asm volatile("" : "+v"(t)); return t; }
__device__ __forceinline__ float bflo(unsigned u) { return __builtin_bit_cast(float, u << 16); }
__device__ __forceinline__ float bfhi(unsigned u) { return __builtin_bit_cast(float, u & 0xffff0000u); }

template <int DK> struct Lay {
    static constexpr int NP = DK / 2, NSEG = 512 / NP, TL = 64 / NSEG, SEGREF = 32 / TL - 1, NDT = DK / 16, NKS = DK / 32;
    static constexpr int PK = DK * 2 + 32, PV = 288, PP = 160, PO = 528;
    static constexpr int OFF_Q = 0, OFF_K = OFF_Q + 64 * PK, OFF_KH = OFF_K + 64 * PK, OFF_V = OFF_KH + 64 * PK, OFF_P = OFF_V + 64 * PV, OFF_O = OFF_P + 64 * PP,
                         OFF_SEG = OFF_O + 64 * PO, OFF_D = OFF_SEG + NSEG * DK * 4, OFF_E = OFF_D + DK * 4, OFF_END = OFF_E + DK * 4;
    static_assert(OFF_END <= 131072, "recurrence LDS map");
};

__device__ __forceinline__ bf16x8 tr_frag(RLAS unsigned char* img, int pitch, int k0, int n0, int lane) {
    const int g = lane >> 4, q = (lane & 15) >> 2, p = lane & 3;
    RLAS unsigned char* a = img + (k0 + 8 * g + q) * pitch + n0 * 2 + 8 * p;
    const s16x4 lo = __builtin_amdgcn_ds_read_tr16_b64_v4i16((RLAS s16x4*)a);
    const s16x4 hi = __builtin_amdgcn_ds_read_tr16_b64_v4i16((RLAS s16x4*)(a + 4 * pitch));
    return __builtin_shufflevector(lo, hi, 0, 1, 2, 3, 4, 5, 6, 7);
}

struct HeadIo {
    const bf16* P; const float* GA; bf16* MIX;
    int qoff, koff, voff, goff, ooff, gaoff;
    const float* onorm; float lb0, lb1;
};

#define REC_BAR() do { asm volatile("s_waitcnt lgkmcnt(0)" ::: "memory"); __builtin_amdgcn_s_barrier(); asm volatile("" ::: "memory"); } while (0)

template <int DK, bool HG, bool DO_OUT> struct Raw { unsigned q2[Lay<DK>::TL], k2[Lay<DK>::TL]; f32x2 av[Lay<DK>::TL]; u32x4 v0, v1, g0, g1; };

template <int DK, bool HG, bool DO_OUT>
__device__ __forceinline__ void load_raw(const HeadIo& io, size_t row0, int tvalid, Raw<DK, HG, DO_OUT>& w) {
    typedef Lay<DK> L;
    const int tid = otid(), dp = tid % L::NP, seg = tid / L::NP;
#pragma unroll
    for (int tt = 0; tt < L::TL; ++tt) {
        const int t = seg * L::TL + tt; const size_t row = row0 + t; const bool ok = t < tvalid;
        if (DO_OUT) w.q2[tt] = ok ? *(const unsigned*)(io.P + row * PWID + io.qoff + 2 * dp) : 0u;
        w.k2[tt] = ok ? *(const unsigned*)(io.P + row * PWID + io.koff + 2 * dp) : 0u;
        if (!HG) w.av[tt] = ok ? *(const f32x2*)(io.GA + row * 256 + io.gaoff + 2 * dp) : (f32x2){1.f, 1.f};
    }
    const int vr = tid >> 3, vc = (tid & 7) * 16; const bool vok = vr < tvalid;
    w.v0 = (u32x4){0u, 0u, 0u, 0u}; w.v1 = w.v0; w.g0 = w.v0; w.g1 = w.v0;
    if (vok) { const u32x4* src = (const u32x4*)(io.P + (row0 + vr) * PWID + io.voff + vc); w.v0 = src[0]; w.v1 = src[1];
        if (DO_OUT) { const u32x4* gp = (const u32x4*)(io.P + (row0 + vr) * PWID + io.goff + vc); w.g0 = gp[0]; w.g1 = gp[1]; } }
}

template <int DK, bool HG, bool DO_OUT>
__device__ __forceinline__ void chunk(RLAS unsigned char* lds, const HeadIo& io, const Raw<DK, HG, DO_OUT>& w, size_t row0, int tvalid, f32x4 (&S)[DK / 16], float& dtot) {
    typedef Lay<DK> L;
    const int tid = otid(), lane = tid & 63, wave = tid >> 6, r = lane & 15, g = lane >> 4, e0 = 16 * wave;
    const int dp = tid % L::NP, seg = tid / L::NP;
    {
        const int vr = tid >> 3, vc = (tid & 7) * 16;
        RLAS u32x4* dst = (RLAS u32x4*)(lds + L::OFF_V + vr * L::PV + vc * 2); dst[0] = w.v0; dst[1] = w.v1;
    }
    float kx[L::TL], ky[L::TL]; f32x2 pr[L::TL];
#pragma unroll
    for (int tt = 0; tt < L::TL; ++tt) {
        if (HG) {
            const bool ok = seg * L::TL + tt < tvalid;
            const float zx = fminf(fmaxf(bflo(w.k2[tt]), -30.f), 30.f), zy = fminf(fmaxf(bfhi(w.k2[tt]), -30.f), 30.f);
            const float ex = __expf(-zx), ey = __expf(-zy), sx = __builtin_amdgcn_rcpf(1.f + ex), sy = __builtin_amdgcn_rcpf(1.f + ey);
            kx[tt] = ok ? (1.f - io.lb0) * ex * sx : 0.f; ky[tt] = ok ? (1.f - io.lb1) * ey * sy : 0.f;
            pr[tt] = ok ? (f32x2){io.lb0 + (1.f - io.lb0) * sx, io.lb1 + (1.f - io.lb1) * sy} : (f32x2){1.f, 1.f};
        } else { kx[tt] = bflo(w.k2[tt]); ky[tt] = bfhi(w.k2[tt]); pr[tt] = w.av[tt]; }
    }
#pragma unroll
    for (int tt = 1; tt < L::TL; ++tt) pr[tt] *= pr[tt - 1];
    *(RLAS f32x2*)(lds + L::OFF_SEG + (seg * DK + 2 * dp) * 4) = pr[L::TL - 1];
    REC_BAR();
    f32x2 off = {1.f, 1.f}, aref = {1.f, 1.f}, alast = {1.f, 1.f};
#pragma unroll
    for (int s = 0; s < L::NSEG; ++s) { const f32x2 v = *(RLAS f32x2*)(lds + L::OFF_SEG + (s * DK + 2 * dp) * 4); if (s < seg) off *= v; if (s <= L::SEGREF) aref *= v; alast *= v; }
    const float irx = __builtin_amdgcn_rcpf(aref.x), iry = __builtin_amdgcn_rcpf(aref.y);
#pragma unroll
    for (int tt = 0; tt < L::TL; ++tt) {
        const int t = seg * L::TL + tt; const f32x2 at = off * pr[tt];
        const float ix = __builtin_amdgcn_rcpf(at.x), iy = __builtin_amdgcn_rcpf(at.y);
        if (DO_OUT) {
            *(RLAS unsigned*)(lds + L::OFF_Q + t * L::PK + 4 * dp) = pkbf(bflo(w.q2[tt]) * (at.x * irx), bfhi(w.q2[tt]) * (at.y * iry));
            *(RLAS unsigned*)(lds + L::OFF_K + t * L::PK + 4 * dp) = pkbf(kx[tt] * (ix * aref.x), ky[tt] * (iy * aref.y));
        }
        *(RLAS unsigned*)(lds + L::OFF_KH + t * L::PK + 4 * dp) = pkbf(kx[tt] * (ix * alast.x), ky[tt] * (iy * alast.y));
    }
    if (seg == 0) { *(RLAS f32x2*)(lds + L::OFF_D + 8 * dp) = alast; *(RLAS f32x2*)(lds + L::OFF_E + 8 * dp) = aref; }
    REC_BAR();
    if (tid < DK) dtot *= *(RLAS float*)(lds + L::OFF_D + 4 * tid);
    f32x4 O[4];
    if (DO_OUT) {
        const int it = wave >> 1;
#pragma unroll
        for (int jj = 0; jj < 2; ++jj) {
            const int jt = 2 * (wave & 1) + jj; f32x4 acc = {0.f, 0.f, 0.f, 0.f};
            if (jt <= it) {
#pragma unroll
                for (int s = 0; s < L::NKS; ++s) {
                    const bf16x8 kf = *(RLAS bf16x8*)(lds + L::OFF_K + (16 * jt + r) * L::PK + (32 * s + 8 * g) * 2);
                    const bf16x8 qf = *(RLAS bf16x8*)(lds + L::OFF_Q + (16 * it + r) * L::PK + (32 * s + 8 * g) * 2);
                    acc = __builtin_amdgcn_mfma_f32_16x16x32_bf16(kf, qf, acc, 0, 0, 0);
                }
            }
            const int i = 16 * it + r, j = 16 * jt + 4 * g;
            u32x2 pw; pw.x = pkbf(j <= i ? acc[0] : 0.f, j + 1 <= i ? acc[1] : 0.f); pw.y = pkbf(j + 2 <= i ? acc[2] : 0.f, j + 3 <= i ? acc[3] : 0.f);
            *(RLAS u32x2*)(lds + L::OFF_P + i * L::PP + j * 2) = pw;
        }
#pragma unroll
        for (int m = 0; m < 4; ++m) O[m] = (f32x4){0.f, 0.f, 0.f, 0.f};
#pragma unroll
        for (int s = 0; s < L::NKS; ++s) {
            const f32x4 ea = *(RLAS f32x4*)(lds + L::OFF_E + (32 * s + 4 * g) * 4), eb = *(RLAS f32x4*)(lds + L::OFF_E + (32 * s + 16 + 4 * g) * 4);
            const f32x4 sa = S[2 * s] * ea, sb = S[2 * s + 1] * eb;
            u32x4 sp; sp.x = pkbf(sa[0], sa[1]); sp.y = pkbf(sa[2], sa[3]); sp.z = pkbf(sb[0], sb[1]); sp.w = pkbf(sb[2], sb[3]);
            const bf16x8 sf = __builtin_bit_cast(bf16x8, sp);
#pragma unroll
            for (int m = 0; m < 4; ++m) {
                const s16x4 qlo = *(RLAS s16x4*)(lds + L::OFF_Q + (16 * m + r) * L::PK + (32 * s + 4 * g) * 2), qhi = *(RLAS s16x4*)(lds + L::OFF_Q + (16 * m + r) * L::PK + (32 * s + 16 + 4 * g) * 2);
                const bf16x8 qf = __builtin_shufflevector(qlo, qhi, 0, 1, 2, 3, 4, 5, 6, 7);
                O[m] = __builtin_amdgcn_mfma_f32_16x16x32_bf16(qf, sf, O[m], 0, 0, 0);
            }
        }
        REC_BAR();
    }
    const bf16x8 vf0 = tr_frag(lds + L::OFF_V, L::PV, 0, e0, lane), vf1 = tr_frag(lds + L::OFF_V, L::PV, 32, e0, lane);
    if (DO_OUT) {
#pragma unroll
        for (int m = 0; m < 4; ++m) {
            const bf16x8 p0 = *(RLAS bf16x8*)(lds + L::OFF_P + (16 * m + r) * L::PP + (8 * g) * 2), p1 = *(RLAS bf16x8*)(lds + L::OFF_P + (16 * m + r) * L::PP + (32 + 8 * g) * 2);
            O[m] = __builtin_amdgcn_mfma_f32_16x16x32_bf16(p0, vf0, O[m], 0, 0, 0);
            O[m] = __builtin_amdgcn_mfma_f32_16x16x32_bf16(p1, vf1, O[m], 0, 0, 0);
        }
    }
#pragma unroll
    for (int dt = 0; dt < L::NDT; ++dt) {
        const f32x4 dv = *(RLAS f32x4*)(lds + L::OFF_D + (16 * dt + 4 * g) * 4);
        const bf16x8 k0 = tr_frag(lds + L::OFF_KH, L::PK, 0, 16 * dt, lane), k1 = tr_frag(lds + L::OFF_KH, L::PK, 32, 16 * dt, lane);
        f32x4 acc = S[dt] * dv;
        acc = __builtin_amdgcn_mfma_f32_16x16x32_bf16(k0, vf0, acc, 0, 0, 0);
        acc = __builtin_amdgcn_mfma_f32_16x16x32_bf16(k1, vf1, acc, 0, 0, 0);
        S[dt] = acc;
    }
    if (DO_OUT) {
#pragma unroll
        for (int m = 0; m < 4; ++m)
#pragma unroll
            for (int ii = 0; ii < 4; ++ii) *(RLAS float*)(lds + L::OFF_O + (16 * m + 4 * g + ii) * L::PO + (e0 + r) * 4) = O[m][ii];
        REC_BAR();
        const int orow = tid >> 3, oc = (tid & 7) * 16;
        f32x4 ov[4]; float ss = 0.f;
#pragma unroll
        for (int c = 0; c < 4; ++c) { ov[c] = *(RLAS f32x4*)(lds + L::OFF_O + orow * L::PO + (oc + 4 * c) * 4); ss += (ov[c][0] * ov[c][0] + ov[c][1] * ov[c][1]) + (ov[c][2] * ov[c][2] + ov[c][3] * ov[c][3]); }
        ss += __shfl_xor(ss, 1); ss += __shfl_xor(ss, 2); ss += __shfl_xor(ss, 4);
        const float rs = rsqrtf(ss * (1.0f / 128.0f) + R_EPS);
        if (orow < tvalid) {
            const size_t row = row0 + orow;
            const unsigned gw[8] = {w.g0.x, w.g0.y, w.g0.z, w.g0.w, w.g1.x, w.g1.y, w.g1.z, w.g1.w};
            unsigned ow[8];
#pragma unroll
            for (int c = 0; c < 8; ++c) {
                const float ga = bflo(gw[c]), gb = bfhi(gw[c]);
                const float oa = ov[c >> 1][(c & 1) * 2] * rs * io.onorm[oc + 2 * c] * (ga * __builtin_amdgcn_rcpf(1.f + __expf(-ga)));
                const float ob = ov[c >> 1][(c & 1) * 2 + 1] * rs * io.onorm[oc + 2 * c + 1] * (gb * __builtin_amdgcn_rcpf(1.f + __expf(-gb)));
                ow[c] = pkbf(oa, ob);
            }
            u32x4* op = (u32x4*)(io.MIX + row * DM + io.ooff + oc);
            op[0] = (u32x4){ow[0], ow[1], ow[2], ow[3]}; op[1] = (u32x4){ow[4], ow[5], ow[6], ow[7]};
        }
    } else {
        REC_BAR();
    }
}

template <int NDT> __device__ __forceinline__ void load_state(f32x4 (&S)[NDT], const float* mem) {
    const int tid_ = otid(), lane = tid_ & 63, wave = tid_ >> 6, r = lane & 15, g = lane >> 4;
#pragma unroll
    for (int dt = 0; dt < NDT; ++dt)
#pragma unroll
        for (int i = 0; i < 4; ++i) S[dt][i] = mem ? mem[(16 * dt + 4 * g + i) * 128 + 16 * wave + r] : 0.f;
}
template <int NDT> __device__ __forceinline__ void store_state(const f32x4 (&S)[NDT], float* mem) {
    const int tid_ = otid(), lane = tid_ & 63, wave = tid_ >> 6, r = lane & 15, g = lane >> 4;
#pragma unroll
    for (int dt = 0; dt < NDT; ++dt)
#pragma unroll
        for (int i = 0; i < 4; ++i) mem[(16 * dt + 4 * g + i) * 128 + 16 * wave + r] = S[dt][i];
}

struct RecArgs {
    const bf16* P; const float* GA; bf16* MIX; const float* lbl; const float* gla_onorm; const float* hg_onorm;
    const float* st_gla_in; const float* st_hg_in; float* ST; float* DT; float* out_sgp; float* out_shp; float* out_sgs; float* out_shs;
};
constexpr int SC_TOK = 256, NCH = SC_TOK / 64, NSC = 8192 / SC_TOK, ST_PER = 4 * 64 * 128 + 4 * 128 * 128, DT_PER = 4 * 64 + 4 * 128;

template <int DK, bool HG> __device__ __forceinline__ HeadIo make_io(const RecArgs& a, int h) {
    HeadIo io; io.P = a.P; io.GA = a.GA; io.MIX = a.MIX;
    if (HG) { io.qoff = 1536 + h * 128; io.koff = 2048 + h * 128; io.voff = 2560 + h * 128; io.goff = 3072 + h * 128; io.ooff = 512 + h * 128; io.gaoff = 0; io.onorm = a.hg_onorm;
        const int d = 2 * (otid() % (DK / 2)); const float l0 = a.lbl[h * 128 + d], l1 = a.lbl[512 + h * 128 + d], m0 = a.lbl[h * 128 + d + 1], m1 = a.lbl[512 + h * 128 + d + 1];
        io.lb0 = 1.0f / (1.0f + __expf(l1 - l0)); io.lb1 = 1.0f / (1.0f + __expf(m1 - m0)); }
    else { io.qoff = h * 64; io.koff = 256 + h * 64; io.voff = 512 + h * 128; io.goff = 1024 + h * 128; io.ooff = h * 128; io.gaoff = h * 64; io.onorm = a.gla_onorm; io.lb0 = 0.f; io.lb1 = 0.f; }
    return io;
}

template <int DK, bool HG> __device__ __forceinline__ void r1_unit(RLAS unsigned char* lds, const RecArgs& a, int seq, int sc, int h) {
    const HeadIo io = make_io<DK, HG>(a, h);
    f32x4 S[DK / 16]; load_state<DK / 16>(S, nullptr); float dtot = 1.f;
    const size_t rb = (size_t)seq * 8192 + sc * SC_TOK;
    Raw<DK, HG, false> cur, nxt; load_raw<DK, HG, false>(io, rb, 64, cur);
#pragma unroll 1
    for (int c = 0; c < NCH; ++c) { if (c + 1 < NCH) load_raw<DK, HG, false>(io, rb + (c + 1) * 64, 64, nxt); chunk<DK, HG, false>(lds, io, cur, rb + c * 64, 64, S, dtot); cur = nxt; }
    const size_t u = (size_t)seq * NSC + sc;
    store_state<DK / 16>(S, a.ST + u * ST_PER + (HG ? 32768 + h * 16384 : h * 8192));
    { const int t_ = otid(); if (t_ < DK) a.DT[u * DT_PER + (HG ? 256 + h * 128 : h * 64) + t_] = dtot; }
}
template <int DK, bool HG> __device__ __forceinline__ void r3_unit(RLAS unsigned char* lds, const RecArgs& a, int seq, int sc, int h) {
    const HeadIo io = make_io<DK, HG>(a, h);
    const size_t u = (size_t)seq * NSC + sc;
    f32x4 S[DK / 16]; load_state<DK / 16>(S, a.ST + u * ST_PER + (HG ? 32768 + h * 16384 : h * 8192)); float dtot = 1.f;
    const size_t rb = (size_t)seq * 8192 + sc * SC_TOK;
    Raw<DK, HG, true> cur, nxt; load_raw<DK, HG, true>(io, rb, 64, cur);
#pragma unroll 1
    for (int c = 0; c < NCH; ++c) { if (c + 1 < NCH) load_raw<DK, HG, true>(io, rb + (c + 1) * 64, 64, nxt); chunk<DK, HG, true>(lds, io, cur, rb + c * 64, 64, S, dtot); cur = nxt; }
    if (sc == NSC - 1) store_state<DK / 16>(S, (HG ? a.out_shp : a.out_sgp) + (size_t)(seq * 4 + h) * DK * 128);
}
template <int DK, bool HG> __device__ __forceinline__ void rs_unit(RLAS unsigned char* lds, const RecArgs& a, int seq, int h) {
    const HeadIo io = make_io<DK, HG>(a, h);
    f32x4 S[DK / 16]; load_state<DK / 16>(S, (HG ? a.st_hg_in : a.st_gla_in) + (size_t)(seq * 4 + h) * DK * 128); float dtot = 1.f;
    Raw<DK, HG, true> cur; load_raw<DK, HG, true>(io, (size_t)32768 + seq * 32, 32, cur);
    chunk<DK, HG, true>(lds, io, cur, (size_t)32768 + seq * 32, 32, S, dtot);
    store_state<DK / 16>(S, (HG ? a.out_shs : a.out_sgs) + (size_t)(seq * 4 + h) * DK * 128);
}
__device__ __forceinline__ void decode_unit(int u, int& scidx, int& head) { scidx = u >> 3; head = ((u & 7) + 4 * ((u >> 8) & 1)) & 7; }

__device__ __forceinline__ void phase_r1(RLAS unsigned char* lds, const RecArgs& a, int G, int bx) {
    for (int u = bx; u < 4 * NSC * 8; u += G) { int scidx, head; decode_unit(u, scidx, head); const int seq = scidx / NSC, sc = scidx % NSC;
        if (sc == NSC - 1) continue;
        if (head < 4) r1_unit<64, false>(lds, a, seq, sc, head); else r1_unit<128, true>(lds, a, seq, sc, head - 4); }
}
__device__ __forceinline__ void phase_r2(const RecArgs& a, int gtid, int NGT) {
    for (int idx = gtid; idx < ST_PER; idx += NGT) {
        const int seq = idx / (ST_PER / 4), off = (idx % (ST_PER / 4)) * 4; int dti;
        if (off < 32768) dti = (off / 8192) * 64 + (off % 8192) / 128; else { const int o2 = off - 32768; dti = 256 + (o2 / 16384) * 128 + (o2 % 16384) / 128; }
        float* st = a.ST + (size_t)seq * NSC * ST_PER + off; const float* dt = a.DT + (size_t)seq * NSC * DT_PER + dti;
        f32x4 t[NSC - 1]; float dd[NSC - 1];
#pragma unroll
        for (int s = 0; s < NSC - 1; ++s) { t[s] = *(const f32x4*)(st + (size_t)s * ST_PER); dd[s] = dt[(size_t)s * DT_PER]; }
        f32x4 x = {0.f, 0.f, 0.f, 0.f};
#pragma unroll
        for (int s = 0; s < NSC; ++s) { *(f32x4*)(st + (size_t)s * ST_PER) = x; if (s < NSC - 1) x = x * dd[s] + t[s]; }
    }
}
__device__ __forceinline__ void phase_r3(RLAS unsigned char* lds, const RecArgs& a, int G, int bx) {
    for (int u = bx; u < 4 * NSC * 8; u += G) { int scidx, head; decode_unit(u, scidx, head); const int seq = scidx / NSC, sc = scidx % NSC;
        if (head < 4) r3_unit<64, false>(lds, a, seq, sc, head); else r3_unit<128, true>(lds, a, seq, sc, head - 4); }
    for (int u = bx; u < 64; u += G) { const int seq = u >> 3, head = u & 7;
        if (head < 4) rs_unit<64, false>(lds, a, seq, head); else rs_unit<128, true>(lds, a, seq, head - 4); }
}
}
namespace sg {
typedef unsigned short bf16;
typedef short bf16x8 __attribute__((ext_vector_type(8)));
typedef float f32x4 __attribute__((ext_vector_type(4)));
typedef unsigned u32x2 __attribute__((ext_vector_type(2)));
typedef unsigned u32x4 __attribute__((ext_vector_type(4)));
__device__ __forceinline__ int otid() { int t = threadIdx.x; asm volatile("" : "+v"(t)); return t; }
__device__ __forceinline__ unsigned pkbf(float lo, float hi) { return rec::pkbf(lo, hi); }
__device__ __forceinline__ float silu_f(float g) { return g * __builtin_amdgcn_rcpf(1.0f + __expf(-g)); }

constexpr int SPITCH = 272, WREG = 64 * SPITCH;
template <int NT, class Epi>
__device__ __forceinline__ void unit(__attribute__((address_space(3))) unsigned char* lds, const bf16* A, int K, const bf16* bt0, const bf16* bt1, const Epi& E) {
    typedef __attribute__((address_space(3))) unsigned char* lptr;
    const int tid = otid(), lane = tid & 63, wave = tid >> 6, r = lane & 15, g = lane >> 4;
    constexpr int NL = 8 + 4 * NT;
    const lptr img = lds + wave * WREG;
    const bf16* gp[NL];
#pragma unroll
    for (int j = 0; j < NL; ++j) { const int row = 4 * j + g;
        const bf16* base = (j < 8) ? A + (size_t)(32 * wave + row) * K : (j < 12 ? bt0 + (size_t)(row - 32) * K : bt1 + (size_t)(row - 48) * K);
        gp[j] = base + 8 * r; }
    const lptr wp = img + g * SPITCH + 16 * r;
    f32x4 acc[2][NT];
#pragma unroll
    for (int mt = 0; mt < 2; ++mt)
#pragma unroll
        for (int nt = 0; nt < NT; ++nt) acc[mt][nt] = (f32x4){0.f, 0.f, 0.f, 0.f};
    u32x4 st[NL];
    const int nb = K / 128;
#pragma unroll
    for (int j = 0; j < NL; ++j) st[j] = *(const u32x4*)(gp[j]);
#pragma unroll 1
    for (int b = 0; b < nb; ++b) {
#pragma unroll
        for (int j = 0; j < NL; ++j) *(__attribute__((address_space(3))) u32x4*)(wp + 4 * j * SPITCH) = st[j];
        if (b + 1 < nb) {
#pragma unroll
            for (int j = 0; j < NL; ++j) st[j] = *(const u32x4*)(gp[j] + (size_t)(b + 1) * 128);
        }
        asm volatile("s_waitcnt lgkmcnt(0)" ::: "memory");
#pragma unroll
        for (int u = 0; u < 4; ++u) {
            bf16x8 af[2], bfr[NT];
#pragma unroll
            for (int mt = 0; mt < 2; ++mt) af[mt] = *(const __attribute__((address_space(3))) bf16x8*)(img + (16 * mt + r) * SPITCH + (4 * u + g) * 16);
#pragma unroll
            for (int nt = 0; nt < NT; ++nt) bfr[nt] = *(const __attribute__((address_space(3))) bf16x8*)(img + (32 + 16 * nt + r) * SPITCH + (4 * u + g) * 16);
#pragma unroll
            for (int mt = 0; mt < 2; ++mt)
#pragma unroll
                for (int nt = 0; nt < NT; ++nt) acc[mt][nt] = __builtin_amdgcn_mfma_f32_16x16x32_bf16(bfr[nt], af[mt], acc[mt][nt], 0, 0, 0);
        }
        asm volatile("s_waitcnt lgkmcnt(0)" ::: "memory");
    }
    E(acc, wave, r, g);
}

struct EpiUpS {
    bf16* H; int ldh; const float* ssq; int hc0;
    __device__ __forceinline__ void operator()(const f32x4 (&acc)[2][2], int wave, int r, int g) const {
#pragma unroll
        for (int mt = 0; mt < 2; ++mt) { const int row = 32 * wave + 16 * mt + r; const float rs = rsqrtf(ssq[row] * (1.0f / 1024.0f) + 1e-6f);
            float h[4];
#pragma unroll
            for (int i = 0; i < 4; ++i) h[i] = silu_f(acc[mt][0][i] * rs) * (acc[mt][1][i] * rs);
            *(u32x2*)(H + (size_t)row * ldh + hc0 + 4 * g) = (u32x2){pkbf(h[0], h[1]), pkbf(h[2], h[3])}; }
    }
};
struct EpiResS {
    const float* xf; bf16* xb; float* ssq; float scale; int c0;
    __device__ __forceinline__ void operator()(const f32x4 (&acc)[2][1], int wave, int r, int g) const {
#pragma unroll
        for (int mt = 0; mt < 2; ++mt) { const int row = 32 * wave + 16 * mt + r; const size_t off = (size_t)row * 1024 + c0 + 4 * g; f32x4 res;
            if (xf) res = *(const f32x4*)(xf + off);
            else { const u32x2 rb = *(const u32x2*)(xb + off); res = (f32x4){__builtin_bit_cast(float, rb.x << 16), __builtin_bit_cast(float, rb.x & 0xffff0000u), __builtin_bit_cast(float, rb.y << 16), __builtin_bit_cast(float, rb.y & 0xffff0000u)}; }
            const f32x4 v = res + acc[mt][0] * scale;
            float s = (v[0] * v[0] + v[1] * v[1]) + (v[2] * v[2] + v[3] * v[3]);
            s += __shfl_xor(s, 16); s += __shfl_xor(s, 32);
            if (g == 0) __hip_atomic_fetch_add(ssq + row, s, __ATOMIC_RELAXED, __HIP_MEMORY_SCOPE_AGENT);
            *(u32x2*)(xb + off) = (u32x2){pkbf(v[0], v[1]), pkbf(v[2], v[3])}; }
    }
};
struct EpiWinS {
    bf16* P; float* GA; const float* ssq; const float* gbias; int c0;
    __device__ __forceinline__ void operator()(const f32x4 (&acc)[2][2], int wave, int r, int g) const {
        const int pn = c0 >> 8;
#pragma unroll
        for (int mt = 0; mt < 2; ++mt) { const int row = 32 * wave + 16 * mt + r; const float rs = rsqrtf(ssq[row] * (1.0f / 1024.0f) + 1e-6f);
#pragma unroll
            for (int nt = 0; nt < 2; ++nt) { const int col = c0 + 16 * nt + 4 * g; f32x4 v = acc[mt][nt] * rs;
                if (pn == 14) { const int tc = col & 255; f32x4 o;
#pragma unroll
                    for (int i = 0; i < 4; ++i) { const float x = v[i] + gbias[tc + i]; const float ls = fminf(x, 0.f) - __logf(1.0f + __expf(-fabsf(x))); o[i] = __expf(ls * 0.0625f); }
                    *(f32x4*)(GA + (size_t)row * 256 + tc) = o;
                } else {
                    if (pn == 0) v = v * 0.125f;
                    else if (pn == 6 || pn == 7) { v[0] = silu_f(v[0]); v[1] = silu_f(v[1]); v[2] = silu_f(v[2]); v[3] = silu_f(v[3]); }
                    *(u32x2*)(P + (size_t)row * 3584 + col) = (u32x2){pkbf(v[0], v[1]), pkbf(v[2], v[3])};
                } } }
    }
};
}
#define GAS __attribute__((address_space(1)))
#define LAS __attribute__((address_space(3)))
typedef unsigned short bf16;
typedef unsigned v4u __attribute__((ext_vector_type(4)));
typedef float f32x4 __attribute__((ext_vector_type(4)));
constexpr int NWAVES = 8;
constexpr int D = 1024, FF = 2816, MP = 32768, MS = 256, M = MP + MS, PW = 3584, NIN = 3840, DINSRC = 3600;
constexpr float EPS = 1e-6f;
constexpr size_t MiB = 1u << 20;
constexpr size_t WS_SSQ = 0, SSQ_STRIDE = (size_t)M * 4;
constexpr size_t WS_BAR = 768 * 1024, BAR_BYTES = 16384;
constexpr int MISC_OFF = 147456 - 64;
constexpr size_t WS_WGU1 = 1 * MiB, WS_WD1 = 12 * MiB, WS_WIN = 18 * MiB, WS_WO = 26 * MiB, WS_WGU2 = 28 * MiB, WS_WD2 = 39 * MiB;
constexpr size_t WS_XB = 45 * MiB, WS_MIX = 110 * MiB, WS_P = 175 * MiB, WS_HID = WS_P, WS_GA = 401 * MiB, WS_ST = 434 * MiB, WS_DT = 483 * MiB, WS_DUMMY = 484 * MiB, WS_END = 512 * MiB;
static_assert(WS_P + (size_t)M * PW * 2 <= WS_GA && WS_GA + (size_t)M * 256 * 4 <= WS_ST && WS_XB + (size_t)M * D * 2 <= WS_MIX && WS_MIX + (size_t)M * D * 2 <= WS_P, "ws map");
constexpr size_t O_Y = 0, O_SGP = (size_t)M * D, O_SHP = O_SGP + 4 * 4 * 64 * 128, O_SGS = O_SHP + 4 * 4 * 128 * 128, O_SHS = O_SGS + 8 * 4 * 64 * 128, O_END = O_SHS + 8 * 4 * 128 * 128;
constexpr int LDS_BYTES = 147456;

__device__ __forceinline__ unsigned f2bf(float f) { unsigned u = __builtin_bit_cast(unsigned, f); return (u + 0x7fffu + ((u >> 16) & 1u)) >> 16; }
__device__ __forceinline__ unsigned pk2(float lo, float hi) { return f2bf(lo) | (f2bf(hi) << 16); }
__device__ __forceinline__ float bf2f(bf16 b) { return __builtin_bit_cast(float, (unsigned)b << 16); }
#define LDS_WAIT() asm volatile("s_waitcnt lgkmcnt(0)" ::: "memory")

#define XB_TMO      128
#define XB_XCNT(j)  (256  + 64 * (j))
#define XB_XSUB(j)  (1280 + 64 * (j))
#define XB_XGEN(j)  (2304 + 64 * (j))
#define XB_TOP      3328
#define XB_TOPGEN   3392
#define XCD_BAR_WORDS 3456
#define XB_SPIN_CAP (1u << 18)

__device__ __forceinline__ unsigned xb_ld(unsigned* p)              { return __hip_atomic_load(p, __ATOMIC_RELAXED, __HIP_MEMORY_SCOPE_AGENT); }
__device__ __forceinline__ unsigned xb_add(unsigned* p, unsigned v) { return __hip_atomic_fetch_add(p, v, __ATOMIC_RELAXED, __HIP_MEMORY_SCOPE_AGENT); }
__device__ __forceinline__ unsigned xb_xcc_id() { return (unsigned)__builtin_amdgcn_s_getreg((3 << 11) | 20) & 0xFu; }
#define XB_SPIN(cond, bar) do { unsigned _sp = 0; while (cond) { __builtin_amdgcn_s_sleep(1); \
    if ((++_sp & 255u) == 0u) { if (xb_ld(&(bar)[XB_TMO])) break; if (_sp > XB_SPIN_CAP) { atomicAdd(&(bar)[XB_TMO], 1u); break; } } } } while (0)

struct XcdBarrier {
    unsigned* bar; unsigned x;
    volatile LAS unsigned* st;
};

__device__ __forceinline__ XcdBarrier xcd_barrier_post(unsigned* bar, volatile LAS unsigned* st) {
    XcdBarrier b; b.bar = bar; b.x = xb_xcc_id(); b.st = st;
    if (threadIdx.x == 0) (void)xb_add(&bar[XB_XCNT(b.x)], 1u);
    return b;
}
__device__ __forceinline__ void xcd_barrier_complete(unsigned* bar, unsigned x, unsigned& nloc, unsigned& nx) {
    const unsigned G = gridDim.x * gridDim.y * gridDim.z;
    unsigned sum, cnt, mine, sp = 0u;
    for (;;) {
        sum = 0u; cnt = 0u; mine = 0u;
#pragma unroll
        for (unsigned j = 0; j < 16; ++j) { const unsigned c = xb_ld(&bar[XB_XCNT(j)]); sum += c; cnt += (c > 0u) ? 1u : 0u; mine = (j == x) ? c : mine; }
        if (sum == G) break;
        __builtin_amdgcn_s_sleep(1);
        if ((++sp & 255u) == 0u) { if (xb_ld(&bar[XB_TMO])) break; if (sp > XB_SPIN_CAP) { atomicAdd(&bar[XB_TMO], 1u); break; } }
    }
    nloc = mine > 0u ? mine : 1u; nx = cnt > 0u ? cnt : 1u;
}

__device__ __forceinline__ void xcd_barrier(const XcdBarrier& b) {
    asm volatile("s_waitcnt vmcnt(0)" ::: "memory");
    __syncthreads();
    if (threadIdx.x == 0) {
        unsigned* bar = b.bar;
        __builtin_amdgcn_s_waitcnt(0);
        unsigned nloc = b.st[0], nx = b.st[1];
        if (nloc == 0u) { xcd_barrier_complete(bar, b.x, nloc, nx); b.st[0] = nloc; b.st[1] = nx; }
        const unsigned old = xb_add(&bar[XB_XSUB(b.x)], 1u);
        const unsigned gen = old / nloc;
        if (old + 1u == (gen + 1u) * nloc) {
            __builtin_amdgcn_fence(__ATOMIC_RELEASE, "agent");
            asm volatile("s_waitcnt vmcnt(0)" ::: "memory");
            const unsigned og = xb_add(&bar[XB_TOP], 1u);
            const unsigned tg = og / nx;
            if (og + 1u == (tg + 1u) * nx) xb_add(&bar[XB_TOPGEN], 1u);
            else XB_SPIN(xb_ld(&bar[XB_TOPGEN]) == tg, bar);
            __builtin_amdgcn_fence(__ATOMIC_ACQUIRE, "agent");
            xb_add(&bar[XB_XGEN(b.x)], 1u);
            asm volatile("s_waitcnt vmcnt(0)" ::: "memory");
        } else {
            XB_SPIN(xb_ld(&bar[XB_XGEN(b.x)]) == gen, bar);
            __builtin_amdgcn_fence(__ATOMIC_ACQUIRE, "agent");
            asm volatile("s_waitcnt vmcnt(0)" ::: "memory");
        }
    }
    __syncthreads();
}

#ifndef DUPMASK
#define DUPMASK 0
#endif
struct Args { const float* in[21]; float* out; unsigned char* ws; int ph_lo, ph_hi, dup, pad; };
typedef const Args __attribute__((address_space(4))) CArgs;

__device__ __forceinline__ float wave_sum(float v) {
#pragma unroll
    for (int o = 1; o < 64; o <<= 1) v += __shfl_xor(v, o);
    return v;
}
__device__ __forceinline__ void tr_item(const float* W, int ldw, int src_col0, int k0, const float* gain, bf16* WT, int K, int dst_row0, LAS float* scr, int lane) {
    float w[32];
    const float* wp = W + (size_t)(k0 + (lane >> 5)) * ldw + src_col0 + (lane & 31);
#pragma unroll
    for (int i = 0; i < 32; ++i) w[i] = __builtin_nontemporal_load(wp + (size_t)(2 * i) * ldw);
    if (gain) {
#pragma unroll
        for (int i = 0; i < 32; ++i) w[i] *= gain[k0 + 2 * i + (lane >> 5)];
    }
#pragma unroll
    for (int i = 0; i < 32; ++i) scr[(2 * i + (lane >> 5)) * 33 + (lane & 31)] = w[i];
    LDS_WAIT(); asm volatile("" ::: "memory");
    const int c = lane & 7;
#pragma unroll
    for (int j = 0; j < 4; ++j) { const int n = (lane >> 3) + 8 * j; const LAS float* s = scr + (8 * c) * 33 + n;
        v4u o; o.x = pk2(s[0 * 33], s[1 * 33]); o.y = pk2(s[2 * 33], s[3 * 33]); o.z = pk2(s[4 * 33], s[5 * 33]); o.w = pk2(s[6 * 33], s[7 * 33]);
        *(v4u*)(WT + (size_t)(dst_row0 + n) * K + k0 + 8 * c) = o; }
    LDS_WAIT(); asm volatile("" ::: "memory");
}
__device__ __forceinline__ void weff_item(const float* Win, const float* up, int n0, int k0, const float* gain, bf16* WT, LAS float* scr, int lane) {
    float upr[16];
#pragma unroll
    for (int r = 0; r < 16; ++r) upr[r] = up[r * 256 + n0 + (lane & 31)];
#pragma unroll 4
    for (int i = 0; i < 32; ++i) { const int kk = 2 * i + (lane >> 5); const float* wr = Win + (size_t)(k0 + kk) * DINSRC + 1536; float s = 0.f;
#pragma unroll
        for (int r = 0; r < 16; ++r) s += wr[r] * upr[r];
        scr[kk * 33 + (lane & 31)] = s * gain[k0 + kk]; }
    LDS_WAIT(); asm volatile("" ::: "memory");
    const int c = lane & 7;
#pragma unroll
    for (int j = 0; j < 4; ++j) { const int n = (lane >> 3) + 8 * j; const LAS float* s = scr + (8 * c) * 33 + n;
        v4u o; o.x = pk2(s[0 * 33], s[1 * 33]); o.y = pk2(s[2 * 33], s[3 * 33]); o.z = pk2(s[4 * 33], s[5 * 33]); o.w = pk2(s[6 * 33], s[7 * 33]);
        *(v4u*)(WT + (size_t)(3584 + n0 + n) * 1024 + k0 + 8 * c) = o; }
    LDS_WAIT(); asm volatile("" ::: "memory");
}
__device__ __forceinline__ void gu_item(int r, const float* wg, const float* wu, const float* gain, bf16* WT, LAS float* scr, int lane) {
    const int kb = r / 176, nb = r % 176, dst = 32 * nb, tile = dst >> 8, j = dst & 255;
    const float* W = (j < 128) ? wg : wu; const int src = tile * 128 + (j & 127);
    tr_item(W, FF, src, 64 * kb, gain, WT, D, dst, scr, lane);
}

__device__ __forceinline__ int opaque_tid() { int t = threadIdx.x; asm volatile("" : "+v"(t)); return t; }
__device__ __forceinline__ void p0_prologue(CArgs& a, LAS unsigned char* lds, int G, int bx) {
    const int tid = opaque_tid(), lane = tid & 63, wave = __builtin_amdgcn_readfirstlane(tid >> 6);
    const int gw = bx * NWAVES + wave, NGW = G * NWAVES, gtid = bx * (NWAVES * 64) + tid, NGT = G * NWAVES * 64;
    LAS float* scr = (LAS float*)(lds + wave * 16384);
    unsigned char* ws = a.ws;
    constexpr int I_GU = 16 * 176, I_D = 44 * 32, I_IN = 16 * 112, I_EFF = 16 * 8, I_O = 16 * 32;
    constexpr int NITEMS = 2 * I_GU + 2 * I_D + I_IN + I_EFF + I_O;
    for (int it = gw; it < NITEMS; it += NGW) {
        int r = it; asm volatile("" : "+s"(ws));
        if (r < I_GU) { gu_item(r, a.in[5], a.in[6], a.in[4], (bf16*)(ws + WS_WGU1), scr, lane); continue; } r -= I_GU;
        if (r < I_D) { tr_item(a.in[7], D, 32 * (r % 32), 64 * (r / 32), nullptr, (bf16*)(ws + WS_WD1), FF, 32 * (r % 32), scr, lane); continue; } r -= I_D;
        if (r < I_IN) { const int kb = r / 112, nb = r % 112, dst = 32 * nb, src = dst < 1536 ? dst : dst + 16;
            tr_item(a.in[9], DINSRC, src, 64 * kb, a.in[8], (bf16*)(ws + WS_WIN), D, dst, scr, lane); continue; } r -= I_IN;
        if (r < I_EFF) { weff_item(a.in[9], a.in[10], 32 * (r % 8), 64 * (r / 8), a.in[8], (bf16*)(ws + WS_WIN), scr, lane); continue; } r -= I_EFF;
        if (r < I_O) { tr_item(a.in[15], D, 32 * (r % 32), 64 * (r / 32), nullptr, (bf16*)(ws + WS_WO), D, 32 * (r % 32), scr, lane); continue; } r -= I_O;
        if (r < I_GU) { gu_item(r, a.in[17], a.in[18], a.in[16], (bf16*)(ws + WS_WGU2), scr, lane); continue; } r -= I_GU;
        tr_item(a.in[19], D, 32 * (r % 32), 64 * (r / 32), nullptr, (bf16*)(ws + WS_WD2), FF, 32 * (r % 32), scr, lane);
    }
    float* ssq1 = (float*)(ws + WS_SSQ); bf16* XB = (bf16*)(ws + WS_XB);
    for (int m0 = 2 * gw; m0 < M; m0 += 2 * NGW) {
        f32x4 v[2][4]; float s[2];
#pragma unroll
        for (int h = 0; h < 2; ++h) { const int m = m0 + h;
            const float* xrow = (m < MP) ? a.in[0] + (size_t)m * D : a.in[1] + (size_t)(m - MP) * D;
            const f32x4* xr = (const f32x4*)xrow + lane;
#pragma unroll
            for (int j = 0; j < 4; ++j) v[h][j] = __builtin_nontemporal_load(xr + 64 * j); }
#pragma unroll
        for (int h = 0; h < 2; ++h) { const int m = m0 + h; float ss = 0.f;
#pragma unroll
            for (int j = 0; j < 4; ++j) ss += (v[h][j].x * v[h][j].x + v[h][j].y * v[h][j].y) + (v[h][j].z * v[h][j].z + v[h][j].w * v[h][j].w);
            s[h] = wave_sum(ss);
            unsigned long long* o8 = (unsigned long long*)(XB + (size_t)m * D) + lane;
#pragma unroll
            for (int j = 0; j < 4; ++j) o8[64 * j] = (unsigned long long)pk2(v[h][j].x, v[h][j].y) | ((unsigned long long)pk2(v[h][j].z, v[h][j].w) << 32);
            if (lane == 0) ssq1[m] = s[h]; }
    }
    for (int i = gtid; i < 3 * M; i += NGT) ssq1[M + i] = 0.f;
}

__device__ __forceinline__ void p8_final(CArgs& a, int G, int bx) {
    const int tid = opaque_tid(), lane = tid & 63, wave = __builtin_amdgcn_readfirstlane(tid >> 6);
    const int gw = bx * NWAVES + wave, NGW = G * NWAVES;
    const float* ssq4 = (const float*)(a.ws + WS_SSQ) + 3 * (size_t)M; const bf16* XB = (const bf16*)(a.ws + WS_XB);
    const f32x4* g = (const f32x4*)a.in[20] + 2 * lane;
    f32x4 gv[2][2];
#pragma unroll
    for (int j = 0; j < 2; ++j) { gv[j][0] = g[128 * j]; gv[j][1] = g[128 * j + 1]; }
    for (int m0 = 2 * gw; m0 < M; m0 += 2 * NGW) {
        v4u xv[2][2];
#pragma unroll
        for (int h = 0; h < 2; ++h)
#pragma unroll
            for (int j = 0; j < 2; ++j) xv[h][j] = __builtin_nontemporal_load((const v4u*)(XB + (size_t)(m0 + h) * D) + lane + 64 * j);
#pragma unroll
        for (int h = 0; h < 2; ++h) { const float rs = rsqrtf(ssq4[m0 + h] * (1.0f / 1024.0f) + EPS); f32x4* yr = (f32x4*)(a.out + (size_t)(m0 + h) * D) + 2 * lane;
#pragma unroll
            for (int j = 0; j < 2; ++j) { const v4u x = xv[h][j];
                const f32x4 lo = {__builtin_bit_cast(float, x.x << 16), __builtin_bit_cast(float, x.x & 0xffff0000u), __builtin_bit_cast(float, x.y << 16), __builtin_bit_cast(float, x.y & 0xffff0000u)};
                const f32x4 hi = {__builtin_bit_cast(float, x.z << 16), __builtin_bit_cast(float, x.z & 0xffff0000u), __builtin_bit_cast(float, x.w << 16), __builtin_bit_cast(float, x.w & 0xffff0000u)};
                __builtin_nontemporal_store(lo * rs * gv[j][0], yr + 128 * j); __builtin_nontemporal_store(hi * rs * gv[j][1], yr + 128 * j + 1); } }
    }
}

__device__ __forceinline__ CArgs& kargs() { CArgs* p = (CArgs*)__builtin_amdgcn_kernarg_segment_ptr(); asm volatile("" : "+s"(p)); return *p; }
__global__ void __launch_bounds__(NWAVES * 64, 2) mega_fwd(Args args_unused) {
    extern __shared__ __attribute__((aligned(16))) unsigned char lds_raw[];
    cg::grid_group grid = cg::this_grid();
    LAS unsigned char* lds = (LAS unsigned char*)lds_raw;
    const int G = gridDim.x, bx = blockIdx.x;
    const int lo = kargs().ph_lo, hi = kargs().ph_hi, dup = kargs().dup;
    volatile LAS unsigned* misc = (volatile LAS unsigned*)(lds + MISC_OFF);
    if (threadIdx.x < 16) misc[threadIdx.x] = 0u;
    __syncthreads();
    XcdBarrier xbar = xcd_barrier_post((unsigned*)(kargs().ws + WS_BAR), misc);
    if (lo == 0) grid.sync();
#define IN(k) (lo <= (k) && (k) < hi)
#define BOTH(k) (IN(k) && IN((k) + 1))
#define GRID_BAR() xcd_barrier(xbar)
#define REP(k) for (int rep_ = ((dup >> (k)) & 1); rep_ >= 0; --rep_)
#define SSQ(a, i) ((float*)((a).ws + WS_SSQ) + (size_t)(i) * M)

    if (IN(0)) REP(0) { p0_prologue(kargs(), lds, G, bx); if (BOTH(0)) GRID_BAR(); }
    if (IN(1)) REP(1) {
        CArgs& a = kargs(); unsigned char* ws = a.ws;
        pg8::Gemm g{(const bf16*)(ws + WS_XB), (const bf16*)(ws + WS_WGU1), MP, 2 * FF, D}; pg8::StaticOrder S; S.init(MP, 2 * FF, G, bx);
        pg8::EpiUp E{(bf16*)(ws + WS_HID), FF, SSQ(a, 0)};
        pg8::gemm_phase<pg8::EpiUp, pg8::StaticOrder, true, true>(lds, g, S, E);
        for (int u = bx; u < FF / 16; u += G) { const int hc0 = 16 * u; const bf16* W = (const bf16*)(ws + WS_WGU1) + (size_t)((hc0 >> 7) * 256 + (hc0 & 127)) * D;
            sg::EpiUpS Es{(bf16*)(ws + WS_HID) + (size_t)MP * FF, FF, SSQ(a, 0) + MP, hc0}; sg::unit<2>(lds, (const bf16*)(ws + WS_XB) + (size_t)MP * D, D, W, W + (size_t)128 * D, Es); }
        if (BOTH(1)) GRID_BAR();
    }
    if (IN(2)) REP(2) {
        CArgs& a = kargs(); unsigned char* ws = a.ws;
        pg8::Gemm g{(const bf16*)(ws + WS_HID), (const bf16*)(ws + WS_WD1), MP, D, FF}; pg8::StaticOrder S; S.init(MP, D, G, bx);
        pg8::EpiRes E{a.in[0], a.in[1], MP / 256, (bf16*)(ws + WS_XB), rep_ ? (float*)(ws + WS_DUMMY) : SSQ(a, 1), rep_ ? 0.f : 0.5f};
        pg8::gemm_phase<pg8::EpiRes, pg8::StaticOrder, true, true>(lds, g, S, E);
        for (int u = bx; u < D / 16; u += G) { const int c0 = 16 * u; const bf16* W = (const bf16*)(ws + WS_WD1) + (size_t)c0 * FF;
            sg::EpiResS Es{a.in[1], (bf16*)(ws + WS_XB) + (size_t)MP * D, (rep_ ? (float*)(ws + WS_DUMMY) : SSQ(a, 1)) + MP, rep_ ? 0.f : 0.5f, c0}; sg::unit<1>(lds, (const bf16*)(ws + WS_HID) + (size_t)MP * FF, FF, W, W, Es); }
        if (BOTH(2)) GRID_BAR();
    }
    if (IN(3)) REP(3) {
        CArgs& a = kargs(); unsigned char* ws = a.ws;
        pg8::Gemm g{(const bf16*)(ws + WS_XB), (const bf16*)(ws + WS_WIN), MP, NIN, D}; pg8::StaticOrder S; S.init(MP, NIN, G, bx);
        pg8::EpiWin E{(bf16*)(ws + WS_P), (float*)(ws + WS_GA), SSQ(a, 1), a.in[11]};
        pg8::gemm_phase<pg8::EpiWin, pg8::StaticOrder, true, true>(lds, g, S, E);
        for (int u = (bx + G / 2) % G; u < NIN / 32; u += G) { const int c0 = 32 * u; const bf16* W = (const bf16*)(ws + WS_WIN) + (size_t)c0 * D;
            sg::EpiWinS Es{(bf16*)(ws + WS_P) + (size_t)MP * PW, (float*)(ws + WS_GA) + (size_t)MP * 256, SSQ(a, 1) + MP, a.in[11], c0}; sg::unit<2>(lds, (const bf16*)(ws + WS_XB) + (size_t)MP * D, D, W, W + (size_t)16 * D, Es); }
        if (BOTH(3)) GRID_BAR();
    }
#define MAKE_RA(a) rec::RecArgs ra{(const bf16*)((a).ws + WS_P), (const float*)((a).ws + WS_GA), (bf16*)((a).ws + WS_MIX), (a).in[13], (a).in[12], (a).in[14], (a).in[2], (a).in[3], \
                        (float*)((a).ws + WS_ST), (float*)((a).ws + WS_DT), (a).out + O_SGP, (a).out + O_SHP, (a).out + O_SGS, (a).out + O_SHS}
    if (IN(4)) REP(4) { CArgs& a = kargs(); MAKE_RA(a); rec::phase_r1(lds, ra, G, bx); if (BOTH(4)) GRID_BAR(); }
    if (IN(5)) { CArgs& a = kargs(); MAKE_RA(a); rec::phase_r2(ra, bx * (NWAVES * 64) + opaque_tid(), G * NWAVES * 64); if (BOTH(5)) GRID_BAR(); }
    if (IN(6)) REP(6) { CArgs& a = kargs(); MAKE_RA(a); rec::phase_r3(lds, ra, G, bx); if (BOTH(6)) GRID_BAR(); }
    if (IN(7)) REP(7) {
        CArgs& a = kargs(); unsigned char* ws = a.ws;
        pg8::Gemm g{(const bf16*)(ws + WS_MIX), (const bf16*)(ws + WS_WO), MP, D, D}; pg8::StaticOrder S; S.init(MP, D, G, bx);
        pg8::EpiRes E{nullptr, nullptr, 1 << 30, (bf16*)(ws + WS_XB), rep_ ? (float*)(ws + WS_DUMMY) : SSQ(a, 2), rep_ ? 0.f : 1.0f};
        pg8::gemm_phase<pg8::EpiRes, pg8::StaticOrder, true, true>(lds, g, S, E);
        for (int u = bx; u < D / 16; u += G) { const int c0 = 16 * u; const bf16* W = (const bf16*)(ws + WS_WO) + (size_t)c0 * D;
            sg::EpiResS Es{nullptr, (bf16*)(ws + WS_XB) + (size_t)MP * D, (rep_ ? (float*)(ws + WS_DUMMY) : SSQ(a, 2)) + MP, rep_ ? 0.f : 1.0f, c0}; sg::unit<1>(lds, (const bf16*)(ws + WS_MIX) + (size_t)MP * D, D, W, W, Es); }
        if (BOTH(7)) GRID_BAR();
    }
    if (IN(8)) REP(8) {
        CArgs& a = kargs(); unsigned char* ws = a.ws;
        pg8::Gemm g{(const bf16*)(ws + WS_XB), (const bf16*)(ws + WS_WGU2), MP, 2 * FF, D}; pg8::StaticOrder S; S.init(MP, 2 * FF, G, bx);
        pg8::EpiUp E{(bf16*)(ws + WS_HID), FF, SSQ(a, 2)};
        pg8::gemm_phase<pg8::EpiUp, pg8::StaticOrder, true, true>(lds, g, S, E);
        for (int u = bx; u < FF / 16; u += G) { const int hc0 = 16 * u; const bf16* W = (const bf16*)(ws + WS_WGU2) + (size_t)((hc0 >> 7) * 256 + (hc0 & 127)) * D;
            sg::EpiUpS Es{(bf16*)(ws + WS_HID) + (size_t)MP * FF, FF, SSQ(a, 2) + MP, hc0}; sg::unit<2>(lds, (const bf16*)(ws + WS_XB) + (size_t)MP * D, D, W, W + (size_t)128 * D, Es); }
        if (BOTH(8)) GRID_BAR();
    }
    if (IN(9)) REP(9) {
        CArgs& a = kargs(); unsigned char* ws = a.ws;
        pg8::Gemm g{(const bf16*)(ws + WS_HID), (const bf16*)(ws + WS_WD2), MP, D, FF}; pg8::StaticOrder S; S.init(MP, D, G, bx);
        pg8::EpiRes E{nullptr, nullptr, 1 << 30, (bf16*)(ws + WS_XB), rep_ ? (float*)(ws + WS_DUMMY) : SSQ(a, 3), rep_ ? 0.f : 0.5f};
        pg8::gemm_phase<pg8::EpiRes, pg8::StaticOrder, true, true>(lds, g, S, E);
        for (int u = bx; u < D / 16; u += G) { const int c0 = 16 * u; const bf16* W = (const bf16*)(ws + WS_WD2) + (size_t)c0 * FF;
            sg::EpiResS Es{nullptr, (bf16*)(ws + WS_XB) + (size_t)MP * D, (rep_ ? (float*)(ws + WS_DUMMY) : SSQ(a, 3)) + MP, rep_ ? 0.f : 0.5f, c0}; sg::unit<1>(lds, (const bf16*)(ws + WS_HID) + (size_t)MP * FF, FF, W, W, Es); }
        if (BOTH(9)) GRID_BAR();
    }
    if (IN(10)) p8_final(kargs(), G, bx);
    if (dup & 2048) for (int i = 0; i < 20; ++i) GRID_BAR();
#undef IN
#undef BOTH
}

extern "C" void kernel_launch(void* const* d_in, const int* in_sizes, int n_in, void* d_out, int out_size, void* d_ws, size_t ws_size, hipStream_t stream) {
    static int grid = 0;
    if (grid == 0) {
        if (n_in != 21 || out_size != (int)O_END || ws_size < WS_END) { fprintf(stderr, "kernel_launch: unexpected sizes n_in %d out %d ws %zu\n", n_in, out_size, ws_size); grid = -1; return; }
        int dev = 0, cus = 0, per_cu = 0;
        (void)hipGetDevice(&dev); (void)hipDeviceGetAttribute(&cus, hipDeviceAttributeMultiprocessorCount, dev);
        if (hipFuncSetAttribute((const void*)mega_fwd, hipFuncAttributeMaxDynamicSharedMemorySize, LDS_BYTES) != hipSuccess) { fprintf(stderr, "hipFuncSetAttribute failed\n"); grid = -1; return; }
        if (hipOccupancyMaxActiveBlocksPerMultiprocessor(&per_cu, (const void*)mega_fwd, NWAVES * 64, LDS_BYTES) != hipSuccess || per_cu < 1) { fprintf(stderr, "occupancy query: %d\n", per_cu); per_cu = 1; }
        (void)hipGetLastError();
        grid = cus * per_cu;
    }
    if (grid < 0) return;
    Args a{};
    for (int i = 0; i < 21; ++i) a.in[i] = (const float*)d_in[i];
    a.out = (float*)d_out; a.ws = (unsigned char*)d_ws;
    a.ph_lo = 0; a.ph_hi = 11; a.dup = DUPMASK;
    if (hipMemsetAsync((char*)d_ws + WS_BAR, 0, BAR_BYTES, stream) != hipSuccess) { fprintf(stderr, "kernel_launch: memset of the barrier words failed\n"); return; }
    void* kargs[] = {&a};
    hipError_t e = hipLaunchCooperativeKernel((const void*)mega_fwd, dim3(grid), dim3(NWAVES * 64), kargs, LDS_BYTES, stream);
    if (e != hipSuccess) fprintf(stderr, "cooperative launch failed: %s (grid %d)\n", hipGetErrorString(e), grid);
}
```

```cpp
#include <hip/hip_runtime.h>
#include <hip/hip_cooperative_groups.h>
#include <cstdio>
#include <cstdint>
namespace cg = cooperative_groups;
namespace pg8 {
#define PG8_LAS __attribute__((address_space(3)))
typedef unsigned short bf16_t;
typedef short bf16x8 __attribute__((ext_vector_type(8)));
typedef float f32x4 __attribute__((ext_vector_type(4)));
typedef unsigned u32x4 __attribute__((ext_vector_type(4)));
constexpr int BM = 256, BK = 64, HALF = 128, HTB = HALF * BK * 2  , STAGE_BYTES = 8 * HTB, NXCD = 8, WGM = 8;

__host__ __device__ __forceinline__ int lds_byte(int r, int c) { const int st = (r >> 4) * 2 + (c >> 5), rr = r & 15, cc = c & 31, ob = rr * 64 + cc * 2; return st * 1024 + (ob ^ (((ob >> 9) & 1) << 5)); }
__host__ __device__ __forceinline__ void stage_rc(int b, int& R, int& C) { const int st = b / 1024, sb = b % 1024, swz = sb ^ (((sb >> 9) & 1) << 5); R = (st >> 1) * 16 + swz / 64; C = (st & 1) * 32 + (swz % 64) / 2; }
__host__ __device__ __forceinline__ int perm32(int rho) { const int n = rho >> 4, i = rho & 15; return 8 * (i >> 2) + 4 * n + (i & 3); }

struct Unit { int pm, pn; };
struct Gemm { const bf16_t* A; const bf16_t* Bt; int M, N, K; int a_tiled = 0; };

struct StaticOrder {
    int nM, nN, nwg, G, c;
    __host__ __device__ void init(int M, int N, int G_, int c_) { nM = M / BM; nN = N / BM; nwg = nM * nN; G = G_; c = c_; }
    __host__ __device__ bool next(int i, Unit& u) const {
        const long L = (long)i * G + c; if (L >= nwg) return false;
        int wgid = (int)L; { const int q = nwg / NXCD, r = nwg % NXCD, xcd = wgid % NXCD, off = wgid / NXCD; wgid = (xcd < r ? xcd * (q + 1) : r * (q + 1) + (xcd - r) * q) + off; }
        const int nig = WGM * nN, gid = wgid / nig, fm = gid * WGM, gsz = (nM - fm) < WGM ? (nM - fm) : WGM;
        u.pm = fm + ((wgid % nig) % gsz); u.pn = (wgid % nig) / gsz; return true;
    }
    __device__ __forceinline__ void a_ready(const Unit&) const {}
    __device__ __forceinline__ void done(const Unit&) const {}
};

__device__ __forceinline__ unsigned cvt_pk_bf16(float lo, float hi) { unsigned r; asm volatile("v_cvt_pk_bf16_f32 %0, %1, %2" : "=v"(r) : "v"(lo), "v"(hi)); return r; }
typedef float f32x2 __attribute__((ext_vector_type(2)));
constexpr float RMS_EPS = 1e-6f;
__device__ __forceinline__ float silu_f(float g) { return g * __builtin_amdgcn_rcpf(1.0f + __expf(-g)); }
__device__ __forceinline__ float rstd_of(const float* ssq, int row) { return rsqrtf(ssq[row] * (1.0f / 1024.0f) + RMS_EPS); }

struct EpiUp {
    static constexpr bool PERM = true, AFTER_DRAIN = false, HAS_PF = false;
    bf16_t* H; int ldh; const float* ssq;
    __device__ __forceinline__ void operator()(const f32x4 (&acc)[2][2][4][2], const Unit& u, int wr, int wc, int fr, int fq) const {
        const int row0 = u.pm * BM + wr * 64 + fr, hcol0 = u.pn * HALF + wc * 32 + 8 * fq;
#pragma unroll
        for (int ai = 0; ai < 2; ++ai)
#pragma unroll
            for (int m = 0; m < 4; ++m) {
                const int row = row0 + ai * HALF + m * 16; const float rs = rstd_of(ssq, row);
                float h[8]; const float ne = rs * -1.4426950408889634f, rs2 = rs * rs;
#pragma unroll
                for (int n = 0; n < 2; ++n)
#pragma unroll
                    for (int p = 0; p < 2; ++p) {
                        const f32x2 ag = {acc[ai][0][m][n][2 * p], acc[ai][0][m][n][2 * p + 1]}, au = {acc[ai][1][m][n][2 * p], acc[ai][1][m][n][2 * p + 1]};
                        const f32x2 x = ag * ne; f32x2 t; t.x = __builtin_amdgcn_exp2f(x.x); t.y = __builtin_amdgcn_exp2f(x.y);
                        const f32x2 den = t + 1.0f, num = (ag * au) * rs2; f32x2 rc; rc.x = __builtin_amdgcn_rcpf(den.x); rc.y = __builtin_amdgcn_rcpf(den.y);
                        const f32x2 o = num * rc; h[4 * n + 2 * p] = o.x; h[4 * n + 2 * p + 1] = o.y; }
                u32x4 w; w.x = cvt_pk_bf16(h[0], h[1]); w.y = cvt_pk_bf16(h[2], h[3]); w.z = cvt_pk_bf16(h[4], h[5]); w.w = cvt_pk_bf16(h[6], h[7]);
                *(u32x4*)(H + (size_t)(row >> 8) * (BM * ldh) + (size_t)(hcol0 >> 6) * (BM * BK) + (row & 255) * BK + (hcol0 & 63)) = w;
            }
    }
};

struct EpiRes {
    static constexpr bool PERM = true, AFTER_DRAIN = false, HAS_PF = false;
    __device__ __forceinline__ void prefetch(const Unit& u, PG8_LAS unsigned char* dummy, int wid, int lane) const {
        PG8_LAS unsigned* dst = (PG8_LAS unsigned*)(dummy + wid * 1024);
        if (xf0) { const char* ub = (const char*)(((u.pm < split_pm) ? xf0 : (xf1 - (size_t)split_pm * BM * 1024)) + (size_t)(u.pm * BM + 32 * wid) * 1024 + u.pn * BM);
            asm volatile("" : "+s"(ub)); unsigned lo = (unsigned)lane * 16u; asm volatile("" : "+v"(lo));
#pragma unroll
            for (int j = 0; j < 32; ++j) __builtin_amdgcn_global_load_lds((const unsigned*)(ub + (size_t)j * 4096 + lo), dst, 16, 0, 0);
        } else { const char* ub = (const char*)(xb + (size_t)(u.pm * BM + 32 * wid) * 1024 + u.pn * BM);
            asm volatile("" : "+s"(ub)); unsigned lo = (unsigned)(lane >> 5) * 2048u + (unsigned)(lane & 31) * 16u; asm volatile("" : "+v"(lo));
#pragma unroll
            for (int j = 0; j < 16; ++j) __builtin_amdgcn_global_load_lds((const unsigned*)(ub + (size_t)j * 4096 + lo), dst, 16, 0, 0);
        }
    }
    const float* xf0; const float* xf1; int split_pm;
    bf16_t* xb; float* ssq; float scale;
    __device__ __forceinline__ void finish(const f32x4 (&a0)[2], const f32x4 (&a1)[2], const f32x4 (&r)[2][2], size_t off, int row, int fq) const {
        float s = 0.f;
#pragma unroll
        for (int bj = 0; bj < 2; ++bj) {
            const f32x4 v0 = r[bj][0] + (bj ? a1[0] : a0[0]) * scale, v1 = r[bj][1] + (bj ? a1[1] : a0[1]) * scale;
            s += ((v0[0] * v0[0] + v0[1] * v0[1]) + (v0[2] * v0[2] + v0[3] * v0[3])) + ((v1[0] * v1[0] + v1[1] * v1[1]) + (v1[2] * v1[2] + v1[3] * v1[3]));
            u32x4 w; w.x = cvt_pk_bf16(v0[0], v0[1]); w.y = cvt_pk_bf16(v0[2], v0[3]); w.z = cvt_pk_bf16(v1[0], v1[1]); w.w = cvt_pk_bf16(v1[2], v1[3]);
            *(u32x4*)(xb + off + bj * HALF) = w;
        }
        s += __shfl_xor(s, 16); s += __shfl_xor(s, 32);
        if (fq == 0) __hip_atomic_fetch_add(ssq + row, s, __ATOMIC_RELAXED, __HIP_MEMORY_SCOPE_AGENT);
    }
    __device__ __forceinline__ void operator()(const f32x4 (&acc)[2][2][4][2], const Unit& u, int wr, int wc, int fr, int fq) const {
        const int row0 = u.pm * BM + wr * 64 + fr, col0 = u.pn * BM + wc * 32 + 8 * fq;
        if (xf0) {
            const float* xin = (u.pm < split_pm) ? xf0 : (xf1 - (size_t)split_pm * BM * 1024);
#pragma unroll
            for (int h = 0; h < 4; ++h) {
                const int ai = h >> 1, m0 = (h & 1) * 2; f32x4 r[2][2][2];
#pragma unroll
                for (int mm = 0; mm < 2; ++mm)
#pragma unroll
                    for (int bj = 0; bj < 2; ++bj) { const float* p = xin + (size_t)(row0 + ai * HALF + (m0 + mm) * 16) * 1024 + col0 + bj * HALF; r[mm][bj][0] = *(const f32x4*)p; r[mm][bj][1] = *(const f32x4*)(p + 4); }
                __builtin_amdgcn_sched_barrier(0);
#pragma unroll
                for (int mm = 0; mm < 2; ++mm) { const int row = row0 + ai * HALF + (m0 + mm) * 16; finish(acc[ai][0][m0 + mm], acc[ai][1][m0 + mm], r[mm], (size_t)row * 1024 + col0, row, fq); }
            }
        } else {
            u32x4 rb[2][4][2];
#pragma unroll
            for (int ai = 0; ai < 2; ++ai)
#pragma unroll
                for (int m = 0; m < 4; ++m)
#pragma unroll
                    for (int bj = 0; bj < 2; ++bj) rb[ai][m][bj] = *(const u32x4*)(xb + (size_t)(row0 + ai * HALF + m * 16) * 1024 + col0 + bj * HALF);
            __builtin_amdgcn_sched_barrier(0);
#pragma unroll
            for (int ai = 0; ai < 2; ++ai)
#pragma unroll
                for (int m = 0; m < 4; ++m) { const int row = row0 + ai * HALF + m * 16; f32x4 r[2][2];
#pragma unroll
                    for (int bj = 0; bj < 2; ++bj) { const u32x4 q = rb[ai][m][bj];
                        r[bj][0] = (f32x4){__builtin_bit_cast(float, q.x << 16), __builtin_bit_cast(float, q.x & 0xffff0000u), __builtin_bit_cast(float, q.y << 16), __builtin_bit_cast(float, q.y & 0xffff0000u)};
                        r[bj][1] = (f32x4){__builtin_bit_cast(float, q.z << 16), __builtin_bit_cast(float, q.z & 0xffff0000u), __builtin_bit_cast(float, q.w << 16), __builtin_bit_cast(float, q.w & 0xffff0000u)}; }
                    finish(acc[ai][0][m], acc[ai][1][m], r, (size_t)row * 1024 + col0, row, fq); }
        }
    }
};

struct EpiWin {
    static constexpr bool PERM = true, AFTER_DRAIN = false, HAS_PF = false;
    bf16_t* P; float* GA; const float* ssq; const float* gbias;
    __device__ __forceinline__ void operator()(const f32x4 (&acc)[2][2][4][2], const Unit& u, int wr, int wc, int fr, int fq) const {
        const int row0 = u.pm * BM + wr * 64 + fr, c0 = wc * 32 + 8 * fq, pn = u.pn;
#pragma unroll
        for (int ai = 0; ai < 2; ++ai)
#pragma unroll
            for (int m = 0; m < 4; ++m) {
                const int row = row0 + ai * HALF + m * 16; const float rs = rstd_of(ssq, row);
#pragma unroll
                for (int bj = 0; bj < 2; ++bj) {
                    float v[8];
#pragma unroll
                    for (int n = 0; n < 2; ++n)
#pragma unroll
                        for (int i = 0; i < 4; ++i) v[4 * n + i] = acc[ai][bj][m][n][i] * rs;
                    const int tc = bj * HALF + c0;
                    if (pn == 14) {
                        f32x4 o0, o1;
#pragma unroll
                        for (int i = 0; i < 8; ++i) { const float x = v[i] + gbias[tc + i]; const float ls = fminf(x, 0.f) - __logf(1.0f + __expf(-fabsf(x))); const float av = __expf(ls * 0.0625f); if (i < 4) o0[i] = av; else o1[i - 4] = av; }
                        *(f32x4*)(GA + (size_t)row * 256 + tc) = o0; *(f32x4*)(GA + (size_t)row * 256 + tc + 4) = o1;
                    } else {
                        if (pn == 0) {
#pragma unroll
                            for (int i = 0; i < 8; ++i) v[i] *= 0.125f;
                        } else if (pn == 6 || pn == 7) {
#pragma unroll
                            for (int i = 0; i < 8; ++i) v[i] = silu_f(v[i]);
                        }
                        u32x4 w; w.x = cvt_pk_bf16(v[0], v[1]); w.y = cvt_pk_bf16(v[2], v[3]); w.z = cvt_pk_bf16(v[4], v[5]); w.w = cvt_pk_bf16(v[6], v[7]);
                        *(u32x4*)(P + ((size_t)(row >> 6) * 14 + pn) * 16384 + (row & 63) * 256 + tc) = w;
                    }
                }
            }
    }
};
template <class Epi, class Sched, bool ALIGN_EPI = false, bool SP2 = false>
__device__ __forceinline__ void gemm_phase(PG8_LAS unsigned char* lds, const Gemm g, const Sched& S, const Epi& E) {
    int tid_ = threadIdx.x; asm volatile("" : "+v"(tid_));
    const int tid = tid_, wid = __builtin_amdgcn_readfirstlane(tid >> 6), lane = tid & 63, wr = wid >> 2, wc = wid & 3, fr = lane & 15, fq = lane >> 4;
    const int K = g.K, nt = K / BK;
    const int ldaA = g.a_tiled ? BK : K;
    unsigned voffA[2], voffB[2];
#pragma unroll
    for (int i = 0; i < 2; ++i) { int R, C; stage_rc(tid * 16 + i * 8192, R, C); const int Rb = Epi::PERM ? ((R & ~31) + perm32(R & 31)) : R;
        voffA[i] = (unsigned)(R * ldaA + C) * 2u; voffB[i] = (unsigned)(Rb * K + C) * 2u; }
    const size_t kstep = (size_t)(BK * 2);
    const size_t hstep = (size_t)HALF * K * 2;
    const size_t tstep = 2 * hstep;
    const size_t kstepA = g.a_tiled ? (size_t)BM * BK * 2 : kstep, hstepA = g.a_tiled ? (size_t)HALF * BK * 2 : hstep;
    const unsigned ldsw = (unsigned)wid * 1024u;
    const int aoff = lds_byte(wr * 64 + fr, fq * 8), boff = lds_byte(wc * 32 + fr, fq * 8);
#define PG8_SA(b, h) (((b) * 2 + (h)) * HTB)
#define PG8_SB(b, h) ((4 + (b) * 2 + (h)) * HTB)
#define PG8_STAGE(bufoff, gbase, voff) do { _Pragma("unroll") for (int _i = 0; _i < 2; ++_i) \
        __builtin_amdgcn_global_load_lds((const unsigned*)((const char*)(gbase) + (voff)[_i]), (PG8_LAS unsigned*)(lds + (bufoff) + ldsw + _i * 8192), 16, 0, 0); } while (0)
#define PG8_LDA(dst, b, h) do { _Pragma("unroll") for (int m = 0; m < 4; ++m) _Pragma("unroll") for (int k = 0; k < 2; ++k) dst[m][k] = *(const PG8_LAS bf16x8*)(lds + PG8_SA(b, h) + aoff + m * 2048 + k * 1024); } while (0)
#define PG8_LDB(dst, b, h) do { _Pragma("unroll") for (int n = 0; n < 2; ++n) _Pragma("unroll") for (int k = 0; k < 2; ++k) dst[n][k] = *(const PG8_LAS bf16x8*)(lds + PG8_SB(b, h) + boff + n * 2048 + k * 1024); } while (0)
#define PG8_MMA(ai, bj, At, Bt) do { __builtin_amdgcn_s_setprio(1); _Pragma("unroll") for (int m = 0; m < 4; ++m) _Pragma("unroll") for (int n = 0; n < 2; ++n) _Pragma("unroll") for (int k = 0; k < 2; ++k) \
        acc[ai][bj][m][n] = __builtin_amdgcn_mfma_f32_16x16x32_bf16(Bt[n][k], At[m][k], acc[ai][bj][m][n], 0, 0, 0); __builtin_amdgcn_s_setprio(0); } while (0)
#define PG8_WAIT_V(n) asm volatile("s_waitcnt vmcnt(" #n ")" ::: "memory")
#define PG8_WAIT_L(n) asm volatile("s_waitcnt lgkmcnt(" #n ")" ::: "memory")
#define PG8_BAR __builtin_amdgcn_s_barrier()
#define PG8_SCHED __builtin_amdgcn_sched_barrier(0)
    Unit cur, nxt; int ui = 0;
    if (!S.next(0, cur)) return;
    f32x4 acc[2][2][4][2];
#pragma unroll
    for (int a = 0; a < 2; ++a)
#pragma unroll
        for (int b = 0; b < 2; ++b)
#pragma unroll
            for (int m = 0; m < 4; ++m)
#pragma unroll
                for (int n = 0; n < 2; ++n) acc[a][b][m][n] = (f32x4){0.f, 0.f, 0.f, 0.f};
    bf16x8 At[4][2], B0[2][2], B1[2][2];
    const char* cA = (const char*)g.A + (size_t)cur.pm * tstep; const char* cB = (const char*)g.Bt + (size_t)cur.pn * tstep;
    S.a_ready(cur);
    if constexpr (SP2) {
        PG8_STAGE(PG8_SB(0, 0), cB, voffB); PG8_STAGE(PG8_SB(0, 1), cB + hstep, voffB); PG8_STAGE(PG8_SA(0, 0), cA, voffA); PG8_STAGE(PG8_SA(0, 1), cA + hstepA, voffA);
        if (wr == 1) PG8_BAR;
        PG8_WAIT_V(2); PG8_BAR;
        PG8_STAGE(PG8_SB(1, 0), cB + kstep, voffB); PG8_STAGE(PG8_SA(1, 0), cA + kstepA, voffA); PG8_STAGE(PG8_SB(1, 1), cB + hstep + kstep, voffB);
        PG8_WAIT_V(6); PG8_BAR;
    } else {
        PG8_STAGE(PG8_SB(0, 0), cB, voffB); PG8_STAGE(PG8_SA(0, 0), cA, voffA); PG8_STAGE(PG8_SB(0, 1), cB + hstep, voffB); PG8_STAGE(PG8_SA(0, 1), cA + hstepA, voffA);
        if (wr == 1) PG8_BAR;
        PG8_WAIT_V(4); PG8_BAR;
        PG8_STAGE(PG8_SB(1, 0), cB + kstep, voffB); PG8_STAGE(PG8_SA(1, 0), cA + kstepA, voffA); PG8_STAGE(PG8_SB(1, 1), cB + hstep + kstep, voffB);
        PG8_WAIT_V(6); PG8_BAR;
    }
    for (;;) {
        const bool has_next = S.next(ui + 1, nxt);
        const char* nA = has_next ? (const char*)g.A + (size_t)nxt.pm * tstep : cA; const char* nB = has_next ? (const char*)g.Bt + (size_t)nxt.pn * tstep : cB;
        for (int t = 0; t < nt; t += 2) {
            if constexpr (Epi::HAS_PF) { if (t == nt - 12) E.prefetch(cur, lds + STAGE_BYTES, wid, lane); }
            const bool last = (t == nt - 2);
            const char* a1 = cA + (size_t)(t + 1) * kstepA;
            const char* a2 = last ? nA : cA + (size_t)(t + 2) * kstepA; const char* b2 = last ? nB : cB + (size_t)(t + 2) * kstep;
            const char* a3 = a2 + kstepA; const char* b3 = b2 + kstep;
            if (last && has_next) S.a_ready(nxt);
            if constexpr (SP2) {
            PG8_LDB(B0, 0, 0); PG8_LDB(B1, 0, 1); PG8_SCHED; PG8_LDA(At, 0, 0); PG8_STAGE(PG8_SA(1, 1), a1 + hstepA, voffA);
            PG8_WAIT_V(8); PG8_WAIT_L(0); PG8_BAR; PG8_MMA(0, 0, At, B0); PG8_MMA(0, 1, At, B1); PG8_BAR; PG8_SCHED;
            PG8_LDA(At, 0, 1); PG8_STAGE(PG8_SB(0, 0), b2, voffB); PG8_STAGE(PG8_SB(0, 1), b2 + hstep, voffB); PG8_STAGE(PG8_SA(0, 0), a2, voffA);
            PG8_WAIT_V(8); PG8_WAIT_L(0); PG8_BAR; PG8_MMA(1, 0, At, B0); PG8_MMA(1, 1, At, B1); PG8_BAR; PG8_SCHED;
            PG8_LDB(B0, 1, 0); PG8_LDB(B1, 1, 1); PG8_SCHED; PG8_LDA(At, 1, 0); PG8_STAGE(PG8_SA(0, 1), a2 + hstepA, voffA);
            PG8_WAIT_V(8); PG8_WAIT_L(0); PG8_BAR; PG8_MMA(0, 0, At, B0); PG8_MMA(0, 1, At, B1); PG8_BAR; PG8_SCHED;
            PG8_LDA(At, 1, 1); PG8_STAGE(PG8_SB(1, 0), b3, voffB); PG8_STAGE(PG8_SB(1, 1), b3 + hstep, voffB); PG8_STAGE(PG8_SA(1, 0), a3, voffA);
            PG8_WAIT_V(8); PG8_WAIT_L(0); PG8_BAR; PG8_MMA(1, 0, At, B0); PG8_MMA(1, 1, At, B1); PG8_BAR; PG8_SCHED;
            } else {
            PG8_LDB(B0, 0, 0); PG8_SCHED; PG8_LDA(At, 0, 0); PG8_STAGE(PG8_SA(1, 1), a1 + hstepA, voffA);
            PG8_WAIT_L(8); PG8_BAR; PG8_WAIT_L(0); PG8_MMA(0, 0, At, B0); PG8_BAR; PG8_SCHED;
            PG8_LDB(B1, 0, 1); PG8_STAGE(PG8_SB(0, 0), b2, voffB);
            PG8_BAR; PG8_WAIT_L(0); PG8_MMA(0, 1, At, B1); PG8_BAR;
            PG8_LDA(At, 0, 1); PG8_STAGE(PG8_SA(0, 0), a2, voffA);
            PG8_BAR; PG8_WAIT_L(0); PG8_MMA(1, 0, At, B0); PG8_BAR; PG8_SCHED;
            PG8_STAGE(PG8_SB(0, 1), b2 + hstep, voffB);
            PG8_WAIT_V(6); PG8_BAR; PG8_MMA(1, 1, At, B1); PG8_BAR;
            PG8_LDB(B0, 1, 0); PG8_SCHED; PG8_LDA(At, 1, 0); PG8_STAGE(PG8_SA(0, 1), a2 + hstepA, voffA);
            PG8_WAIT_L(8); PG8_BAR; PG8_WAIT_L(0); PG8_MMA(0, 0, At, B0); PG8_BAR; PG8_SCHED;
            PG8_LDB(B1, 1, 1); PG8_STAGE(PG8_SB(1, 0), b3, voffB);
            PG8_BAR; PG8_WAIT_L(0); PG8_MMA(0, 1, At, B1); PG8_BAR;
            PG8_LDA(At, 1, 1); PG8_STAGE(PG8_SA(1, 0), a3, voffA);
            PG8_BAR; PG8_WAIT_L(0); PG8_MMA(1, 0, At, B0); PG8_BAR; PG8_SCHED;
            PG8_STAGE(PG8_SB(1, 1), b3 + hstep, voffB);
            PG8_WAIT_V(6); PG8_BAR; PG8_MMA(1, 1, At, B1); PG8_BAR;
            }
        }
        if constexpr (ALIGN_EPI) { if (wr == 0) PG8_BAR; }
        if constexpr (!Epi::AFTER_DRAIN) { E(acc, cur, wr, wc, fr, fq); S.done(cur); }
        if (!has_next) break;
#pragma unroll
        for (int a = 0; a < 2; ++a)
#pragma unroll
            for (int b = 0; b < 2; ++b)
#pragma unroll
                for (int m = 0; m < 4; ++m)
#pragma unroll
                    for (int n = 0; n < 2; ++n) acc[a][b][m][n] = (f32x4){0.f, 0.f, 0.f, 0.f};
        cur = nxt; cA = nA; cB = nB; ++ui;
        if constexpr (ALIGN_EPI) { if (wr == 1) PG8_BAR; }
    }
    PG8_WAIT_V(0);
    if constexpr (!ALIGN_EPI) { if (wr == 0) PG8_BAR; }
    PG8_BAR;
    if constexpr (Epi::AFTER_DRAIN) { E.fused(acc, cur, wr, wc, fr, fq, lds, wid, lane); S.done(cur); }
#undef PG8_SA
#undef PG8_SB
#undef PG8_STAGE
#undef PG8_LDA
#undef PG8_LDB
#undef PG8_MMA
#undef PG8_WAIT_V
#undef PG8_WAIT_L
#undef PG8_BAR
#undef PG8_SCHED
}
}
namespace rec {
#define RLAS __attribute__((address_space(3)))
typedef unsigned short bf16;
typedef short bf16x8 __attribute__((ext_vector_type(8)));
typedef short s16x4 __attribute__((ext_vector_type(4)));
typedef float f32x4 __attribute__((ext_vector_type(4)));
typedef float f32x2 __attribute__((ext_vector_type(2)));
typedef unsigned u32x2 __attribute__((ext_vector_type(2)));
typedef unsigned u32x4 __attribute__((ext_vector_type(4)));
constexpr int PWID = 3584, DM = 1024;
__device__ __forceinline__ const bf16* pat(const bf16* P, size_t row, int col) { return P + ((row >> 6) * 14 + (size_t)(col >> 8)) * 16384 + (row & 63) * 256 + (col & 255); }
constexpr float R_EPS = 1e-6f;

typedef __bf16 bf16x2_t __attribute__((ext_vector_type(2)));
__device__ __forceinline__ unsigned pkbf(float lo, float hi) { const f32x2 v = {lo, hi}; const bf16x2_t b = __builtin_convertvector(v, bf16x2_t); return __builtin_bit_cast(unsigned, b); }
__device__ __forceinline__ int otid() { int t = threadIdx.x; asm volatile("" : "+v"(t)); return t; }
__device__ __forceinline__ float bflo(unsigned u) { return __builtin_bit_cast(float, u << 16); }
__device__ __forceinline__ float bfhi(unsigned u) { return __builtin_bit_cast(float, u & 0xffff0000u); }

template <int DK> struct Lay {
    static constexpr int NP = DK / 2, NSEG = 512 / NP, TL = 64 / NSEG, SEGREF = 32 / TL - 1, NDT = DK / 16, NKS = DK / 32;
    static constexpr int PK = DK * 2 + 32, PV = 288, PP = 160, PO = 528;
    static constexpr int OFF_Q = 0, OFF_K = OFF_Q + 64 * PK, OFF_KH = OFF_K + 64 * PK, OFF_V = OFF_KH + 64 * PK, OFF_P = OFF_V + 64 * PV, OFF_O = OFF_P + 64 * PP,
                         OFF_SEG = OFF_O + 64 * PO, OFF_D = OFF_SEG + NSEG * DK * 4, OFF_E = OFF_D + DK * 4, OFF_END = OFF_E + DK * 4;
    static_assert(OFF_END <= 131072, "recurrence LDS map");
};

__device__ __forceinline__ bf16x8 tr_frag(RLAS unsigned char* img, int pitch, int k0, int n0, int lane) {
    const int g = lane >> 4, q = (lane & 15) >> 2, p = lane & 3;
    RLAS unsigned char* a = img + (k0 + 8 * g + q) * pitch + n0 * 2 + 8 * p;
    const s16x4 lo = __builtin_amdgcn_ds_read_tr16_b64_v4i16((RLAS s16x4*)a);
    const s16x4 hi = __builtin_amdgcn_ds_read_tr16_b64_v4i16((RLAS s16x4*)(a + 4 * pitch));
    return __builtin_shufflevector(lo, hi, 0, 1, 2, 3, 4, 5, 6, 7);
}

struct HeadIo {
    const bf16* P; const float* GA; bf16* MIX;
    int qoff, koff, voff, goff, ooff, gaoff;
    const float* onorm; float lb0, lb1;
};

#define REC_BAR() do { asm volatile("s_waitcnt lgkmcnt(0)" ::: "memory"); __builtin_amdgcn_s_barrier(); asm volatile("" ::: "memory"); } while (0)

template <int DK, bool HG, bool DO_OUT> struct Raw { unsigned q2[Lay<DK>::TL], k2[Lay<DK>::TL]; f32x2 av[Lay<DK>::TL]; u32x4 v0, v1, g0, g1; };

template <int DK, bool HG, bool DO_OUT>
__device__ __forceinline__ void load_raw(const HeadIo& io, size_t row0, int tvalid, Raw<DK, HG, DO_OUT>& w) {
    typedef Lay<DK> L;
    const int tid = otid(), dp = tid % L::NP, seg = tid / L::NP;
#pragma unroll
    for (int tt = 0; tt < L::TL; ++tt) {
        const int t = seg * L::TL + tt; const size_t row = row0 + t; const bool ok = t < tvalid;
        if (DO_OUT) w.q2[tt] = ok ? __builtin_nontemporal_load((const unsigned*)pat(io.P, row, io.qoff + 2 * dp)) : 0u;
        w.k2[tt] = ok ? __builtin_nontemporal_load((const unsigned*)pat(io.P, row, io.koff + 2 * dp)) : 0u;
        if (!HG) w.av[tt] = ok ? __builtin_nontemporal_load((const f32x2*)(io.GA + row * 256 + io.gaoff + 2 * dp)) : (f32x2){1.f, 1.f};
    }
    const int vr = tid >> 3, vc = (tid & 7) * 16; const bool vok = vr < tvalid;
    w.v0 = (u32x4){0u, 0u, 0u, 0u}; w.v1 = w.v0; w.g0 = w.v0; w.g1 = w.v0;
    if (vok) { const u32x4* src = (const u32x4*)pat(io.P, row0 + vr, io.voff + vc); w.v0 = __builtin_nontemporal_load(src); w.v1 = __builtin_nontemporal_load(src + 1);
        if (DO_OUT) { const u32x4* gp = (const u32x4*)pat(io.P, row0 + vr, io.goff + vc); w.g0 = __builtin_nontemporal_load(gp); w.g1 = __builtin_nontemporal_load(gp + 1); } }
}

template <int DK, bool HG, bool DO_OUT>
__device__ __forceinline__ void chunk(RLAS unsigned char* lds, const HeadIo& io, const Raw<DK, HG, DO_OUT>& w, size_t row0, int tvalid, f32x4 (&S)[DK / 16], float& dtot) {
    typedef Lay<DK> L;
    const int tid = otid(), lane = tid & 63, wave = tid >> 6, r = lane & 15, g = lane >> 4, e0 = 16 * wave;
    const int dp = tid % L::NP, seg = tid / L::NP;
    {
        const int vr = tid >> 3, vc = (tid & 7) * 16;
        RLAS u32x4* dst = (RLAS u32x4*)(lds + L::OFF_V + vr * L::PV + vc * 2); dst[0] = w.v0; dst[1] = w.v1;
    }
    f32x2 kk[L::TL], pr[L::TL];
    const f32x2 lbv = {io.lb0, io.lb1}, oml = {1.f - io.lb0, 1.f - io.lb1};
#pragma unroll
    for (int tt = 0; tt < L::TL; ++tt) {
        if (HG) {
            const bool ok = seg * L::TL + tt < tvalid;
            f32x2 z = {bflo(w.k2[tt]), bfhi(w.k2[tt])}; z = __builtin_elementwise_min(__builtin_elementwise_max(z, (f32x2){-30.f, -30.f}), (f32x2){30.f, 30.f});
            const f32x2 x = z * -1.4426950408889634f; f32x2 e, s; e.x = __builtin_amdgcn_exp2f(x.x); e.y = __builtin_amdgcn_exp2f(x.y);
            const f32x2 den = e + 1.0f; s.x = __builtin_amdgcn_rcpf(den.x); s.y = __builtin_amdgcn_rcpf(den.y);
            kk[tt] = ok ? oml * (e * s) : (f32x2){0.f, 0.f};
            pr[tt] = ok ? lbv + oml * s : (f32x2){1.f, 1.f};
        } else { kk[tt] = (f32x2){bflo(w.k2[tt]), bfhi(w.k2[tt])}; pr[tt] = w.av[tt]; }
    }
#pragma unroll
    for (int tt = 1; tt < L::TL; ++tt) pr[tt] *= pr[tt - 1];
    *(RLAS f32x2*)(lds + L::OFF_SEG + (seg * DK + 2 * dp) * 4) = pr[L::TL - 1];
    REC_BAR();
    f32x2 off = {1.f, 1.f}, aref = {1.f, 1.f}, alast = {1.f, 1.f};
#pragma unroll
    for (int s = 0; s < L::NSEG; ++s) { const f32x2 v = *(RLAS f32x2*)(lds + L::OFF_SEG + (s * DK + 2 * dp) * 4); if (s < seg) off *= v; if (s <= L::SEGREF) aref *= v; alast *= v; }
    f32x2 ir; ir.x = __builtin_amdgcn_rcpf(aref.x); ir.y = __builtin_amdgcn_rcpf(aref.y);
#pragma unroll
    for (int tt = 0; tt < L::TL; ++tt) {
        const int t = seg * L::TL + tt; const f32x2 at = off * pr[tt];
        f32x2 inv; inv.x = __builtin_amdgcn_rcpf(at.x); inv.y = __builtin_amdgcn_rcpf(at.y);
        if (DO_OUT) {
            const f32x2 qv = (f32x2){bflo(w.q2[tt]), bfhi(w.q2[tt])} * (at * ir), kv = kk[tt] * (inv * aref);
            *(RLAS unsigned*)(lds + L::OFF_Q + t * L::PK + 4 * dp) = pkbf(qv.x, qv.y);
            *(RLAS unsigned*)(lds + L::OFF_K + t * L::PK + 4 * dp) = pkbf(kv.x, kv.y);
        }
        const f32x2 kh = kk[tt] * (inv * alast);
        *(RLAS unsigned*)(lds + L::OFF_KH + t * L::PK + 4 * dp) = pkbf(kh.x, kh.y);
    }
    if (seg == 0) { *(RLAS f32x2*)(lds + L::OFF_D + 8 * dp) = alast; *(RLAS f32x2*)(lds + L::OFF_E + 8 * dp) = aref; }
    REC_BAR();
    if (tid < DK) dtot *= *(RLAS float*)(lds + L::OFF_D + 4 * tid);
    f32x4 O[4];
    if (DO_OUT) {
        const int it = wave >> 1, jt0 = 2 * (wave & 1);
        {
            bf16x8 qf[L::NKS], kf[2][L::NKS];
#pragma unroll
            for (int s = 0; s < L::NKS; ++s) {
                qf[s] = *(RLAS bf16x8*)(lds + L::OFF_Q + (16 * it + r) * L::PK + (32 * s + 8 * g) * 2);
#pragma unroll
                for (int jj = 0; jj < 2; ++jj) kf[jj][s] = *(RLAS bf16x8*)(lds + L::OFF_K + (16 * (jt0 + jj) + r) * L::PK + (32 * s + 8 * g) * 2);
            }
            __builtin_amdgcn_sched_barrier(0);
            f32x4 acc[2] = {{0.f, 0.f, 0.f, 0.f}, {0.f, 0.f, 0.f, 0.f}};
#pragma unroll
            for (int s = 0; s < L::NKS; ++s)
#pragma unroll
                for (int jj = 0; jj < 2; ++jj) acc[jj] = __builtin_amdgcn_mfma_f32_16x16x32_bf16(kf[jj][s], qf[s], acc[jj], 0, 0, 0);
#pragma unroll
            for (int jj = 0; jj < 2; ++jj) {
                const int i = 16 * it + r, j = 16 * (jt0 + jj) + 4 * g;
                u32x2 pw; pw.x = pkbf(j <= i ? acc[jj][0] : 0.f, j + 1 <= i ? acc[jj][1] : 0.f); pw.y = pkbf(j + 2 <= i ? acc[jj][2] : 0.f, j + 3 <= i ? acc[jj][3] : 0.f);
                *(RLAS u32x2*)(lds + L::OFF_P + i * L::PP + j * 2) = pw;
            }
        }
        {
            s16x4 qlo[L::NKS][4], qhi[L::NKS][4]; f32x4 ea[L::NKS], eb[L::NKS];
#pragma unroll
            for (int s = 0; s < L::NKS; ++s) {
                ea[s] = *(RLAS f32x4*)(lds + L::OFF_E + (32 * s + 4 * g) * 4); eb[s] = *(RLAS f32x4*)(lds + L::OFF_E + (32 * s + 16 + 4 * g) * 4);
#pragma unroll
                for (int m = 0; m < 4; ++m) { qlo[s][m] = *(RLAS s16x4*)(lds + L::OFF_Q + (16 * m + r) * L::PK + (32 * s + 4 * g) * 2); qhi[s][m] = *(RLAS s16x4*)(lds + L::OFF_Q + (16 * m + r) * L::PK + (32 * s + 16 + 4 * g) * 2); }
            }
            __builtin_amdgcn_sched_barrier(0);
#pragma unroll
            for (int m = 0; m < 4; ++m) O[m] = (f32x4){0.f, 0.f, 0.f, 0.f};
#pragma unroll
            for (int s = 0; s < L::NKS; ++s) {
                const f32x4 sa = S[2 * s] * ea[s], sb = S[2 * s + 1] * eb[s];
                u32x4 sp; sp.x = pkbf(sa[0], sa[1]); sp.y = pkbf(sa[2], sa[3]); sp.z = pkbf(sb[0], sb[1]); sp.w = pkbf(sb[2], sb[3]);
                const bf16x8 sf = __builtin_bit_cast(bf16x8, sp);
#pragma unroll
                for (int m = 0; m < 4; ++m) O[m] = __builtin_amdgcn_mfma_f32_16x16x32_bf16(__builtin_shufflevector(qlo[s][m], qhi[s][m], 0, 1, 2, 3, 4, 5, 6, 7), sf, O[m], 0, 0, 0);
            }
        }
        REC_BAR();
    }
    const bf16x8 vf0 = tr_frag(lds + L::OFF_V, L::PV, 0, e0, lane), vf1 = tr_frag(lds + L::OFF_V, L::PV, 32, e0, lane);
    if (DO_OUT) {
        bf16x8 p0[4], p1[4];
#pragma unroll
        for (int m = 0; m < 4; ++m) { p0[m] = *(RLAS bf16x8*)(lds + L::OFF_P + (16 * m + r) * L::PP + (8 * g) * 2); p1[m] = *(RLAS bf16x8*)(lds + L::OFF_P + (16 * m + r) * L::PP + (32 + 8 * g) * 2); }
        __builtin_amdgcn_sched_barrier(0);
#pragma unroll
        for (int m = 0; m < 4; ++m) O[m] = __builtin_amdgcn_mfma_f32_16x16x32_bf16(p0[m], vf0, O[m], 0, 0, 0);
#pragma unroll
        for (int m = 0; m < 4; ++m) O[m] = __builtin_amdgcn_mfma_f32_16x16x32_bf16(p1[m], vf1, O[m], 0, 0, 0);
    }
#pragma unroll
    for (int d0 = 0; d0 < L::NDT; d0 += 4) {
        bf16x8 k0[4], k1[4]; f32x4 dv[4];
#pragma unroll
        for (int q = 0; q < 4; ++q) { dv[q] = *(RLAS f32x4*)(lds + L::OFF_D + (16 * (d0 + q) + 4 * g) * 4);
            k0[q] = tr_frag(lds + L::OFF_KH, L::PK, 0, 16 * (d0 + q), lane); k1[q] = tr_frag(lds + L::OFF_KH, L::PK, 32, 16 * (d0 + q), lane); }
        __builtin_amdgcn_sched_barrier(0);
#pragma unroll
        for (int q = 0; q < 4; ++q) S[d0 + q] = __builtin_amdgcn_mfma_f32_16x16x32_bf16(k0[q], vf0, S[d0 + q] * dv[q], 0, 0, 0);
#pragma unroll
        for (int q = 0; q < 4; ++q) S[d0 + q] = __builtin_amdgcn_mfma_f32_16x16x32_bf16(k1[q], vf1, S[d0 + q], 0, 0, 0);
    }
    if (DO_OUT) {
#pragma unroll
        for (int m = 0; m < 4; ++m)
#pragma unroll
            for (int ii = 0; ii < 4; ++ii) *(RLAS float*)(lds + L::OFF_O + (16 * m + 4 * g + ii) * L::PO + (e0 + r) * 4) = O[m][ii];
        REC_BAR();
        const int orow = tid >> 3, oc = (tid & 7) * 16;
        f32x4 ov[4]; float ss = 0.f;
#pragma unroll
        for (int c = 0; c < 4; ++c) { ov[c] = *(RLAS f32x4*)(lds + L::OFF_O + orow * L::PO + (oc + 4 * c) * 4); ss += (ov[c][0] * ov[c][0] + ov[c][1] * ov[c][1]) + (ov[c][2] * ov[c][2] + ov[c][3] * ov[c][3]); }
        ss += __shfl_xor(ss, 1); ss += __shfl_xor(ss, 2); ss += __shfl_xor(ss, 4);
        const float rs = rsqrtf(ss * (1.0f / 128.0f) + R_EPS);
        if (orow < tvalid) {
            const size_t row = row0 + orow;
            const unsigned gw[8] = {w.g0.x, w.g0.y, w.g0.z, w.g0.w, w.g1.x, w.g1.y, w.g1.z, w.g1.w};
            unsigned ow[8];
#pragma unroll
            for (int c = 0; c < 8; ++c) {
                const f32x2 gg = {bflo(gw[c]), bfhi(gw[c])}, x = gg * -1.4426950408889634f; f32x2 e, sg_; e.x = __builtin_amdgcn_exp2f(x.x); e.y = __builtin_amdgcn_exp2f(x.y);
                const f32x2 den = e + 1.0f; sg_.x = __builtin_amdgcn_rcpf(den.x); sg_.y = __builtin_amdgcn_rcpf(den.y);
                const f32x2 ovv = {ov[c >> 1][(c & 1) * 2], ov[c >> 1][(c & 1) * 2 + 1]}, on = *(const f32x2*)(io.onorm + oc + 2 * c);
                const f32x2 o = (ovv * rs) * on * (gg * sg_);
                ow[c] = pkbf(o.x, o.y);
            }
            u32x4* op = (u32x4*)(io.MIX + row * DM + io.ooff + oc);
            op[0] = (u32x4){ow[0], ow[1], ow[2], ow[3]}; op[1] = (u32x4){ow[4], ow[5], ow[6], ow[7]};
        }
    } else {
        REC_BAR();
    }
}

template <int NDT> __device__ __forceinline__ void load_state(f32x4 (&S)[NDT], const float* mem) {
    const int tid_ = otid(), lane = tid_ & 63, wave = tid_ >> 6, r = lane & 15, g = lane >> 4;
#pragma unroll
    for (int dt = 0; dt < NDT; ++dt)
#pragma unroll
        for (int i = 0; i < 4; ++i) S[dt][i] = mem ? mem[(16 * dt + 4 * g + i) * 128 + 16 * wave + r] : 0.f;
}
template <int NDT> __device__ __forceinline__ void store_state(const f32x4 (&S)[NDT], float* mem) {
    const int tid_ = otid(), lane = tid_ & 63, wave = tid_ >> 6, r = lane & 15, g = lane >> 4;
#pragma unroll
    for (int dt = 0; dt < NDT; ++dt)
#pragma unroll
        for (int i = 0; i < 4; ++i) mem[(16 * dt + 4 * g + i) * 128 + 16 * wave + r] = S[dt][i];
}

struct RecArgs {
    const bf16* P; const float* GA; bf16* MIX; const float* lbl; const float* gla_onorm; const float* hg_onorm;
    const float* st_gla_in; const float* st_hg_in; float* ST; float* DT; float* out_sgp; float* out_shp; float* out_sgs; float* out_shs;
};
constexpr int SC_TOK = 512, NCH = SC_TOK / 64, NSC = 8192 / SC_TOK, ST_PER = 4 * 64 * 128 + 4 * 128 * 128, DT_PER = 4 * 64 + 4 * 128;

template <int DK, bool HG> __device__ __forceinline__ HeadIo make_io(const RecArgs& a, int h) {
    HeadIo io; io.P = a.P; io.GA = a.GA; io.MIX = a.MIX;
    if (HG) { io.qoff = 1536 + h * 128; io.koff = 2048 + h * 128; io.voff = 2560 + h * 128; io.goff = 3072 + h * 128; io.ooff = 512 + h * 128; io.gaoff = 0; io.onorm = a.hg_onorm;
        const int d = 2 * (otid() % (DK / 2)); const float l0 = a.lbl[h * 128 + d], l1 = a.lbl[512 + h * 128 + d], m0 = a.lbl[h * 128 + d + 1], m1 = a.lbl[512 + h * 128 + d + 1];
        io.lb0 = 1.0f / (1.0f + __expf(l1 - l0)); io.lb1 = 1.0f / (1.0f + __expf(m1 - m0)); }
    else { io.qoff = h * 64; io.koff = 256 + h * 64; io.voff = 512 + h * 128; io.goff = 1024 + h * 128; io.ooff = h * 128; io.gaoff = h * 64; io.onorm = a.gla_onorm; io.lb0 = 0.f; io.lb1 = 0.f; }
    return io;
}

template <int DK, bool HG> __device__ __forceinline__ void r1_unit(RLAS unsigned char* lds, const RecArgs& a, int seq, int sc, int h) {
    const HeadIo io = make_io<DK, HG>(a, h);
    f32x4 S[DK / 16]; load_state<DK / 16>(S, nullptr); float dtot = 1.f;
    const size_t rb = (size_t)seq * 8192 + sc * SC_TOK;
    Raw<DK, HG, false> cur, nxt; load_raw<DK, HG, false>(io, rb, 64, cur);
#pragma unroll 1
    for (int c = 0; c < NCH; ++c) { if (c + 1 < NCH) load_raw<DK, HG, false>(io, rb + (c + 1) * 64, 64, nxt); chunk<DK, HG, false>(lds, io, cur, rb + c * 64, 64, S, dtot); cur = nxt; }
    const size_t u = (size_t)seq * NSC + sc;
    store_state<DK / 16>(S, a.ST + u * ST_PER + (HG ? 32768 + h * 16384 : h * 8192));
    { const int t_ = otid(); if (t_ < DK) a.DT[u * DT_PER + (HG ? 256 + h * 128 : h * 64) + t_] = dtot; }
}
template <int DK, bool HG> __device__ __forceinline__ void r3_unit(RLAS unsigned char* lds, const RecArgs& a, int seq, int sc, int h) {
    const HeadIo io = make_io<DK, HG>(a, h);
    const size_t u = (size_t)seq * NSC + sc;
    f32x4 S[DK / 16]; load_state<DK / 16>(S, a.ST + u * ST_PER + (HG ? 32768 + h * 16384 : h * 8192)); float dtot = 1.f;
    const size_t rb = (size_t)seq * 8192 + sc * SC_TOK;
    Raw<DK, HG, true> cur, nxt; load_raw<DK, HG, true>(io, rb, 64, cur);
#pragma unroll 1
    for (int c = 0; c < NCH; ++c) { if (c + 1 < NCH) load_raw<DK, HG, true>(io, rb + (c + 1) * 64, 64, nxt); chunk<DK, HG, true>(lds, io, cur, rb + c * 64, 64, S, dtot); cur = nxt; }
    if (sc == NSC - 1) store_state<DK / 16>(S, (HG ? a.out_shp : a.out_sgp) + (size_t)(seq * 4 + h) * DK * 128);
}
template <int DK, bool HG> __device__ __forceinline__ void rs_unit(RLAS unsigned char* lds, const RecArgs& a, int seq, int h) {
    const HeadIo io = make_io<DK, HG>(a, h);
    f32x4 S[DK / 16]; load_state<DK / 16>(S, (HG ? a.st_hg_in : a.st_gla_in) + (size_t)(seq * 4 + h) * DK * 128); float dtot = 1.f;
    Raw<DK, HG, true> cur; load_raw<DK, HG, true>(io, (size_t)32768 + seq * 32, 32, cur);
    chunk<DK, HG, true>(lds, io, cur, (size_t)32768 + seq * 32, 32, S, dtot);
    store_state<DK / 16>(S, (HG ? a.out_shs : a.out_sgs) + (size_t)(seq * 4 + h) * DK * 128);
}
__device__ __forceinline__ void decode_unit(int u, int& scidx, int& head) { scidx = u >> 3; head = ((u & 7) + 4 * ((u >> 8) & 1)) & 7; }

__device__ __forceinline__ void sample_units(RLAS unsigned char* lds, const RecArgs& a, int first, int step) {
    for (int u = first; u < 64; u += step) { const int seq = u >> 3, head = u & 7;
        if (head < 4) rs_unit<64, false>(lds, a, seq, head); else rs_unit<128, true>(lds, a, seq, head - 4); }
}
__device__ __forceinline__ void phase_r1(RLAS unsigned char* lds, const RecArgs& a, int G, int bx) {
    for (int u = bx; u < 4 * NSC * 8; u += G) { int scidx, head; decode_unit(u, scidx, head); const int seq = scidx / NSC, sc = scidx % NSC;
        if (sc == NSC - 1) continue;
        if (head < 4) r1_unit<64, false>(lds, a, seq, sc, head); else r1_unit<128, true>(lds, a, seq, sc, head - 4); }
    if (G == 256 && NSC == 16 && (bx & 127) >= 120) sample_units(lds, a, ((bx >> 7) << 3) + (bx & 7), 16);
}
__device__ __forceinline__ void phase_r2(const RecArgs& a, int gtid, int NGT) {
    for (int idx = gtid; idx < ST_PER; idx += NGT) {
        const int seq = idx / (ST_PER / 4), off = (idx % (ST_PER / 4)) * 4; int dti;
        if (off < 32768) dti = (off / 8192) * 64 + (off % 8192) / 128; else { const int o2 = off - 32768; dti = 256 + (o2 / 16384) * 128 + (o2 % 16384) / 128; }
        float* st = a.ST + (size_t)seq * NSC * ST_PER + off; const float* dt = a.DT + (size_t)seq * NSC * DT_PER + dti;
        f32x4 t[NSC - 1]; float dd[NSC - 1];
#pragma unroll
        for (int s = 0; s < NSC - 1; ++s) { t[s] = *(const f32x4*)(st + (size_t)s * ST_PER); dd[s] = dt[(size_t)s * DT_PER]; }
        f32x4 x = {0.f, 0.f, 0.f, 0.f};
#pragma unroll
        for (int s = 0; s < NSC; ++s) { *(f32x4*)(st + (size_t)s * ST_PER) = x; if (s < NSC - 1) x = x * dd[s] + t[s]; }
    }
}
__device__ __forceinline__ void phase_r3(RLAS unsigned char* lds, const RecArgs& a, int G, int bx) {
    for (int u = bx; u < 4 * NSC * 8; u += G) { int scidx, head; decode_unit(u, scidx, head); const int seq = scidx / NSC, sc = scidx % NSC;
        if (head < 4) r3_unit<64, false>(lds, a, seq, sc, head); else r3_unit<128, true>(lds, a, seq, sc, head - 4); }
    if (!(G == 256 && NSC == 16)) sample_units(lds, a, bx, G);
}
}
namespace sg {
typedef unsigned short bf16;
typedef short bf16x8 __attribute__((ext_vector_type(8)));
typedef float f32x4 __attribute__((ext_vector_type(4)));
typedef unsigned u32x2 __attribute__((ext_vector_type(2)));
typedef unsigned u32x4 __attribute__((ext_vector_type(4)));
__device__ __forceinline__ int otid() { int t = threadIdx.x; asm volatile("" : "+v"(t)); return t; }
__device__ __forceinline__ unsigned pkbf(float lo, float hi) { return rec::pkbf(lo, hi); }
__device__ __forceinline__ float silu_f(float g) { return g * __builtin_amdgcn_rcpf(1.0f + __expf(-g)); }

constexpr int SPITCH = 272, WREG = 64 * SPITCH;
template <int NT, class Epi>
__device__ __forceinline__ void unit(__attribute__((address_space(3))) unsigned char* lds, const bf16* A, int K, const bf16* bt0, const bf16* bt1, const Epi& E) {
    typedef __attribute__((address_space(3))) unsigned char* lptr;
    const int tid = otid(), lane = tid & 63, wave = tid >> 6, r = lane & 15, g = lane >> 4;
    constexpr int NL = 8 + 4 * NT;
    const lptr img = lds + wave * WREG;
    const bf16* gp[NL];
#pragma unroll
    for (int j = 0; j < NL; ++j) { const int row = 4 * j + g;
        const bf16* base = (j < 8) ? A + (size_t)(32 * wave + row) * K : (j < 12 ? bt0 + (size_t)(row - 32) * K : bt1 + (size_t)(row - 48) * K);
        gp[j] = base + 8 * r; }
    const lptr wp = img + g * SPITCH + 16 * r;
    f32x4 acc[2][NT];
#pragma unroll
    for (int mt = 0; mt < 2; ++mt)
#pragma unroll
        for (int nt = 0; nt < NT; ++nt) acc[mt][nt] = (f32x4){0.f, 0.f, 0.f, 0.f};
    u32x4 st[NL];
    const int nb = K / 128;
#pragma unroll
    for (int j = 0; j < NL; ++j) st[j] = *(const u32x4*)(gp[j]);
#pragma unroll 1
    for (int b = 0; b < nb; ++b) {
#pragma unroll
        for (int j = 0; j < NL; ++j) *(__attribute__((address_space(3))) u32x4*)(wp + 4 * j * SPITCH) = st[j];
        if (b + 1 < nb) {
#pragma unroll
            for (int j = 0; j < NL; ++j) st[j] = *(const u32x4*)(gp[j] + (size_t)(b + 1) * 128);
        }
        asm volatile("s_waitcnt lgkmcnt(0)" ::: "memory");
#pragma unroll
        for (int u = 0; u < 4; ++u) {
            bf16x8 af[2], bfr[NT];
#pragma unroll
            for (int mt = 0; mt < 2; ++mt) af[mt] = *(const __attribute__((address_space(3))) bf16x8*)(img + (16 * mt + r) * SPITCH + (4 * u + g) * 16);
#pragma unroll
            for (int nt = 0; nt < NT; ++nt) bfr[nt] = *(const __attribute__((address_space(3))) bf16x8*)(img + (32 + 16 * nt + r) * SPITCH + (4 * u + g) * 16);
#pragma unroll
            for (int mt = 0; mt < 2; ++mt)
#pragma unroll
                for (int nt = 0; nt < NT; ++nt) acc[mt][nt] = __builtin_amdgcn_mfma_f32_16x16x32_bf16(bfr[nt], af[mt], acc[mt][nt], 0, 0, 0);
        }
        asm volatile("s_waitcnt lgkmcnt(0)" ::: "memory");
    }
    E(acc, wave, r, g);
}

constexpr int SPITCH2 = 528;
template <class Epi>
__device__ __forceinline__ void unit_k256(__attribute__((address_space(3))) unsigned char* lds, const bf16* A, int K, const bf16* bt, const Epi& E) {
    typedef __attribute__((address_space(3))) unsigned char* lptr;
    const int tid = otid(), lane = tid & 63, wave = tid >> 6, r = lane & 15, g = lane >> 4, hr = lane >> 5, ch = lane & 31;
    const lptr img = lds + wave * (32 * SPITCH2);
    const bf16* gp[16];
#pragma unroll
    for (int j = 0; j < 16; ++j) { const int row = 2 * j + hr; gp[j] = ((j < 8) ? A + (size_t)(16 * wave + row) * K : bt + (size_t)(row - 16) * K) + 8 * ch; }
    const lptr wp = img + hr * SPITCH2 + 16 * ch;
    f32x4 acc = {0.f, 0.f, 0.f, 0.f};
    u32x4 st[16];
    const int nb = K / 256;
#pragma unroll
    for (int j = 0; j < 16; ++j) st[j] = *(const u32x4*)(gp[j]);
#pragma unroll 1
    for (int b = 0; b < nb; ++b) {
#pragma unroll
        for (int j = 0; j < 16; ++j) *(__attribute__((address_space(3))) u32x4*)(wp + 2 * j * SPITCH2) = st[j];
        if (b + 1 < nb) {
#pragma unroll
            for (int j = 0; j < 16; ++j) st[j] = *(const u32x4*)(gp[j] + (size_t)(b + 1) * 256);
        }
        asm volatile("s_waitcnt lgkmcnt(0)" ::: "memory");
        bf16x8 af[8], bfr[8];
#pragma unroll
        for (int u = 0; u < 8; ++u) { af[u] = *(const __attribute__((address_space(3))) bf16x8*)(img + r * SPITCH2 + (4 * u + g) * 16);
            bfr[u] = *(const __attribute__((address_space(3))) bf16x8*)(img + (16 + r) * SPITCH2 + (4 * u + g) * 16); }
#pragma unroll
        for (int u = 0; u < 8; ++u) acc = __builtin_amdgcn_mfma_f32_16x16x32_bf16(bfr[u], af[u], acc, 0, 0, 0);
        asm volatile("s_waitcnt lgkmcnt(0)" ::: "memory");
    }
    E(acc, wave, r, g);
}
struct EpiResS1 {
    bf16* xb; float* ssq; float scale; int c0, rbase;
    __device__ __forceinline__ void operator()(const f32x4& acc, int wave, int r, int g) const {
        const int row = rbase + 16 * wave + r; const size_t off = (size_t)row * 1024 + c0 + 4 * g;
        const u32x2 rb = *(const u32x2*)(xb + off);
        const f32x4 res = {__builtin_bit_cast(float, rb.x << 16), __builtin_bit_cast(float, rb.x & 0xffff0000u), __builtin_bit_cast(float, rb.y << 16), __builtin_bit_cast(float, rb.y & 0xffff0000u)};
        const f32x4 v = res + acc * scale;
        float s = (v[0] * v[0] + v[1] * v[1]) + (v[2] * v[2] + v[3] * v[3]);
        s += __shfl_xor(s, 16); s += __shfl_xor(s, 32);
        if (g == 0) __hip_atomic_fetch_add(ssq + row, s, __ATOMIC_RELAXED, __HIP_MEMORY_SCOPE_AGENT);
        *(u32x2*)(xb + off) = (u32x2){pkbf(v[0], v[1]), pkbf(v[2], v[3])};
    }
};

struct EpiUpS {
    bf16* H; int ldh; const float* ssq; int hc0;
    __device__ __forceinline__ void operator()(const f32x4 (&acc)[2][2], int wave, int r, int g) const {
#pragma unroll
        for (int mt = 0; mt < 2; ++mt) { const int row = 32 * wave + 16 * mt + r; const float rs = rsqrtf(ssq[row] * (1.0f / 1024.0f) + 1e-6f);
            float h[4];
#pragma unroll
            for (int i = 0; i < 4; ++i) h[i] = silu_f(acc[mt][0][i] * rs) * (acc[mt][1][i] * rs);
            *(u32x2*)(H + (size_t)row * ldh + hc0 + 4 * g) = (u32x2){pkbf(h[0], h[1]), pkbf(h[2], h[3])}; }
    }
};
struct EpiResS {
    const float* xf; bf16* xb; float* ssq; float scale; int c0;
    __device__ __forceinline__ void operator()(const f32x4 (&acc)[2][1], int wave, int r, int g) const {
#pragma unroll
        for (int mt = 0; mt < 2; ++mt) { const int row = 32 * wave + 16 * mt + r; const size_t off = (size_t)row * 1024 + c0 + 4 * g; f32x4 res;
            if (xf) res = *(const f32x4*)(xf + off);
            else { const u32x2 rb = *(const u32x2*)(xb + off); res = (f32x4){__builtin_bit_cast(float, rb.x << 16), __builtin_bit_cast(float, rb.x & 0xffff0000u), __builtin_bit_cast(float, rb.y << 16), __builtin_bit_cast(float, rb.y & 0xffff0000u)}; }
            const f32x4 v = res + acc[mt][0] * scale;
            float s = (v[0] * v[0] + v[1] * v[1]) + (v[2] * v[2] + v[3] * v[3]);
            s += __shfl_xor(s, 16); s += __shfl_xor(s, 32);
            if (g == 0) __hip_atomic_fetch_add(ssq + row, s, __ATOMIC_RELAXED, __HIP_MEMORY_SCOPE_AGENT);
            *(u32x2*)(xb + off) = (u32x2){pkbf(v[0], v[1]), pkbf(v[2], v[3])}; }
    }
};
struct EpiWinS {
    bf16* P; float* GA; const float* ssq; const float* gbias; int c0;
    __device__ __forceinline__ void operator()(const f32x4 (&acc)[2][2], int wave, int r, int g) const {
        const int pn = c0 >> 8;
#pragma unroll
        for (int mt = 0; mt < 2; ++mt) { const int row = 32 * wave + 16 * mt + r; const float rs = rsqrtf(ssq[row] * (1.0f / 1024.0f) + 1e-6f);
#pragma unroll
            for (int nt = 0; nt < 2; ++nt) { const int col = c0 + 16 * nt + 4 * g; f32x4 v = acc[mt][nt] * rs;
                if (pn == 14) { const int tc = col & 255; f32x4 o;
#pragma unroll
                    for (int i = 0; i < 4; ++i) { const float x = v[i] + gbias[tc + i]; const float ls = fminf(x, 0.f) - __logf(1.0f + __expf(-fabsf(x))); o[i] = __expf(ls * 0.0625f); }
                    *(f32x4*)(GA + (size_t)row * 256 + tc) = o;
                } else {
                    if (pn == 0) v = v * 0.125f;
                    else if (pn == 6 || pn == 7) { v[0] = silu_f(v[0]); v[1] = silu_f(v[1]); v[2] = silu_f(v[2]); v[3] = silu_f(v[3]); }
                    *(u32x2*)(P + ((size_t)(row >> 6) * 14 + (col >> 8)) * 16384 + (row & 63) * 256 + (col & 255)) = (u32x2){pkbf(v[0], v[1]), pkbf(v[2], v[3])};
                } } }
    }
};
}
#define GAS __attribute__((address_space(1)))
#define LAS __attribute__((address_space(3)))
typedef unsigned short bf16;
typedef unsigned v4u __attribute__((ext_vector_type(4)));
typedef float f32x4 __attribute__((ext_vector_type(4)));
constexpr int NWAVES = 8;
constexpr int D = 1024, FF = 2816, MP = 32768, MS = 256, M = MP + MS, PW = 3584, NIN = 3840, DINSRC = 3600;
constexpr float EPS = 1e-6f;
constexpr size_t MiB = 1u << 20;
constexpr size_t WS_SSQ = 0, SSQ_STRIDE = (size_t)M * 4;
constexpr size_t WS_BAR = 768 * 1024, BAR_BYTES = 16384;
constexpr int MISC_OFF = 147456 - 64;
constexpr size_t WS_WGU1 = 1 * MiB, WS_WD1 = 12 * MiB, WS_WIN = 18 * MiB, WS_WO = 26 * MiB, WS_WGU2 = 28 * MiB, WS_WD2 = 39 * MiB;
constexpr size_t WS_XB = 45 * MiB, WS_MIX = 110 * MiB, WS_P = 175 * MiB, WS_HID = WS_P, WS_GA = 401 * MiB, WS_ST = 434 * MiB, WS_DT = 483 * MiB, WS_DUMMY = 484 * MiB, WS_END = 512 * MiB;
static_assert(WS_P + (size_t)M * PW * 2 <= WS_GA && WS_GA + (size_t)M * 256 * 4 <= WS_ST && WS_XB + (size_t)M * D * 2 <= WS_MIX && WS_MIX + (size_t)M * D * 2 <= WS_P, "ws map");
constexpr size_t O_Y = 0, O_SGP = (size_t)M * D, O_SHP = O_SGP + 4 * 4 * 64 * 128, O_SGS = O_SHP + 4 * 4 * 128 * 128, O_SHS = O_SGS + 8 * 4 * 64 * 128, O_END = O_SHS + 8 * 4 * 128 * 128;
constexpr int LDS_BYTES = 147456;

__device__ __forceinline__ unsigned f2bf(float f) { unsigned u = __builtin_bit_cast(unsigned, f); return (u + 0x7fffu + ((u >> 16) & 1u)) >> 16; }
__device__ __forceinline__ unsigned pk2(float lo, float hi) { return f2bf(lo) | (f2bf(hi) << 16); }
__device__ __forceinline__ float bf2f(bf16 b) { return __builtin_bit_cast(float, (unsigned)b << 16); }
#define LDS_WAIT() asm volatile("s_waitcnt lgkmcnt(0)" ::: "memory")

#define XB_TMO      128
#define XB_XCNT(j)  (256  + 64 * (j))
#define XB_XSUB(j)  (1280 + 64 * (j))
#define XB_XGEN(j)  (2304 + 64 * (j))
#define XB_TOP      3328
#define XB_TOPGEN   3392
#define XCD_BAR_WORDS 3456
#define XB_SPIN_CAP (1u << 18)

__device__ __forceinline__ unsigned xb_ld(unsigned* p)              { return __hip_atomic_load(p, __ATOMIC_RELAXED, __HIP_MEMORY_SCOPE_AGENT); }
__device__ __forceinline__ unsigned xb_add(unsigned* p, unsigned v) { return __hip_atomic_fetch_add(p, v, __ATOMIC_RELAXED, __HIP_MEMORY_SCOPE_AGENT); }
__device__ __forceinline__ unsigned xb_xcc_id() { return (unsigned)__builtin_amdgcn_s_getreg((3 << 11) | 20) & 0xFu; }
#define XB_SPIN(cond, bar) do { unsigned _sp = 0; while (cond) { __builtin_amdgcn_s_sleep(1); \
    if ((++_sp & 255u) == 0u) { if (xb_ld(&(bar)[XB_TMO])) break; if (_sp > XB_SPIN_CAP) { atomicAdd(&(bar)[XB_TMO], 1u); break; } } } } while (0)

struct XcdBarrier {
    unsigned* bar; unsigned x;
    volatile LAS unsigned* st;
};

__device__ __forceinline__ XcdBarrier xcd_barrier_post(unsigned* bar, volatile LAS unsigned* st) {
    XcdBarrier b; b.bar = bar; b.x = xb_xcc_id(); b.st = st;
    if (threadIdx.x == 0) (void)xb_add(&bar[XB_XCNT(b.x)], 1u);
    return b;
}
__device__ __forceinline__ void xcd_barrier_complete(unsigned* bar, unsigned x, unsigned& nloc, unsigned& nx) {
    const unsigned G = gridDim.x * gridDim.y * gridDim.z;
    unsigned sum, cnt, mine, sp = 0u;
    for (;;) {
        sum = 0u; cnt = 0u; mine = 0u;
#pragma unroll
        for (unsigned j = 0; j < 16; ++j) { const unsigned c = xb_ld(&bar[XB_XCNT(j)]); sum += c; cnt += (c > 0u) ? 1u : 0u; mine = (j == x) ? c : mine; }
        if (sum == G) break;
        __builtin_amdgcn_s_sleep(1);
        if ((++sp & 255u) == 0u) { if (xb_ld(&bar[XB_TMO])) break; if (sp > XB_SPIN_CAP) { atomicAdd(&bar[XB_TMO], 1u); break; } }
    }
    nloc = mine > 0u ? mine : 1u; nx = cnt > 0u ? cnt : 1u;
}

__device__ __forceinline__ void xcd_barrier(const XcdBarrier& b) {
    asm volatile("s_waitcnt vmcnt(0)" ::: "memory");
    __syncthreads();
    if (threadIdx.x == 0) {
        unsigned* bar = b.bar;
        __builtin_amdgcn_s_waitcnt(0);
        unsigned nloc = b.st[0], nx = b.st[1];
        if (nloc == 0u) { xcd_barrier_complete(bar, b.x, nloc, nx); b.st[0] = nloc; b.st[1] = nx; }
        const unsigned old = xb_add(&bar[XB_XSUB(b.x)], 1u);
        const unsigned gen = old / nloc;
        if (old + 1u == (gen + 1u) * nloc) {
            __builtin_amdgcn_fence(__ATOMIC_RELEASE, "agent");
            asm volatile("s_waitcnt vmcnt(0)" ::: "memory");
            const unsigned og = xb_add(&bar[XB_TOP], 1u);
            const unsigned tg = og / nx;
            if (og + 1u == (tg + 1u) * nx) xb_add(&bar[XB_TOPGEN], 1u);
            else XB_SPIN(xb_ld(&bar[XB_TOPGEN]) == tg, bar);
            __builtin_amdgcn_fence(__ATOMIC_ACQUIRE, "agent");
            xb_add(&bar[XB_XGEN(b.x)], 1u);
            asm volatile("s_waitcnt vmcnt(0)" ::: "memory");
        } else {
            XB_SPIN(xb_ld(&bar[XB_XGEN(b.x)]) == gen, bar);
            __builtin_amdgcn_fence(__ATOMIC_ACQUIRE, "agent");
            asm volatile("s_waitcnt vmcnt(0)" ::: "memory");
        }
    }
    __syncthreads();
}

#ifndef DUPMASK
#define DUPMASK 0
#endif
struct Args { const float* in[21]; float* out; unsigned char* ws; int ph_lo, ph_hi, dup, pad; };
typedef const Args __attribute__((address_space(4))) CArgs;

__device__ __forceinline__ float wave_sum(float v) {
#pragma unroll
    for (int o = 1; o < 64; o <<= 1) v += __shfl_xor(v, o);
    return v;
}
__device__ __forceinline__ void tr_item(const float* W, int ldw, int src_col0, int k0, const float* gain, bf16* WT, int K, int dst_row0, LAS float* scr, int lane) {
    float w[32];
    const float* wp = W + (size_t)(k0 + (lane >> 5)) * ldw + src_col0 + (lane & 31);
#pragma unroll
    for (int i = 0; i < 32; ++i) w[i] = __builtin_nontemporal_load(wp + (size_t)(2 * i) * ldw);
    if (gain) {
#pragma unroll
        for (int i = 0; i < 32; ++i) w[i] *= gain[k0 + 2 * i + (lane >> 5)];
    }
#pragma unroll
    for (int i = 0; i < 32; ++i) scr[(2 * i + (lane >> 5)) * 33 + (lane & 31)] = w[i];
    LDS_WAIT(); asm volatile("" ::: "memory");
    const int c = lane & 7;
#pragma unroll
    for (int j = 0; j < 4; ++j) { const int n = (lane >> 3) + 8 * j; const LAS float* s = scr + (8 * c) * 33 + n;
        v4u o; o.x = pk2(s[0 * 33], s[1 * 33]); o.y = pk2(s[2 * 33], s[3 * 33]); o.z = pk2(s[4 * 33], s[5 * 33]); o.w = pk2(s[6 * 33], s[7 * 33]);
        *(v4u*)(WT + (size_t)(dst_row0 + n) * K + k0 + 8 * c) = o; }
    LDS_WAIT(); asm volatile("" ::: "memory");
}
__device__ __forceinline__ void weff_item(const float* Win, const float* up, int n0, int k0, const float* gain, bf16* WT, LAS float* scr, int lane) {
    float upr[16];
#pragma unroll
    for (int r = 0; r < 16; ++r) upr[r] = up[r * 256 + n0 + (lane & 31)];
#pragma unroll 4
    for (int i = 0; i < 32; ++i) { const int kk = 2 * i + (lane >> 5); const float* wr = Win + (size_t)(k0 + kk) * DINSRC + 1536; float s = 0.f;
#pragma unroll
        for (int r = 0; r < 16; ++r) s += wr[r] * upr[r];
        scr[kk * 33 + (lane & 31)] = s * gain[k0 + kk]; }
    LDS_WAIT(); asm volatile("" ::: "memory");
    const int c = lane & 7;
#pragma unroll
    for (int j = 0; j < 4; ++j) { const int n = (lane >> 3) + 8 * j; const LAS float* s = scr + (8 * c) * 33 + n;
        v4u o; o.x = pk2(s[0 * 33], s[1 * 33]); o.y = pk2(s[2 * 33], s[3 * 33]); o.z = pk2(s[4 * 33], s[5 * 33]); o.w = pk2(s[6 * 33], s[7 * 33]);
        *(v4u*)(WT + (size_t)(3584 + n0 + n) * 1024 + k0 + 8 * c) = o; }
    LDS_WAIT(); asm volatile("" ::: "memory");
}
__device__ __forceinline__ void gu_item(int r, const float* wg, const float* wu, const float* gain, bf16* WT, LAS float* scr, int lane) {
    const int kb = r / 176, nb = r % 176, dst = 32 * nb, tile = dst >> 8, j = dst & 255;
    const float* W = (j < 128) ? wg : wu; const int src = tile * 128 + (j & 127);
    tr_item(W, FF, src, 64 * kb, gain, WT, D, dst, scr, lane);
}

__device__ __forceinline__ int opaque_tid() { int t = threadIdx.x; asm volatile("" : "+v"(t)); return t; }
__device__ __forceinline__ void p0_prologue(CArgs& a, LAS unsigned char* lds, int G, int bx) {
    const int tid = opaque_tid(), lane = tid & 63, wave = __builtin_amdgcn_readfirstlane(tid >> 6);
    const int gw = bx * NWAVES + wave, NGW = G * NWAVES, gtid = bx * (NWAVES * 64) + tid, NGT = G * NWAVES * 64;
    LAS float* scr = (LAS float*)(lds + wave * 16384);
    unsigned char* ws = a.ws;
    constexpr int I_GU = 16 * 176, I_D = 44 * 32, I_IN = 16 * 112, I_EFF = 16 * 8, I_O = 16 * 32;
    constexpr int NITEMS = 2 * I_GU + 2 * I_D + I_IN + I_EFF + I_O;
    for (int it = gw; it < NITEMS; it += NGW) {
        int r = it; asm volatile("" : "+s"(ws));
        if (r < I_GU) { gu_item(r, a.in[5], a.in[6], a.in[4], (bf16*)(ws + WS_WGU1), scr, lane); continue; } r -= I_GU;
        if (r < I_D) { tr_item(a.in[7], D, 32 * (r % 32), 64 * (r / 32), nullptr, (bf16*)(ws + WS_WD1), FF, 32 * (r % 32), scr, lane); continue; } r -= I_D;
        if (r < I_IN) { const int kb = r / 112, nb = r % 112, dst = 32 * nb, src = dst < 1536 ? dst : dst + 16;
            tr_item(a.in[9], DINSRC, src, 64 * kb, a.in[8], (bf16*)(ws + WS_WIN), D, dst, scr, lane); continue; } r -= I_IN;
        if (r < I_EFF) { weff_item(a.in[9], a.in[10], 32 * (r % 8), 64 * (r / 8), a.in[8], (bf16*)(ws + WS_WIN), scr, lane); continue; } r -= I_EFF;
        if (r < I_O) { tr_item(a.in[15], D, 32 * (r % 32), 64 * (r / 32), nullptr, (bf16*)(ws + WS_WO), D, 32 * (r % 32), scr, lane); continue; } r -= I_O;
        if (r < I_GU) { gu_item(r, a.in[17], a.in[18], a.in[16], (bf16*)(ws + WS_WGU2), scr, lane); continue; } r -= I_GU;
        tr_item(a.in[19], D, 32 * (r % 32), 64 * (r / 32), nullptr, (bf16*)(ws + WS_WD2), FF, 32 * (r % 32), scr, lane);
    }
    float* ssq1 = (float*)(ws + WS_SSQ); bf16* XB = (bf16*)(ws + WS_XB);
    for (int m0 = 2 * gw; m0 < M; m0 += 2 * NGW) {
        f32x4 v[2][4]; float s[2];
#pragma unroll
        for (int h = 0; h < 2; ++h) { const int m = m0 + h;
            const float* xrow = (m < MP) ? a.in[0] + (size_t)m * D : a.in[1] + (size_t)(m - MP) * D;
            const f32x4* xr = (const f32x4*)xrow + lane;
#pragma unroll
            for (int j = 0; j < 4; ++j) v[h][j] = __builtin_nontemporal_load(xr + 64 * j); }
#pragma unroll
        for (int h = 0; h < 2; ++h) { const int m = m0 + h; float ss = 0.f;
#pragma unroll
            for (int j = 0; j < 4; ++j) ss += (v[h][j].x * v[h][j].x + v[h][j].y * v[h][j].y) + (v[h][j].z * v[h][j].z + v[h][j].w * v[h][j].w);
            s[h] = wave_sum(ss);
            unsigned long long* o8 = (unsigned long long*)(XB + (size_t)m * D) + lane;
#pragma unroll
            for (int j = 0; j < 4; ++j) o8[64 * j] = (unsigned long long)pk2(v[h][j].x, v[h][j].y) | ((unsigned long long)pk2(v[h][j].z, v[h][j].w) << 32);
            if (lane == 0) ssq1[m] = s[h]; }
    }
    for (int i = gtid; i < 3 * M; i += NGT) ssq1[M + i] = 0.f;
}

__device__ __forceinline__ void p8_final(CArgs& a, int G, int bx) {
    const int tid = opaque_tid(), lane = tid & 63, wave = __builtin_amdgcn_readfirstlane(tid >> 6);
    const int gw = bx * NWAVES + wave, NGW = G * NWAVES;
    const float* ssq4 = (const float*)(a.ws + WS_SSQ) + 3 * (size_t)M; const bf16* XB = (const bf16*)(a.ws + WS_XB);
    const f32x4* g = (const f32x4*)a.in[20] + 2 * lane;
    f32x4 gv[2][2];
#pragma unroll
    for (int j = 0; j < 2; ++j) { gv[j][0] = g[128 * j]; gv[j][1] = g[128 * j + 1]; }
    for (int m0 = 2 * gw; m0 < M; m0 += 2 * NGW) {
        v4u xv[2][2];
#pragma unroll
        for (int h = 0; h < 2; ++h)
#pragma unroll
            for (int j = 0; j < 2; ++j) xv[h][j] = __builtin_nontemporal_load((const v4u*)(XB + (size_t)(m0 + h) * D) + lane + 64 * j);
#pragma unroll
        for (int h = 0; h < 2; ++h) { const float rs = rsqrtf(ssq4[m0 + h] * (1.0f / 1024.0f) + EPS); f32x4* yr = (f32x4*)(a.out + (size_t)(m0 + h) * D) + 2 * lane;
#pragma unroll
            for (int j = 0; j < 2; ++j) { const v4u x = xv[h][j];
                const f32x4 lo = {__builtin_bit_cast(float, x.x << 16), __builtin_bit_cast(float, x.x & 0xffff0000u), __builtin_bit_cast(float, x.y << 16), __builtin_bit_cast(float, x.y & 0xffff0000u)};
                const f32x4 hi = {__builtin_bit_cast(float, x.z << 16), __builtin_bit_cast(float, x.z & 0xffff0000u), __builtin_bit_cast(float, x.w << 16), __builtin_bit_cast(float, x.w & 0xffff0000u)};
                __builtin_nontemporal_store(lo * rs * gv[j][0], yr + 128 * j); __builtin_nontemporal_store(hi * rs * gv[j][1], yr + 128 * j + 1); } }
    }
}

__device__ __forceinline__ CArgs& kargs() { CArgs* p = (CArgs*)__builtin_amdgcn_kernarg_segment_ptr(); asm volatile("" : "+s"(p)); return *p; }
__global__ void __launch_bounds__(NWAVES * 64, 2) mega_fwd(Args args_unused) {
    extern __shared__ __attribute__((aligned(16))) unsigned char lds_raw[];
    cg::grid_group grid = cg::this_grid();
    LAS unsigned char* lds = (LAS unsigned char*)lds_raw;
    const int G = gridDim.x, bx = blockIdx.x;
    const int lo = kargs().ph_lo, hi = kargs().ph_hi, dup = kargs().dup;
    volatile LAS unsigned* misc = (volatile LAS unsigned*)(lds + MISC_OFF);
    if (threadIdx.x < 16) misc[threadIdx.x] = 0u;
    __syncthreads();
    XcdBarrier xbar = xcd_barrier_post((unsigned*)(kargs().ws + WS_BAR), misc);
    if (lo < 0) grid.sync();
#define IN(k) (lo <= (k) && (k) < hi)
#define BOTH(k) (IN(k) && IN((k) + 1))
#define GRID_BAR() xcd_barrier(xbar)
#define REP(k) for (int rep_ = ((dup >> (k)) & 1); rep_ >= 0; --rep_)
#define STAGGER(us_step) do { const unsigned long long t0_ = __builtin_amdgcn_s_memrealtime(); const unsigned long long d_ = (unsigned long long)(((bx >> 3) & 7) * (us_step)) * 100ull; \
        while (__builtin_amdgcn_s_memrealtime() - t0_ < d_) __builtin_amdgcn_s_sleep(8); } while (0)
#define SSQ(a, i) ((float*)((a).ws + WS_SSQ) + (size_t)(i) * M)

    if (IN(0)) REP(0) { p0_prologue(kargs(), lds, G, bx); if (BOTH(0)) GRID_BAR(); }
    if (IN(1)) REP(1) {
        CArgs& a = kargs(); unsigned char* ws = a.ws;
        pg8::Gemm g{(const bf16*)(ws + WS_XB), (const bf16*)(ws + WS_WGU1), MP, 2 * FF, D}; pg8::StaticOrder S; S.init(MP, 2 * FF, G, bx);
        pg8::EpiUp E{(bf16*)(ws + WS_HID), FF, SSQ(a, 0)};
#define SMALL_UP(WOFF, SIDX) for (int u = bx; u < FF / 16; u += G) { const int hc0 = 16 * u; const bf16* W = (const bf16*)(ws + (WOFF)) + (size_t)((hc0 >> 7) * 256 + (hc0 & 127)) * D; \
            sg::EpiUpS Es{(bf16*)(ws + WS_HID) + (size_t)MP * FF, FF, SSQ(a, SIDX) + MP, hc0}; sg::unit<2>(lds, (const bf16*)(ws + WS_XB) + (size_t)MP * D, D, W, W + (size_t)128 * D, Es); }
        const bool pre = bx < G / 2;
        if (pre) { SMALL_UP(WS_WGU1, 0) __syncthreads(); }
        pg8::gemm_phase<pg8::EpiUp, pg8::StaticOrder, true, true>(lds, g, S, E);
        if (!pre) { SMALL_UP(WS_WGU1, 0) }
        if (BOTH(1)) GRID_BAR();
    }
    if (IN(2)) REP(2) {
        CArgs& a = kargs(); unsigned char* ws = a.ws;
        pg8::Gemm g{(const bf16*)(ws + WS_HID), (const bf16*)(ws + WS_WD1), MP, D, FF, 1}; pg8::StaticOrder S; S.init(MP, D, G, bx);
        pg8::EpiRes E{nullptr, nullptr, 1 << 30, (bf16*)(ws + WS_XB), rep_ ? (float*)(ws + WS_DUMMY) : SSQ(a, 1), rep_ ? 0.f : 0.5f};
#define SMALL_DOWN(WOFF, SIDX) for (int u = bx; u < 2 * (D / 16); u += G) { const int c0 = 16 * (u >> 1), rb = 128 * (u & 1); const bf16* W = (const bf16*)(ws + (WOFF)) + (size_t)c0 * FF; \
            sg::EpiResS1 Es{(bf16*)(ws + WS_XB) + (size_t)MP * D, (rep_ ? (float*)(ws + WS_DUMMY) : SSQ(a, SIDX)) + MP, rep_ ? 0.f : 0.5f, c0, rb}; sg::unit_k256(lds, (const bf16*)(ws + WS_HID) + (size_t)(MP + rb) * FF, FF, W, Es); }
        const bool pre = bx < G / 2;
        if (pre) { SMALL_DOWN(WS_WD1, 1) __syncthreads(); }
        pg8::gemm_phase<pg8::EpiRes, pg8::StaticOrder, true, true>(lds, g, S, E);
        if (!pre) { SMALL_DOWN(WS_WD1, 1) }
        if (BOTH(2)) GRID_BAR();
    }
    if (IN(3)) REP(3) {
        CArgs& a = kargs(); unsigned char* ws = a.ws;
        pg8::Gemm g{(const bf16*)(ws + WS_XB), (const bf16*)(ws + WS_WIN), MP, NIN, D}; pg8::StaticOrder S; S.init(MP, NIN, G, bx);
        pg8::EpiWin E{(bf16*)(ws + WS_P), (float*)(ws + WS_GA), SSQ(a, 1), a.in[11]};
        for (int u = (bx + G / 2) % G; u < NIN / 32; u += G) { const int c0 = 32 * u; const bf16* W = (const bf16*)(ws + WS_WIN) + (size_t)c0 * D;
            sg::EpiWinS Es{(bf16*)(ws + WS_P) + (size_t)MP * PW, (float*)(ws + WS_GA) + (size_t)MP * 256, SSQ(a, 1) + MP, a.in[11], c0}; sg::unit<2>(lds, (const bf16*)(ws + WS_XB) + (size_t)MP * D, D, W, W + (size_t)16 * D, Es); }
        __syncthreads();
        pg8::gemm_phase<pg8::EpiWin, pg8::StaticOrder, true, true>(lds, g, S, E);
        if (BOTH(3)) GRID_BAR();
    }
#define MAKE_RA(a) rec::RecArgs ra{(const bf16*)((a).ws + WS_P), (const float*)((a).ws + WS_GA), (bf16*)((a).ws + WS_MIX), (a).in[13], (a).in[12], (a).in[14], (a).in[2], (a).in[3], \
                        (float*)((a).ws + WS_ST), (float*)((a).ws + WS_DT), (a).out + O_SGP, (a).out + O_SHP, (a).out + O_SGS, (a).out + O_SHS}
    if (IN(4)) REP(4) { CArgs& a = kargs(); MAKE_RA(a); rec::phase_r1(lds, ra, G, bx); if (BOTH(4)) GRID_BAR(); }
    if (IN(5)) { CArgs& a = kargs(); MAKE_RA(a); rec::phase_r2(ra, bx * (NWAVES * 64) + opaque_tid(), G * NWAVES * 64); if (BOTH(5)) GRID_BAR(); }
    if (IN(6)) REP(6) { CArgs& a = kargs(); MAKE_RA(a); rec::phase_r3(lds, ra, G, bx); if (BOTH(6)) GRID_BAR(); }
    if (IN(7)) REP(7) {
        CArgs& a = kargs(); unsigned char* ws = a.ws;
        pg8::Gemm g{(const bf16*)(ws + WS_MIX), (const bf16*)(ws + WS_WO), MP, D, D}; pg8::StaticOrder S; S.init(MP, D, G, bx);
        pg8::EpiRes E{nullptr, nullptr, 1 << 30, (bf16*)(ws + WS_XB), rep_ ? (float*)(ws + WS_DUMMY) : SSQ(a, 2), rep_ ? 0.f : 1.0f};
#define SMALL_OUT() for (int u = bx; u < D / 16; u += G) { const int c0 = 16 * u; const bf16* W = (const bf16*)(ws + WS_WO) + (size_t)c0 * D; \
            sg::EpiResS Es{nullptr, (bf16*)(ws + WS_XB) + (size_t)MP * D, (rep_ ? (float*)(ws + WS_DUMMY) : SSQ(a, 2)) + MP, rep_ ? 0.f : 1.0f, c0}; sg::unit<1>(lds, (const bf16*)(ws + WS_MIX) + (size_t)MP * D, D, W, W, Es); }
        const bool pre = bx < G / 2;
        if (pre) { SMALL_OUT() __syncthreads(); }
        pg8::gemm_phase<pg8::EpiRes, pg8::StaticOrder, true, true>(lds, g, S, E);
        if (!pre) { SMALL_OUT() }
        if (BOTH(7)) GRID_BAR();
    }
    if (IN(8)) REP(8) {
        CArgs& a = kargs(); unsigned char* ws = a.ws;
        pg8::Gemm g{(const bf16*)(ws + WS_XB), (const bf16*)(ws + WS_WGU2), MP, 2 * FF, D}; pg8::StaticOrder S; S.init(MP, 2 * FF, G, bx);
        pg8::EpiUp E{(bf16*)(ws + WS_HID), FF, SSQ(a, 2)};
        const bool pre = bx < G / 2;
        if (pre) { SMALL_UP(WS_WGU2, 2) __syncthreads(); }
        pg8::gemm_phase<pg8::EpiUp, pg8::StaticOrder, true, true>(lds, g, S, E);
        if (!pre) { SMALL_UP(WS_WGU2, 2) }
        if (BOTH(8)) GRID_BAR();
    }
    if (IN(9)) REP(9) {
        CArgs& a = kargs(); unsigned char* ws = a.ws;
        pg8::Gemm g{(const bf16*)(ws + WS_HID), (const bf16*)(ws + WS_WD2), MP, D, FF, 1}; pg8::StaticOrder S; S.init(MP, D, G, bx);
        pg8::EpiRes E{nullptr, nullptr, 1 << 30, (bf16*)(ws + WS_XB), rep_ ? (float*)(ws + WS_DUMMY) : SSQ(a, 3), rep_ ? 0.f : 0.5f};
        const bool pre = bx < G / 2;
        if (pre) { SMALL_DOWN(WS_WD2, 3) __syncthreads(); }
        pg8::gemm_phase<pg8::EpiRes, pg8::StaticOrder, true, true>(lds, g, S, E);
        if (!pre) { SMALL_DOWN(WS_WD2, 3) }
        if (BOTH(9)) GRID_BAR();
    }
    if (IN(10)) p8_final(kargs(), G, bx);
    if (dup & 2048) for (int i = 0; i < 20; ++i) GRID_BAR();
#undef IN
#undef BOTH
}

extern "C" void kernel_launch(void* const* d_in, const int* in_sizes, int n_in, void* d_out, int out_size, void* d_ws, size_t ws_size, hipStream_t stream) {
    static int grid = 0;
    if (grid == 0) {
        if (n_in != 21 || out_size != (int)O_END || ws_size < WS_END) { fprintf(stderr, "kernel_launch: unexpected sizes n_in %d out %d ws %zu\n", n_in, out_size, ws_size); grid = -1; return; }
        int dev = 0, cus = 0, per_cu = 0;
        (void)hipGetDevice(&dev); (void)hipDeviceGetAttribute(&cus, hipDeviceAttributeMultiprocessorCount, dev);
        if (hipFuncSetAttribute((const void*)mega_fwd, hipFuncAttributeMaxDynamicSharedMemorySize, LDS_BYTES) != hipSuccess) { fprintf(stderr, "hipFuncSetAttribute failed\n"); grid = -1; return; }
        if (hipOccupancyMaxActiveBlocksPerMultiprocessor(&per_cu, (const void*)mega_fwd, NWAVES * 64, LDS_BYTES) != hipSuccess || per_cu < 1) { fprintf(stderr, "occupancy query: %d\n", per_cu); per_cu = 1; }
        (void)hipGetLastError();
        grid = cus * per_cu;
    }
    if (grid < 0) return;
    Args a{};
    for (int i = 0; i < 21; ++i) a.in[i] = (const float*)d_in[i];
    a.out = (float*)d_out; a.ws = (unsigned char*)d_ws;
    a.ph_lo = 0; a.ph_hi = 11; a.dup = DUPMASK;
    if (hipMemsetAsync((char*)d_ws + WS_BAR, 0, BAR_BYTES, stream) != hipSuccess) { fprintf(stderr, "kernel_launch: memset of the barrier words failed\n"); return; }
    void* kargs[] = {&a};
    hipError_t e = hipLaunchCooperativeKernel((const void*)mega_fwd, dim3(grid), dim3(NWAVES * 64), kargs, LDS_BYTES, stream);
    if (e != hipSuccess) fprintf(stderr, "cooperative launch failed: %s (grid %d)\n", hipGetErrorString(e), grid);
}
```

```cpp
#include <hip/hip_runtime.h>
#include <hip/hip_cooperative_groups.h>
#include <cstdio>
#include <cstdint>
namespace cg = cooperative_groups;
namespace pg8 {
#define PG8_LAS __attribute__((address_space(3)))
typedef unsigned short bf16_t;
typedef short bf16x8 __attribute__((ext_vector_type(8)));
typedef float f32x4 __attribute__((ext_vector_type(4)));
typedef unsigned u32x4 __attribute__((ext_vector_type(4)));
constexpr int BM = 256, BK = 64, HALF = 128, HTB = HALF * BK * 2  , STAGE_BYTES = 8 * HTB, NXCD = 8, WGM = 8;

__host__ __device__ __forceinline__ int lds_byte(int r, int c) { const int st = (r >> 4) * 2 + (c >> 5), rr = r & 15, cc = c & 31, ob = rr * 64 + cc * 2; return st * 1024 + (ob ^ (((ob >> 9) & 1) << 5)); }
__host__ __device__ __forceinline__ void stage_rc(int b, int& R, int& C) { const int st = b / 1024, sb = b % 1024, swz = sb ^ (((sb >> 9) & 1) << 5); R = (st >> 1) * 16 + swz / 64; C = (st & 1) * 32 + (swz % 64) / 2; }
__host__ __device__ __forceinline__ int perm32(int rho) { const int n = rho >> 4, i = rho & 15; return 8 * (i >> 2) + 4 * n + (i & 3); }

struct Unit { int pm, pn; };
struct Gemm { const bf16_t* A; const bf16_t* Bt; int M, N, K; int a_tiled = 0; };

struct StaticOrder {
    int nM, nN, nwg, G, c;
    __host__ __device__ void init(int M, int N, int G_, int c_) { nM = M / BM; nN = N / BM; nwg = nM * nN; G = G_; c = c_; }
    __host__ __device__ bool next(int i, Unit& u) const {
        const long L = (long)i * G + c; if (L >= nwg) return false;
        int wgid = (int)L; { const int q = nwg / NXCD, r = nwg % NXCD, xcd = wgid % NXCD, off = wgid / NXCD; wgid = (xcd < r ? xcd * (q + 1) : r * (q + 1) + (xcd - r) * q) + off; }
        const int nig = WGM * nN, gid = wgid / nig, fm = gid * WGM, gsz = (nM - fm) < WGM ? (nM - fm) : WGM;
        u.pm = fm + ((wgid % nig) % gsz); u.pn = (wgid % nig) / gsz; return true;
    }
    __device__ __forceinline__ void a_ready(const Unit&) const {}
    __device__ __forceinline__ void done(const Unit&) const {}
};

__device__ __forceinline__ unsigned cvt_pk_bf16(float lo, float hi) { unsigned r; asm volatile("v_cvt_pk_bf16_f32 %0, %1, %2" : "=v"(r) : "v"(lo), "v"(hi)); return r; }
typedef float f32x2 __attribute__((ext_vector_type(2)));
constexpr float RMS_EPS = 1e-6f;
__device__ __forceinline__ float silu_f(float g) { return g * __builtin_amdgcn_rcpf(1.0f + __expf(-g)); }
__device__ __forceinline__ float rstd_of(const float* ssq, int row) { return rsqrtf(ssq[row] * (1.0f / 1024.0f) + RMS_EPS); }

struct EpiUp {
    static constexpr bool PERM = true, AFTER_DRAIN = false, HAS_PF = false;
    bf16_t* H; int ldh; const float* ssq;
    __device__ __forceinline__ void operator()(const f32x4 (&acc)[2][2][4][2], const Unit& u, int wr, int wc, int fr, int fq) const {
        const int row0 = u.pm * BM + wr * 64 + fr, hcol0 = u.pn * HALF + wc * 32 + 8 * fq;
#pragma unroll
        for (int ai = 0; ai < 2; ++ai)
#pragma unroll
            for (int m = 0; m < 4; ++m) {
                const int row = row0 + ai * HALF + m * 16; const float rs = rstd_of(ssq, row);
                float h[8]; const float ne = rs * -1.4426950408889634f, rs2 = rs * rs;
#pragma unroll
                for (int n = 0; n < 2; ++n)
#pragma unroll
                    for (int p = 0; p < 2; ++p) {
                        const f32x2 ag = {acc[ai][0][m][n][2 * p], acc[ai][0][m][n][2 * p + 1]}, au = {acc[ai][1][m][n][2 * p], acc[ai][1][m][n][2 * p + 1]};
                        const f32x2 x = ag * ne; f32x2 t; t.x = __builtin_amdgcn_exp2f(x.x); t.y = __builtin_amdgcn_exp2f(x.y);
                        const f32x2 den = t + 1.0f, num = (ag * au) * rs2; f32x2 rc; rc.x = __builtin_amdgcn_rcpf(den.x); rc.y = __builtin_amdgcn_rcpf(den.y);
                        const f32x2 o = num * rc; h[4 * n + 2 * p] = o.x; h[4 * n + 2 * p + 1] = o.y; }
                u32x4 w; w.x = cvt_pk_bf16(h[0], h[1]); w.y = cvt_pk_bf16(h[2], h[3]); w.z = cvt_pk_bf16(h[4], h[5]); w.w = cvt_pk_bf16(h[6], h[7]);
                *(u32x4*)(H + (size_t)(row >> 8) * (BM * ldh) + (size_t)(hcol0 >> 6) * (BM * BK) + (row & 255) * BK + (hcol0 & 63)) = w;
            }
    }
};

struct EpiRes {
    static constexpr bool PERM = true, AFTER_DRAIN = false, HAS_PF = false;
    __device__ __forceinline__ void prefetch(const Unit& u, PG8_LAS unsigned char* dummy, int wid, int lane) const {
        PG8_LAS unsigned* dst = (PG8_LAS unsigned*)(dummy + wid * 1024);
        if (xf0) { const char* ub = (const char*)(((u.pm < split_pm) ? xf0 : (xf1 - (size_t)split_pm * BM * 1024)) + (size_t)(u.pm * BM + 32 * wid) * 1024 + u.pn * BM);
            asm volatile("" : "+s"(ub)); unsigned lo = (unsigned)lane * 16u; asm volatile("" : "+v"(lo));
#pragma unroll
            for (int j = 0; j < 32; ++j) __builtin_amdgcn_global_load_lds((const unsigned*)(ub + (size_t)j * 4096 + lo), dst, 16, 0, 0);
        } else { const char* ub = (const char*)(xb + (size_t)(u.pm * BM + 32 * wid) * 1024 + u.pn * BM);
            asm volatile("" : "+s"(ub)); unsigned lo = (unsigned)(lane >> 5) * 2048u + (unsigned)(lane & 31) * 16u; asm volatile("" : "+v"(lo));
#pragma unroll
            for (int j = 0; j < 16; ++j) __builtin_amdgcn_global_load_lds((const unsigned*)(ub + (size_t)j * 4096 + lo), dst, 16, 0, 0);
        }
    }
    const float* xf0; const float* xf1; int split_pm;
    bf16_t* xb; float* ssq; float scale;
    __device__ __forceinline__ void finish(const f32x4 (&a0)[2], const f32x4 (&a1)[2], const f32x4 (&r)[2][2], size_t off, int row, int fq) const {
        float s = 0.f;
#pragma unroll
        for (int bj = 0; bj < 2; ++bj) {
            const f32x4 v0 = r[bj][0] + (bj ? a1[0] : a0[0]) * scale, v1 = r[bj][1] + (bj ? a1[1] : a0[1]) * scale;
            s += ((v0[0] * v0[0] + v0[1] * v0[1]) + (v0[2] * v0[2] + v0[3] * v0[3])) + ((v1[0] * v1[0] + v1[1] * v1[1]) + (v1[2] * v1[2] + v1[3] * v1[3]));
            u32x4 w; w.x = cvt_pk_bf16(v0[0], v0[1]); w.y = cvt_pk_bf16(v0[2], v0[3]); w.z = cvt_pk_bf16(v1[0], v1[1]); w.w = cvt_pk_bf16(v1[2], v1[3]);
            *(u32x4*)(xb + off + bj * HALF) = w;
        }
        s += __shfl_xor(s, 16); s += __shfl_xor(s, 32);
        if (fq == 0) __hip_atomic_fetch_add(ssq + row, s, __ATOMIC_RELAXED, __HIP_MEMORY_SCOPE_AGENT);
    }
    __device__ __forceinline__ void operator()(const f32x4 (&acc)[2][2][4][2], const Unit& u, int wr, int wc, int fr, int fq) const {
        const int row0 = u.pm * BM + wr * 64 + fr, col0 = u.pn * BM + wc * 32 + 8 * fq;
        if (xf0) {
            const float* xin = (u.pm < split_pm) ? xf0 : (xf1 - (size_t)split_pm * BM * 1024);
#pragma unroll
            for (int h = 0; h < 4; ++h) {
                const int ai = h >> 1, m0 = (h & 1) * 2; f32x4 r[2][2][2];
#pragma unroll
                for (int mm = 0; mm < 2; ++mm)
#pragma unroll
                    for (int bj = 0; bj < 2; ++bj) { const float* p = xin + (size_t)(row0 + ai * HALF + (m0 + mm) * 16) * 1024 + col0 + bj * HALF; r[mm][bj][0] = *(const f32x4*)p; r[mm][bj][1] = *(const f32x4*)(p + 4); }
                __builtin_amdgcn_sched_barrier(0);
#pragma unroll
                for (int mm = 0; mm < 2; ++mm) { const int row = row0 + ai * HALF + (m0 + mm) * 16; finish(acc[ai][0][m0 + mm], acc[ai][1][m0 + mm], r[mm], (size_t)row * 1024 + col0, row, fq); }
            }
        } else {
            u32x4 rb[2][4][2];
#pragma unroll
            for (int ai = 0; ai < 2; ++ai)
#pragma unroll
                for (int m = 0; m < 4; ++m)
#pragma unroll
                    for (int bj = 0; bj < 2; ++bj) rb[ai][m][bj] = *(const u32x4*)(xb + (size_t)(row0 + ai * HALF + m * 16) * 1024 + col0 + bj * HALF);
            __builtin_amdgcn_sched_barrier(0);
#pragma unroll
            for (int ai = 0; ai < 2; ++ai)
#pragma unroll
                for (int m = 0; m < 4; ++m) { const int row = row0 + ai * HALF + m * 16; f32x4 r[2][2];
#pragma unroll
                    for (int bj = 0; bj < 2; ++bj) { const u32x4 q = rb[ai][m][bj];
                        r[bj][0] = (f32x4){__builtin_bit_cast(float, q.x << 16), __builtin_bit_cast(float, q.x & 0xffff0000u), __builtin_bit_cast(float, q.y << 16), __builtin_bit_cast(float, q.y & 0xffff0000u)};
                        r[bj][1] = (f32x4){__builtin_bit_cast(float, q.z << 16), __builtin_bit_cast(float, q.z & 0xffff0000u), __builtin_bit_cast(float, q.w << 16), __builtin_bit_cast(float, q.w & 0xffff0000u)}; }
                    finish(acc[ai][0][m], acc[ai][1][m], r, (size_t)row * 1024 + col0, row, fq); }
        }
    }
};

struct EpiWin {
    static constexpr bool PERM = true, AFTER_DRAIN = false, HAS_PF = false;
    bf16_t* P; float* GA; const float* ssq; const float* gbias;
    __device__ __forceinline__ void operator()(const f32x4 (&acc)[2][2][4][2], const Unit& u, int wr, int wc, int fr, int fq) const {
        const int row0 = u.pm * BM + wr * 64 + fr, c0 = wc * 32 + 8 * fq, pn = u.pn;
#pragma unroll
        for (int ai = 0; ai < 2; ++ai)
#pragma unroll
            for (int m = 0; m < 4; ++m) {
                const int row = row0 + ai * HALF + m * 16; const float rs = rstd_of(ssq, row);
#pragma unroll
                for (int bj = 0; bj < 2; ++bj) {
                    float v[8];
#pragma unroll
                    for (int n = 0; n < 2; ++n)
#pragma unroll
                        for (int i = 0; i < 4; ++i) v[4 * n + i] = acc[ai][bj][m][n][i] * rs;
                    const int tc = bj * HALF + c0;
                    if (pn == 14) {
                        f32x4 o0, o1;
#pragma unroll
                        for (int i = 0; i < 8; ++i) { const float x = v[i] + gbias[tc + i]; const float ls = fminf(x, 0.f) - __logf(1.0f + __expf(-fabsf(x))); const float av = __expf(ls * 0.0625f); if (i < 4) o0[i] = av; else o1[i - 4] = av; }
                        *(f32x4*)(GA + (size_t)row * 256 + tc) = o0; *(f32x4*)(GA + (size_t)row * 256 + tc + 4) = o1;
                    } else {
                        if (pn == 0) {
#pragma unroll
                            for (int i = 0; i < 8; ++i) v[i] *= 0.125f;
                        } else if (pn == 6 || pn == 7) {
#pragma unroll
                            for (int i = 0; i < 8; ++i) v[i] = silu_f(v[i]);
                        }
                        u32x4 w; w.x = cvt_pk_bf16(v[0], v[1]); w.y = cvt_pk_bf16(v[2], v[3]); w.z = cvt_pk_bf16(v[4], v[5]); w.w = cvt_pk_bf16(v[6], v[7]);
                        *(u32x4*)(P + ((size_t)(row >> 6) * 14 + pn) * 16384 + (row & 63) * 256 + tc) = w;
                    }
                }
            }
    }
};
template <class Epi, class Sched, bool ALIGN_EPI = false, bool SP2 = false>
__device__ __forceinline__ void gemm_phase(PG8_LAS unsigned char* lds, const Gemm g, const Sched& S, const Epi& E) {
    int tid_ = threadIdx.x; asm volatile("" : "+v"(tid_));
    const int tid = tid_, wid = __builtin_amdgcn_readfirstlane(tid >> 6), lane = tid & 63, wr = wid >> 2, wc = wid & 3, fr = lane & 15, fq = lane >> 4;
    const int K = g.K, nt = K / BK;
    const int ldaA = g.a_tiled ? BK : K;
    unsigned voffA[2], voffB[2];
#pragma unroll
    for (int i = 0; i < 2; ++i) { int R, C; stage_rc(tid * 16 + i * 8192, R, C); const int Rb = Epi::PERM ? ((R & ~31) + perm32(R & 31)) : R;
        voffA[i] = (unsigned)(R * ldaA + C) * 2u; voffB[i] = (unsigned)(Rb * K + C) * 2u; }
    const size_t kstep = (size_t)(BK * 2);
    const size_t hstep = (size_t)HALF * K * 2;
    const size_t tstep = 2 * hstep;
    const size_t kstepA = g.a_tiled ? (size_t)BM * BK * 2 : kstep, hstepA = g.a_tiled ? (size_t)HALF * BK * 2 : hstep;
    const unsigned ldsw = (unsigned)wid * 1024u;
    const int aoff = lds_byte(wr * 64 + fr, fq * 8), boff = lds_byte(wc * 32 + fr, fq * 8);
#define PG8_SA(b, h) (((b) * 2 + (h)) * HTB)
#define PG8_SB(b, h) ((4 + (b) * 2 + (h)) * HTB)
#define PG8_STAGE(bufoff, gbase, voff) do { _Pragma("unroll") for (int _i = 0; _i < 2; ++_i) \
        __builtin_amdgcn_global_load_lds((const unsigned*)((const char*)(gbase) + (voff)[_i]), (PG8_LAS unsigned*)(lds + (bufoff) + ldsw + _i * 8192), 16, 0, 0); } while (0)
#define PG8_LDA(dst, b, h) do { _Pragma("unroll") for (int m = 0; m < 4; ++m) _Pragma("unroll") for (int k = 0; k < 2; ++k) dst[m][k] = *(const PG8_LAS bf16x8*)(lds + PG8_SA(b, h) + aoff + m * 2048 + k * 1024); } while (0)
#define PG8_LDB(dst, b, h) do { _Pragma("unroll") for (int n = 0; n < 2; ++n) _Pragma("unroll") for (int k = 0; k < 2; ++k) dst[n][k] = *(const PG8_LAS bf16x8*)(lds + PG8_SB(b, h) + boff + n * 2048 + k * 1024); } while (0)
#define PG8_MMA(ai, bj, At, Bt) do { __builtin_amdgcn_s_setprio(1); _Pragma("unroll") for (int m = 0; m < 4; ++m) _Pragma("unroll") for (int n = 0; n < 2; ++n) _Pragma("unroll") for (int k = 0; k < 2; ++k) \
        acc[ai][bj][m][n] = __builtin_amdgcn_mfma_f32_16x16x32_bf16(Bt[n][k], At[m][k], acc[ai][bj][m][n], 0, 0, 0); __builtin_amdgcn_s_setprio(0); } while (0)
#define PG8_WAIT_V(n) asm volatile("s_waitcnt vmcnt(" #n ")" ::: "memory")
#define PG8_WAIT_L(n) asm volatile("s_waitcnt lgkmcnt(" #n ")" ::: "memory")
#define PG8_BAR __builtin_amdgcn_s_barrier()
#define PG8_SCHED __builtin_amdgcn_sched_barrier(0)
    Unit cur, nxt; int ui = 0;
    if (!S.next(0, cur)) return;
    f32x4 acc[2][2][4][2];
#pragma unroll
    for (int a = 0; a < 2; ++a)
#pragma unroll
        for (int b = 0; b < 2; ++b)
#pragma unroll
            for (int m = 0; m < 4; ++m)
#pragma unroll
                for (int n = 0; n < 2; ++n) acc[a][b][m][n] = (f32x4){0.f, 0.f, 0.f, 0.f};
    bf16x8 At[4][2], B0[2][2], B1[2][2];
    const char* cA = (const char*)g.A + (size_t)cur.pm * tstep; const char* cB = (const char*)g.Bt + (size_t)cur.pn * tstep;
    S.a_ready(cur);
    if constexpr (SP2) {
        PG8_STAGE(PG8_SB(0, 0), cB, voffB); PG8_STAGE(PG8_SB(0, 1), cB + hstep, voffB); PG8_STAGE(PG8_SA(0, 0), cA, voffA); PG8_STAGE(PG8_SA(0, 1), cA + hstepA, voffA);
        if (wr == 1) PG8_BAR;
        PG8_WAIT_V(2); PG8_BAR;
        PG8_STAGE(PG8_SB(1, 0), cB + kstep, voffB); PG8_STAGE(PG8_SA(1, 0), cA + kstepA, voffA); PG8_STAGE(PG8_SB(1, 1), cB + hstep + kstep, voffB);
        PG8_WAIT_V(6); PG8_BAR;
    } else {
        PG8_STAGE(PG8_SB(0, 0), cB, voffB); PG8_STAGE(PG8_SA(0, 0), cA, voffA); PG8_STAGE(PG8_SB(0, 1), cB + hstep, voffB); PG8_STAGE(PG8_SA(0, 1), cA + hstepA, voffA);
        if (wr == 1) PG8_BAR;
        PG8_WAIT_V(4); PG8_BAR;
        PG8_STAGE(PG8_SB(1, 0), cB + kstep, voffB); PG8_STAGE(PG8_SA(1, 0), cA + kstepA, voffA); PG8_STAGE(PG8_SB(1, 1), cB + hstep + kstep, voffB);
        PG8_WAIT_V(6); PG8_BAR;
    }
    for (;;) {
        const bool has_next = S.next(ui + 1, nxt);
        const char* nA = has_next ? (const char*)g.A + (size_t)nxt.pm * tstep : cA; const char* nB = has_next ? (const char*)g.Bt + (size_t)nxt.pn * tstep : cB;
        for (int t = 0; t < nt; t += 2) {
            if constexpr (Epi::HAS_PF) { if (t == nt - 12) E.prefetch(cur, lds + STAGE_BYTES, wid, lane); }
            const bool last = (t == nt - 2);
            const char* a1 = cA + (size_t)(t + 1) * kstepA;
            const char* a2 = last ? nA : cA + (size_t)(t + 2) * kstepA; const char* b2 = last ? nB : cB + (size_t)(t + 2) * kstep;
            const char* a3 = a2 + kstepA; const char* b3 = b2 + kstep;
            if (last && has_next) S.a_ready(nxt);
            if constexpr (SP2) {
            PG8_LDB(B0, 0, 0); PG8_LDB(B1, 0, 1); PG8_SCHED; PG8_LDA(At, 0, 0); PG8_STAGE(PG8_SA(1, 1), a1 + hstepA, voffA);
            PG8_WAIT_V(8); PG8_WAIT_L(0); PG8_BAR; PG8_MMA(0, 0, At, B0); PG8_MMA(0, 1, At, B1); PG8_BAR; PG8_SCHED;
            PG8_LDA(At, 0, 1); PG8_STAGE(PG8_SB(0, 0), b2, voffB); PG8_STAGE(PG8_SB(0, 1), b2 + hstep, voffB); PG8_STAGE(PG8_SA(0, 0), a2, voffA);
            PG8_WAIT_V(8); PG8_WAIT_L(0); PG8_BAR; PG8_MMA(1, 0, At, B0); PG8_MMA(1, 1, At, B1); PG8_BAR; PG8_SCHED;
            PG8_LDB(B0, 1, 0); PG8_LDB(B1, 1, 1); PG8_SCHED; PG8_LDA(At, 1, 0); PG8_STAGE(PG8_SA(0, 1), a2 + hstepA, voffA);
            PG8_WAIT_V(8); PG8_WAIT_L(0); PG8_BAR; PG8_MMA(0, 0, At, B0); PG8_MMA(0, 1, At, B1); PG8_BAR; PG8_SCHED;
            PG8_LDA(At, 1, 1); PG8_STAGE(PG8_SB(1, 0), b3, voffB); PG8_STAGE(PG8_SB(1, 1), b3 + hstep, voffB); PG8_STAGE(PG8_SA(1, 0), a3, voffA);
            PG8_WAIT_V(8); PG8_WAIT_L(0); PG8_BAR; PG8_MMA(1, 0, At, B0); PG8_MMA(1, 1, At, B1); PG8_BAR; PG8_SCHED;
            } else {
            PG8_LDB(B0, 0, 0); PG8_SCHED; PG8_LDA(At, 0, 0); PG8_STAGE(PG8_SA(1, 1), a1 + hstepA, voffA);
            PG8_WAIT_L(8); PG8_BAR; PG8_WAIT_L(0); PG8_MMA(0, 0, At, B0); PG8_BAR; PG8_SCHED;
            PG8_LDB(B1, 0, 1); PG8_STAGE(PG8_SB(0, 0), b2, voffB);
            PG8_BAR; PG8_WAIT_L(0); PG8_MMA(0, 1, At, B1); PG8_BAR;
            PG8_LDA(At, 0, 1); PG8_STAGE(PG8_SA(0, 0), a2, voffA);
            PG8_BAR; PG8_WAIT_L(0); PG8_MMA(1, 0, At, B0); PG8_BAR; PG8_SCHED;
            PG8_STAGE(PG8_SB(0, 1), b2 + hstep, voffB);
            PG8_WAIT_V(6); PG8_BAR; PG8_MMA(1, 1, At, B1); PG8_BAR;
            PG8_LDB(B0, 1, 0); PG8_SCHED; PG8_LDA(At, 1, 0); PG8_STAGE(PG8_SA(0, 1), a2 + hstepA, voffA);
            PG8_WAIT_L(8); PG8_BAR; PG8_WAIT_L(0); PG8_MMA(0, 0, At, B0); PG8_BAR; PG8_SCHED;
            PG8_LDB(B1, 1, 1); PG8_STAGE(PG8_SB(1, 0), b3, voffB);
            PG8_BAR; PG8_WAIT_L(0); PG8_MMA(0, 1, At, B1); PG8_BAR;
            PG8_LDA(At, 1, 1); PG8_STAGE(PG8_SA(1, 0), a3, voffA);
            PG8_BAR; PG8_WAIT_L(0); PG8_MMA(1, 0, At, B0); PG8_BAR; PG8_SCHED;
            PG8_STAGE(PG8_SB(1, 1), b3 + hstep, voffB);
            PG8_WAIT_V(6); PG8_BAR; PG8_MMA(1, 1, At, B1); PG8_BAR;
            }
        }
        if constexpr (ALIGN_EPI) { if (wr == 0) PG8_BAR; }
        if constexpr (!Epi::AFTER_DRAIN) { E(acc, cur, wr, wc, fr, fq); S.done(cur); }
        if (!has_next) break;
#pragma unroll
        for (int a = 0; a < 2; ++a)
#pragma unroll
            for (int b = 0; b < 2; ++b)
#pragma unroll
                for (int m = 0; m < 4; ++m)
#pragma unroll
                    for (int n = 0; n < 2; ++n) acc[a][b][m][n] = (f32x4){0.f, 0.f, 0.f, 0.f};
        cur = nxt; cA = nA; cB = nB; ++ui;
        if constexpr (ALIGN_EPI) { if (wr == 1) PG8_BAR; }
    }
    PG8_WAIT_V(0);
    if constexpr (!ALIGN_EPI) { if (wr == 0) PG8_BAR; }
    PG8_BAR;
    if constexpr (Epi::AFTER_DRAIN) { E.fused(acc, cur, wr, wc, fr, fq, lds, wid, lane); S.done(cur); }
#undef PG8_SA
#undef PG8_SB
#undef PG8_STAGE
#undef PG8_LDA
#undef PG8_LDB
#undef PG8_MMA
#undef PG8_WAIT_V
#undef PG8_WAIT_L
#undef PG8_BAR
#undef PG8_SCHED
}
}
namespace rec {
#define RLAS __attribute__((address_space(3)))
typedef unsigned short bf16;
typedef short bf16x8 __attribute__((ext_vector_type(8)));
typedef short s16x4 __attribute__((ext_vector_type(4)));
typedef float f32x4 __attribute__((ext_vector_type(4)));
typedef float f32x2 __attribute__((ext_vector_type(2)));
typedef unsigned u32x2 __attribute__((ext_vector_type(2)));
typedef unsigned u32x4 __attribute__((ext_vector_type(4)));
constexpr int PWID = 3584, DM = 1024;
__device__ __forceinline__ const bf16* pat(const bf16* P, size_t row, int col) { return P + ((row >> 6) * 14 + (size_t)(col >> 8)) * 16384 + (row & 63) * 256 + (col & 255); }
constexpr float R_EPS = 1e-6f;

typedef __bf16 bf16x2_t __attribute__((ext_vector_type(2)));
__device__ __forceinline__ unsigned pkbf(float lo, float hi) { const f32x2 v = {lo, hi}; const bf16x2_t b = __builtin_convertvector(v, bf16x2_t); return __builtin_bit_cast(unsigned, b); }
__device__ __forceinline__ int otid() { int t = threadIdx.x; asm volatile("" : "+v"(t)); return t; }
__device__ __forceinline__ float bflo(unsigned u) { return __builtin_bit_cast(float, u << 16); }
__device__ __forceinline__ float bfhi(unsigned u) { return __builtin_bit_cast(float, u & 0xffff0000u); }

template <int DK> struct Lay {
    static constexpr int NP = DK / 2, NSEG = 512 / NP, TL = 64 / NSEG, SEGREF = 32 / TL - 1, NDT = DK / 16, NKS = DK / 32;
    static constexpr int PK = DK * 2 + 32, PV = 288, PP = 160, PO = 528;
    static constexpr int OFF_Q = 0, OFF_K = OFF_Q + 64 * PK, OFF_KH = OFF_K + 64 * PK, OFF_V = OFF_KH + 64 * PK, OFF_P = OFF_V + 64 * PV, OFF_O = OFF_P + 64 * PP,
                         OFF_SEG = OFF_O + 64 * PO, OFF_D = OFF_SEG + NSEG * DK * 4, OFF_E = OFF_D + DK * 4, OFF_END = OFF_E + DK * 4;
    static_assert(OFF_END <= 131072, "recurrence LDS map");
};

__device__ __forceinline__ bf16x8 tr_frag(RLAS unsigned char* img, int pitch, int k0, int n0, int lane) {
    const int g = lane >> 4, q = (lane & 15) >> 2, p = lane & 3;
    RLAS unsigned char* a = img + (k0 + 8 * g + q) * pitch + n0 * 2 + 8 * p;
    const s16x4 lo = __builtin_amdgcn_ds_read_tr16_b64_v4i16((RLAS s16x4*)a);
    const s16x4 hi = __builtin_amdgcn_ds_read_tr16_b64_v4i16((RLAS s16x4*)(a + 4 * pitch));
    return __builtin_shufflevector(lo, hi, 0, 1, 2, 3, 4, 5, 6, 7);
}

struct HeadIo {
    const bf16* P; const float* GA; bf16* MIX;
    int qoff, koff, voff, goff, ooff, gaoff;
    const float* onorm; float lb0, lb1;
};

#define REC_BAR() do { asm volatile("s_waitcnt lgkmcnt(0)" ::: "memory"); __builtin_amdgcn_s_barrier(); asm volatile("" ::: "memory"); } while (0)

template <int DK, bool HG, bool DO_OUT> struct Raw { unsigned q2[Lay<DK>::TL], k2[Lay<DK>::TL]; f32x2 av[Lay<DK>::TL]; u32x4 v0, v1, g0, g1; };

template <int DK, bool HG, bool DO_OUT>
__device__ __forceinline__ void load_raw(const HeadIo& io, size_t row0, int tvalid, Raw<DK, HG, DO_OUT>& w) {
    typedef Lay<DK> L;
    const int tid = otid(), dp = tid % L::NP, seg = tid / L::NP;
#pragma unroll
    for (int tt = 0; tt < L::TL; ++tt) {
        const int t = seg * L::TL + tt; const size_t row = row0 + t; const bool ok = t < tvalid;
        if (DO_OUT) w.q2[tt] = ok ? *(const unsigned*)pat(io.P, row, io.qoff + 2 * dp) : 0u;
        w.k2[tt] = ok ? *(const unsigned*)pat(io.P, row, io.koff + 2 * dp) : 0u;
        if (!HG) w.av[tt] = ok ? *(const f32x2*)(io.GA + row * 256 + io.gaoff + 2 * dp) : (f32x2){1.f, 1.f};
    }
    const int vr = tid >> 3, vc = (tid & 7) * 16; const bool vok = vr < tvalid;
    w.v0 = (u32x4){0u, 0u, 0u, 0u}; w.v1 = w.v0; w.g0 = w.v0; w.g1 = w.v0;
    if (vok) { const u32x4* src = (const u32x4*)pat(io.P, row0 + vr, io.voff + vc); w.v0 = src[0]; w.v1 = src[1];
        if (DO_OUT) { const u32x4* gp = (const u32x4*)pat(io.P, row0 + vr, io.goff + vc); w.g0 = gp[0]; w.g1 = gp[1]; } }
}

template <int DK, bool HG, bool DO_OUT>
__device__ __forceinline__ void chunk(RLAS unsigned char* lds, const HeadIo& io, const Raw<DK, HG, DO_OUT>& w, size_t row0, int tvalid, f32x4 (&S)[DK / 16], float& dtot) {
    typedef Lay<DK> L;
    const int tid = otid(), lane = tid & 63, wave = tid >> 6, r = lane & 15, g = lane >> 4, e0 = 16 * wave;
    const int dp = tid % L::NP, seg = tid / L::NP;
    {
        const int vr = tid >> 3, vc = (tid & 7) * 16;
        RLAS u32x4* dst = (RLAS u32x4*)(lds + L::OFF_V + vr * L::PV + vc * 2); dst[0] = w.v0; dst[1] = w.v1;
    }
    f32x2 kk[L::TL], pr[L::TL];
    const f32x2 lbv = {io.lb0, io.lb1}, oml = {1.f - io.lb0, 1.f - io.lb1};
#pragma unroll
    for (int tt = 0; tt < L::TL; ++tt) {
        if (HG) {
            const bool ok = seg * L::TL + tt < tvalid;
            f32x2 z = {bflo(w.k2[tt]), bfhi(w.k2[tt])}; z = __builtin_elementwise_min(__builtin_elementwise_max(z, (f32x2){-30.f, -30.f}), (f32x2){30.f, 30.f});
            const f32x2 x = z * -1.4426950408889634f; f32x2 e, s; e.x = __builtin_amdgcn_exp2f(x.x); e.y = __builtin_amdgcn_exp2f(x.y);
            const f32x2 den = e + 1.0f; s.x = __builtin_amdgcn_rcpf(den.x); s.y = __builtin_amdgcn_rcpf(den.y);
            kk[tt] = ok ? oml * (e * s) : (f32x2){0.f, 0.f};
            pr[tt] = ok ? lbv + oml * s : (f32x2){1.f, 1.f};
        } else { kk[tt] = (f32x2){bflo(w.k2[tt]), bfhi(w.k2[tt])}; pr[tt] = w.av[tt]; }
    }
#pragma unroll
    for (int tt = 1; tt < L::TL; ++tt) pr[tt] *= pr[tt - 1];
    *(RLAS f32x2*)(lds + L::OFF_SEG + (seg * DK + 2 * dp) * 4) = pr[L::TL - 1];
    REC_BAR();
    f32x2 off = {1.f, 1.f}, aref = {1.f, 1.f}, alast = {1.f, 1.f};
#pragma unroll
    for (int s = 0; s < L::NSEG; ++s) { const f32x2 v = *(RLAS f32x2*)(lds + L::OFF_SEG + (s * DK + 2 * dp) * 4); if (s < seg) off *= v; if (s <= L::SEGREF) aref *= v; alast *= v; }
    f32x2 ir; ir.x = __builtin_amdgcn_rcpf(aref.x); ir.y = __builtin_amdgcn_rcpf(aref.y);
#pragma unroll
    for (int tt = 0; tt < L::TL; ++tt) {
        const int t = seg * L::TL + tt; const f32x2 at = off * pr[tt];
        f32x2 inv; inv.x = __builtin_amdgcn_rcpf(at.x); inv.y = __builtin_amdgcn_rcpf(at.y);
        if (DO_OUT) {
            const f32x2 qv = (f32x2){bflo(w.q2[tt]), bfhi(w.q2[tt])} * (at * ir), kv = kk[tt] * (inv * aref);
            *(RLAS unsigned*)(lds + L::OFF_Q + t * L::PK + 4 * dp) = pkbf(qv.x, qv.y);
            *(RLAS unsigned*)(lds + L::OFF_K + t * L::PK + 4 * dp) = pkbf(kv.x, kv.y);
        }
        const f32x2 kh = kk[tt] * (inv * alast);
        *(RLAS unsigned*)(lds + L::OFF_KH + t * L::PK + 4 * dp) = pkbf(kh.x, kh.y);
    }
    if (seg == 0) { *(RLAS f32x2*)(lds + L::OFF_D + 8 * dp) = alast; *(RLAS f32x2*)(lds + L::OFF_E + 8 * dp) = aref; }
    REC_BAR();
    if (tid < DK) dtot *= *(RLAS float*)(lds + L::OFF_D + 4 * tid);
    __builtin_amdgcn_s_setprio(1);
    f32x4 O[4];
    if (DO_OUT) {
        const int it = wave >> 1, jt0 = 2 * (wave & 1);
        {
            bf16x8 qf[L::NKS], kf[2][L::NKS];
#pragma unroll
            for (int s = 0; s < L::NKS; ++s) {
                qf[s] = *(RLAS bf16x8*)(lds + L::OFF_Q + (16 * it + r) * L::PK + (32 * s + 8 * g) * 2);
#pragma unroll
                for (int jj = 0; jj < 2; ++jj) kf[jj][s] = *(RLAS bf16x8*)(lds + L::OFF_K + (16 * (jt0 + jj) + r) * L::PK + (32 * s + 8 * g) * 2);
            }
            __builtin_amdgcn_sched_barrier(0);
            f32x4 acc[2] = {{0.f, 0.f, 0.f, 0.f}, {0.f, 0.f, 0.f, 0.f}};
#pragma unroll
            for (int s = 0; s < L::NKS; ++s)
#pragma unroll
                for (int jj = 0; jj < 2; ++jj) acc[jj] = __builtin_amdgcn_mfma_f32_16x16x32_bf16(kf[jj][s], qf[s], acc[jj], 0, 0, 0);
#pragma unroll
            for (int jj = 0; jj < 2; ++jj) {
                const int i = 16 * it + r, j = 16 * (jt0 + jj) + 4 * g;
                u32x2 pw; pw.x = pkbf(j <= i ? acc[jj][0] : 0.f, j + 1 <= i ? acc[jj][1] : 0.f); pw.y = pkbf(j + 2 <= i ? acc[jj][2] : 0.f, j + 3 <= i ? acc[jj][3] : 0.f);
                *(RLAS u32x2*)(lds + L::OFF_P + i * L::PP + j * 2) = pw;
            }
        }
        {
            s16x4 qlo[L::NKS][4], qhi[L::NKS][4]; f32x4 ea[L::NKS], eb[L::NKS];
#pragma unroll
            for (int s = 0; s < L::NKS; ++s) {
                ea[s] = *(RLAS f32x4*)(lds + L::OFF_E + (32 * s + 4 * g) * 4); eb[s] = *(RLAS f32x4*)(lds + L::OFF_E + (32 * s + 16 + 4 * g) * 4);
#pragma unroll
                for (int m = 0; m < 4; ++m) { qlo[s][m] = *(RLAS s16x4*)(lds + L::OFF_Q + (16 * m + r) * L::PK + (32 * s + 4 * g) * 2); qhi[s][m] = *(RLAS s16x4*)(lds + L::OFF_Q + (16 * m + r) * L::PK + (32 * s + 16 + 4 * g) * 2); }
            }
            __builtin_amdgcn_sched_barrier(0);
#pragma unroll
            for (int m = 0; m < 4; ++m) O[m] = (f32x4){0.f, 0.f, 0.f, 0.f};
#pragma unroll
            for (int s = 0; s < L::NKS; ++s) {
                const f32x4 sa = S[2 * s] * ea[s], sb = S[2 * s + 1] * eb[s];
                u32x4 sp; sp.x = pkbf(sa[0], sa[1]); sp.y = pkbf(sa[2], sa[3]); sp.z = pkbf(sb[0], sb[1]); sp.w = pkbf(sb[2], sb[3]);
                const bf16x8 sf = __builtin_bit_cast(bf16x8, sp);
#pragma unroll
                for (int m = 0; m < 4; ++m) O[m] = __builtin_amdgcn_mfma_f32_16x16x32_bf16(__builtin_shufflevector(qlo[s][m], qhi[s][m], 0, 1, 2, 3, 4, 5, 6, 7), sf, O[m], 0, 0, 0);
            }
        }
        REC_BAR();
    }
    const bf16x8 vf0 = tr_frag(lds + L::OFF_V, L::PV, 0, e0, lane), vf1 = tr_frag(lds + L::OFF_V, L::PV, 32, e0, lane);
    if (DO_OUT) {
        bf16x8 p0[4], p1[4];
#pragma unroll
        for (int m = 0; m < 4; ++m) { p0[m] = *(RLAS bf16x8*)(lds + L::OFF_P + (16 * m + r) * L::PP + (8 * g) * 2); p1[m] = *(RLAS bf16x8*)(lds + L::OFF_P + (16 * m + r) * L::PP + (32 + 8 * g) * 2); }
        __builtin_amdgcn_sched_barrier(0);
#pragma unroll
        for (int m = 0; m < 4; ++m) O[m] = __builtin_amdgcn_mfma_f32_16x16x32_bf16(p0[m], vf0, O[m], 0, 0, 0);
#pragma unroll
        for (int m = 0; m < 4; ++m) O[m] = __builtin_amdgcn_mfma_f32_16x16x32_bf16(p1[m], vf1, O[m], 0, 0, 0);
    }
#pragma unroll
    for (int d0 = 0; d0 < L::NDT; d0 += 4) {
        bf16x8 k0[4], k1[4]; f32x4 dv[4];
#pragma unroll
        for (int q = 0; q < 4; ++q) { dv[q] = *(RLAS f32x4*)(lds + L::OFF_D + (16 * (d0 + q) + 4 * g) * 4);
            k0[q] = tr_frag(lds + L::OFF_KH, L::PK, 0, 16 * (d0 + q), lane); k1[q] = tr_frag(lds + L::OFF_KH, L::PK, 32, 16 * (d0 + q), lane); }
        __builtin_amdgcn_sched_barrier(0);
#pragma unroll
        for (int q = 0; q < 4; ++q) S[d0 + q] = __builtin_amdgcn_mfma_f32_16x16x32_bf16(k0[q], vf0, S[d0 + q] * dv[q], 0, 0, 0);
#pragma unroll
        for (int q = 0; q < 4; ++q) S[d0 + q] = __builtin_amdgcn_mfma_f32_16x16x32_bf16(k1[q], vf1, S[d0 + q], 0, 0, 0);
    }
    __builtin_amdgcn_s_setprio(0);
    if (DO_OUT) {
#pragma unroll
        for (int m = 0; m < 4; ++m)
#pragma unroll
            for (int ii = 0; ii < 4; ++ii) *(RLAS float*)(lds + L::OFF_O + (16 * m + 4 * g + ii) * L::PO + (e0 + r) * 4) = O[m][ii];
        REC_BAR();
        const int orow = tid >> 3, oc = (tid & 7) * 16;
        f32x4 ov[4]; float ss = 0.f;
#pragma unroll
        for (int c = 0; c < 4; ++c) { ov[c] = *(RLAS f32x4*)(lds + L::OFF_O + orow * L::PO + (oc + 4 * c) * 4); ss += (ov[c][0] * ov[c][0] + ov[c][1] * ov[c][1]) + (ov[c][2] * ov[c][2] + ov[c][3] * ov[c][3]); }
        ss += __shfl_xor(ss, 1); ss += __shfl_xor(ss, 2); ss += __shfl_xor(ss, 4);
        const float rs = rsqrtf(ss * (1.0f / 128.0f) + R_EPS);
        if (orow < tvalid) {
            const size_t row = row0 + orow;
            const unsigned gw[8] = {w.g0.x, w.g0.y, w.g0.z, w.g0.w, w.g1.x, w.g1.y, w.g1.z, w.g1.w};
            unsigned ow[8];
#pragma unroll
            for (int c = 0; c < 8; ++c) {
                const f32x2 gg = {bflo(gw[c]), bfhi(gw[c])}, x = gg * -1.4426950408889634f; f32x2 e, sg_; e.x = __builtin_amdgcn_exp2f(x.x); e.y = __builtin_amdgcn_exp2f(x.y);
                const f32x2 den = e + 1.0f; sg_.x = __builtin_amdgcn_rcpf(den.x); sg_.y = __builtin_amdgcn_rcpf(den.y);
                const f32x2 ovv = {ov[c >> 1][(c & 1) * 2], ov[c >> 1][(c & 1) * 2 + 1]}, on = *(const f32x2*)(io.onorm + oc + 2 * c);
                const f32x2 o = (ovv * rs) * on * (gg * sg_);
                ow[c] = pkbf(o.x, o.y);
            }
            u32x4* op = (u32x4*)(io.MIX + row * DM + io.ooff + oc);
            op[0] = (u32x4){ow[0], ow[1], ow[2], ow[3]}; op[1] = (u32x4){ow[4], ow[5], ow[6], ow[7]};
        }
    } else {
        REC_BAR();
    }
}

template <int NDT> __device__ __forceinline__ void load_state(f32x4 (&S)[NDT], const float* mem) {
    const int tid_ = otid(), lane = tid_ & 63, wave = tid_ >> 6, r = lane & 15, g = lane >> 4;
#pragma unroll
    for (int dt = 0; dt < NDT; ++dt)
#pragma unroll
        for (int i = 0; i < 4; ++i) S[dt][i] = mem ? mem[(16 * dt + 4 * g + i) * 128 + 16 * wave + r] : 0.f;
}
template <int NDT> __device__ __forceinline__ void store_state(const f32x4 (&S)[NDT], float* mem) {
    const int tid_ = otid(), lane = tid_ & 63, wave = tid_ >> 6, r = lane & 15, g = lane >> 4;
#pragma unroll
    for (int dt = 0; dt < NDT; ++dt)
#pragma unroll
        for (int i = 0; i < 4; ++i) mem[(16 * dt + 4 * g + i) * 128 + 16 * wave + r] = S[dt][i];
}

struct RecArgs {
    const bf16* P; const float* GA; bf16* MIX; const float* lbl; const float* gla_onorm; const float* hg_onorm;
    const float* st_gla_in; const float* st_hg_in; float* ST; float* DT; float* out_sgp; float* out_shp; float* out_sgs; float* out_shs;
};
constexpr int SC_TOK = 512, NCH = SC_TOK / 64, NSC = 8192 / SC_TOK, ST_PER = 4 * 64 * 128 + 4 * 128 * 128, DT_PER = 4 * 64 + 4 * 128;

template <int DK, bool HG> __device__ __forceinline__ HeadIo make_io(const RecArgs& a, int h) {
    HeadIo io; io.P = a.P; io.GA = a.GA; io.MIX = a.MIX;
    if (HG) { io.qoff = 1536 + h * 128; io.koff = 2048 + h * 128; io.voff = 2560 + h * 128; io.goff = 3072 + h * 128; io.ooff = 512 + h * 128; io.gaoff = 0; io.onorm = a.hg_onorm;
        const int d = 2 * (otid() % (DK / 2)); const float l0 = a.lbl[h * 128 + d], l1 = a.lbl[512 + h * 128 + d], m0 = a.lbl[h * 128 + d + 1], m1 = a.lbl[512 + h * 128 + d + 1];
        io.lb0 = 1.0f / (1.0f + __expf(l1 - l0)); io.lb1 = 1.0f / (1.0f + __expf(m1 - m0)); }
    else { io.qoff = h * 64; io.koff = 256 + h * 64; io.voff = 512 + h * 128; io.goff = 1024 + h * 128; io.ooff = h * 128; io.gaoff = h * 64; io.onorm = a.gla_onorm; io.lb0 = 0.f; io.lb1 = 0.f; }
    return io;
}

template <int DK, bool HG> __device__ __forceinline__ void r1_unit(RLAS unsigned char* lds, const RecArgs& a, int seq, int sc, int h) {
    const HeadIo io = make_io<DK, HG>(a, h);
    f32x4 S[DK / 16]; load_state<DK / 16>(S, nullptr); float dtot = 1.f;
    const size_t rb = (size_t)seq * 8192 + sc * SC_TOK;
    Raw<DK, HG, false> cur, nxt; load_raw<DK, HG, false>(io, rb, 64, cur);
#pragma unroll 1
    for (int c = 0; c < NCH; ++c) { if (c + 1 < NCH) load_raw<DK, HG, false>(io, rb + (c + 1) * 64, 64, nxt); chunk<DK, HG, false>(lds, io, cur, rb + c * 64, 64, S, dtot); cur = nxt; }
    const size_t u = (size_t)seq * NSC + sc;
    store_state<DK / 16>(S, a.ST + u * ST_PER + (HG ? 32768 + h * 16384 : h * 8192));
    { const int t_ = otid(); if (t_ < DK) a.DT[u * DT_PER + (HG ? 256 + h * 128 : h * 64) + t_] = dtot; }
}
template <int DK, bool HG> __device__ __forceinline__ void r3_unit(RLAS unsigned char* lds, const RecArgs& a, int seq, int sc, int h) {
    const HeadIo io = make_io<DK, HG>(a, h);
    const size_t u = (size_t)seq * NSC + sc;
    f32x4 S[DK / 16]; load_state<DK / 16>(S, a.ST + u * ST_PER + (HG ? 32768 + h * 16384 : h * 8192)); float dtot = 1.f;
    const size_t rb = (size_t)seq * 8192 + sc * SC_TOK;
    Raw<DK, HG, true> cur, nxt; load_raw<DK, HG, true>(io, rb, 64, cur);
#pragma unroll 1
    for (int c = 0; c < NCH; ++c) { if (c + 1 < NCH) load_raw<DK, HG, true>(io, rb + (c + 1) * 64, 64, nxt); chunk<DK, HG, true>(lds, io, cur, rb + c * 64, 64, S, dtot); cur = nxt; }
    if (sc == NSC - 1) store_state<DK / 16>(S, (HG ? a.out_shp : a.out_sgp) + (size_t)(seq * 4 + h) * DK * 128);
}
template <int DK, bool HG> __device__ __forceinline__ void rs_unit(RLAS unsigned char* lds, const RecArgs& a, int seq, int h) {
    const HeadIo io = make_io<DK, HG>(a, h);
    f32x4 S[DK / 16]; load_state<DK / 16>(S, (HG ? a.st_hg_in : a.st_gla_in) + (size_t)(seq * 4 + h) * DK * 128); float dtot = 1.f;
    Raw<DK, HG, true> cur; load_raw<DK, HG, true>(io, (size_t)32768 + seq * 32, 32, cur);
    chunk<DK, HG, true>(lds, io, cur, (size_t)32768 + seq * 32, 32, S, dtot);
    store_state<DK / 16>(S, (HG ? a.out_shs : a.out_sgs) + (size_t)(seq * 4 + h) * DK * 128);
}
__device__ __forceinline__ void decode_unit(int u, int& scidx, int& head) { scidx = u >> 3; head = ((u & 7) + 4 * ((u >> 8) & 1)) & 7; }

__device__ __forceinline__ void sample_units(RLAS unsigned char* lds, const RecArgs& a, int first, int step) {
    for (int u = first; u < 64; u += step) { const int seq = u >> 3, head = u & 7;
        if (head < 4) rs_unit<64, false>(lds, a, seq, head); else rs_unit<128, true>(lds, a, seq, head - 4); }
}
__device__ __forceinline__ void phase_r1(RLAS unsigned char* lds, const RecArgs& a, int G, int bx) {
    for (int u = bx; u < 4 * NSC * 8; u += G) { int scidx, head; decode_unit(u, scidx, head); const int seq = scidx / NSC, sc = scidx % NSC;
        if (sc == NSC - 1) continue;
        if (head < 4) r1_unit<64, false>(lds, a, seq, sc, head); else r1_unit<128, true>(lds, a, seq, sc, head - 4); }
    if (G == 256 && NSC == 16 && (bx & 127) >= 120) sample_units(lds, a, ((bx >> 7) << 3) + (bx & 7), 16);
}
__device__ __forceinline__ void phase_r2(const RecArgs& a, int gtid, int NGT) {
    for (int idx = gtid; idx < ST_PER; idx += NGT) {
        const int seq = idx / (ST_PER / 4), off = (idx % (ST_PER / 4)) * 4; int dti;
        if (off < 32768) dti = (off / 8192) * 64 + (off % 8192) / 128; else { const int o2 = off - 32768; dti = 256 + (o2 / 16384) * 128 + (o2 % 16384) / 128; }
        float* st = a.ST + (size_t)seq * NSC * ST_PER + off; const float* dt = a.DT + (size_t)seq * NSC * DT_PER + dti;
        f32x4 t[NSC - 1]; float dd[NSC - 1];
#pragma unroll
        for (int s = 0; s < NSC - 1; ++s) { t[s] = *(const f32x4*)(st + (size_t)s * ST_PER); dd[s] = dt[(size_t)s * DT_PER]; }
        f32x4 x = {0.f, 0.f, 0.f, 0.f};
#pragma unroll
        for (int s = 0; s < NSC; ++s) { *(f32x4*)(st + (size_t)s * ST_PER) = x; if (s < NSC - 1) x = x * dd[s] + t[s]; }
    }
}
__device__ __forceinline__ void phase_r3(RLAS unsigned char* lds, const RecArgs& a, int G, int bx) {
    for (int u = bx; u < 4 * NSC * 8; u += G) { int scidx, head; decode_unit(u, scidx, head); const int seq = scidx / NSC, sc = scidx % NSC;
        if (head < 4) r3_unit<64, false>(lds, a, seq, sc, head); else r3_unit<128, true>(lds, a, seq, sc, head - 4); }
    if (!(G == 256 && NSC == 16)) sample_units(lds, a, bx, G);
}
}
namespace sg {
typedef unsigned short bf16;
typedef short bf16x8 __attribute__((ext_vector_type(8)));
typedef float f32x4 __attribute__((ext_vector_type(4)));
typedef unsigned u32x2 __attribute__((ext_vector_type(2)));
typedef unsigned u32x4 __attribute__((ext_vector_type(4)));
__device__ __forceinline__ int otid() { int t = threadIdx.x; asm volatile("" : "+v"(t)); return t; }
__device__ __forceinline__ unsigned pkbf(float lo, float hi) { return rec::pkbf(lo, hi); }
__device__ __forceinline__ float silu_f(float g) { return g * __builtin_amdgcn_rcpf(1.0f + __expf(-g)); }

constexpr int SPITCH = 272, WREG = 64 * SPITCH;
template <int NT, class Epi>
__device__ __forceinline__ void unit(__attribute__((address_space(3))) unsigned char* lds, const bf16* A, int K, const bf16* bt0, const bf16* bt1, const Epi& E) {
    typedef __attribute__((address_space(3))) unsigned char* lptr;
    const int tid = otid(), lane = tid & 63, wave = tid >> 6, r = lane & 15, g = lane >> 4;
    constexpr int NL = 8 + 4 * NT;
    const lptr img = lds + wave * WREG;
    const bf16* gp[NL];
#pragma unroll
    for (int j = 0; j < NL; ++j) { const int row = 4 * j + g;
        const bf16* base = (j < 8) ? A + (size_t)(32 * wave + row) * K : (j < 12 ? bt0 + (size_t)(row - 32) * K : bt1 + (size_t)(row - 48) * K);
        gp[j] = base + 8 * r; }
    const lptr wp = img + g * SPITCH + 16 * r;
    f32x4 acc[2][NT];
#pragma unroll
    for (int mt = 0; mt < 2; ++mt)
#pragma unroll
        for (int nt = 0; nt < NT; ++nt) acc[mt][nt] = (f32x4){0.f, 0.f, 0.f, 0.f};
    u32x4 st[NL];
    const int nb = K / 128;
#pragma unroll
    for (int j = 0; j < NL; ++j) st[j] = *(const u32x4*)(gp[j]);
#pragma unroll 1
    for (int b = 0; b < nb; ++b) {
#pragma unroll
        for (int j = 0; j < NL; ++j) *(__attribute__((address_space(3))) u32x4*)(wp + 4 * j * SPITCH) = st[j];
        if (b + 1 < nb) {
#pragma unroll
            for (int j = 0; j < NL; ++j) st[j] = *(const u32x4*)(gp[j] + (size_t)(b + 1) * 128);
        }
        asm volatile("s_waitcnt lgkmcnt(0)" ::: "memory");
#pragma unroll
        for (int u = 0; u < 4; ++u) {
            bf16x8 af[2], bfr[NT];
#pragma unroll
            for (int mt = 0; mt < 2; ++mt) af[mt] = *(const __attribute__((address_space(3))) bf16x8*)(img + (16 * mt + r) * SPITCH + (4 * u + g) * 16);
#pragma unroll
            for (int nt = 0; nt < NT; ++nt) bfr[nt] = *(const __attribute__((address_space(3))) bf16x8*)(img + (32 + 16 * nt + r) * SPITCH + (4 * u + g) * 16);
#pragma unroll
            for (int mt = 0; mt < 2; ++mt)
#pragma unroll
                for (int nt = 0; nt < NT; ++nt) acc[mt][nt] = __builtin_amdgcn_mfma_f32_16x16x32_bf16(bfr[nt], af[mt], acc[mt][nt], 0, 0, 0);
        }
        asm volatile("s_waitcnt lgkmcnt(0)" ::: "memory");
    }
    E(acc, wave, r, g);
}

constexpr int SPITCH2 = 528;
template <class Epi>
__device__ __forceinline__ void unit_k256(__attribute__((address_space(3))) unsigned char* lds, const bf16* A, int K, const bf16* bt, const Epi& E) {
    typedef __attribute__((address_space(3))) unsigned char* lptr;
    const int tid = otid(), lane = tid & 63, wave = tid >> 6, r = lane & 15, g = lane >> 4, hr = lane >> 5, ch = lane & 31;
    const lptr img = lds + wave * (32 * SPITCH2);
    const bf16* gp[16];
#pragma unroll
    for (int j = 0; j < 16; ++j) { const int row = 2 * j + hr; gp[j] = ((j < 8) ? A + (size_t)(16 * wave + row) * K : bt + (size_t)(row - 16) * K) + 8 * ch; }
    const lptr wp = img + hr * SPITCH2 + 16 * ch;
    f32x4 acc = {0.f, 0.f, 0.f, 0.f};
    u32x4 st[16];
    const int nb = K / 256;
#pragma unroll
    for (int j = 0; j < 16; ++j) st[j] = *(const u32x4*)(gp[j]);
#pragma unroll 1
    for (int b = 0; b < nb; ++b) {
#pragma unroll
        for (int j = 0; j < 16; ++j) *(__attribute__((address_space(3))) u32x4*)(wp + 2 * j * SPITCH2) = st[j];
        if (b + 1 < nb) {
#pragma unroll
            for (int j = 0; j < 16; ++j) st[j] = *(const u32x4*)(gp[j] + (size_t)(b + 1) * 256);
        }
        asm volatile("s_waitcnt lgkmcnt(0)" ::: "memory");
        bf16x8 af[8], bfr[8];
#pragma unroll
        for (int u = 0; u < 8; ++u) { af[u] = *(const __attribute__((address_space(3))) bf16x8*)(img + r * SPITCH2 + (4 * u + g) * 16);
            bfr[u] = *(const __attribute__((address_space(3))) bf16x8*)(img + (16 + r) * SPITCH2 + (4 * u + g) * 16); }
#pragma unroll
        for (int u = 0; u < 8; ++u) acc = __builtin_amdgcn_mfma_f32_16x16x32_bf16(bfr[u], af[u], acc, 0, 0, 0);
        asm volatile("s_waitcnt lgkmcnt(0)" ::: "memory");
    }
    E(acc, wave, r, g);
}
struct EpiResS1 {
    bf16* xb; float* ssq; float scale; int c0, rbase;
    __device__ __forceinline__ void operator()(const f32x4& acc, int wave, int r, int g) const {
        const int row = rbase + 16 * wave + r; const size_t off = (size_t)row * 1024 + c0 + 4 * g;
        const u32x2 rb = *(const u32x2*)(xb + off);
        const f32x4 res = {__builtin_bit_cast(float, rb.x << 16), __builtin_bit_cast(float, rb.x & 0xffff0000u), __builtin_bit_cast(float, rb.y << 16), __builtin_bit_cast(float, rb.y & 0xffff0000u)};
        const f32x4 v = res + acc * scale;
        float s = (v[0] * v[0] + v[1] * v[1]) + (v[2] * v[2] + v[3] * v[3]);
        s += __shfl_xor(s, 16); s += __shfl_xor(s, 32);
        if (g == 0) __hip_atomic_fetch_add(ssq + row, s, __ATOMIC_RELAXED, __HIP_MEMORY_SCOPE_AGENT);
        *(u32x2*)(xb + off) = (u32x2){pkbf(v[0], v[1]), pkbf(v[2], v[3])};
    }
};

struct EpiUpS {
    bf16* H; int ldh; const float* ssq; int hc0;
    __device__ __forceinline__ void operator()(const f32x4 (&acc)[2][2], int wave, int r, int g) const {
#pragma unroll
        for (int mt = 0; mt < 2; ++mt) { const int row = 32 * wave + 16 * mt + r; const float rs = rsqrtf(ssq[row] * (1.0f / 1024.0f) + 1e-6f);
            float h[4];
#pragma unroll
            for (int i = 0; i < 4; ++i) h[i] = silu_f(acc[mt][0][i] * rs) * (acc[mt][1][i] * rs);
            *(u32x2*)(H + (size_t)row * ldh + hc0 + 4 * g) = (u32x2){pkbf(h[0], h[1]), pkbf(h[2], h[3])}; }
    }
};
struct EpiResS {
    const float* xf; bf16* xb; float* ssq; float scale; int c0;
    __device__ __forceinline__ void operator()(const f32x4 (&acc)[2][1], int wave, int r, int g) const {
#pragma unroll
        for (int mt = 0; mt < 2; ++mt) { const int row = 32 * wave + 16 * mt + r; const size_t off = (size_t)row * 1024 + c0 + 4 * g; f32x4 res;
            if (xf) res = *(const f32x4*)(xf + off);
            else { const u32x2 rb = *(const u32x2*)(xb + off); res = (f32x4){__builtin_bit_cast(float, rb.x << 16), __builtin_bit_cast(float, rb.x & 0xffff0000u), __builtin_bit_cast(float, rb.y << 16), __builtin_bit_cast(float, rb.y & 0xffff0000u)}; }
            const f32x4 v = res + acc[mt][0] * scale;
            float s = (v[0] * v[0] + v[1] * v[1]) + (v[2] * v[2] + v[3] * v[3]);
            s += __shfl_xor(s, 16); s += __shfl_xor(s, 32);
            if (g == 0) __hip_atomic_fetch_add(ssq + row, s, __ATOMIC_RELAXED, __HIP_MEMORY_SCOPE_AGENT);
            *(u32x2*)(xb + off) = (u32x2){pkbf(v[0], v[1]), pkbf(v[2], v[3])}; }
    }
};
struct EpiWinS {
    bf16* P; float* GA; const float* ssq; const float* gbias; int c0;
    __device__ __forceinline__ void operator()(const f32x4 (&acc)[2][2], int wave, int r, int g) const {
        const int pn = c0 >> 8;
#pragma unroll
        for (int mt = 0; mt < 2; ++mt) { const int row = 32 * wave + 16 * mt + r; const float rs = rsqrtf(ssq[row] * (1.0f / 1024.0f) + 1e-6f);
#pragma unroll
            for (int nt = 0; nt < 2; ++nt) { const int col = c0 + 16 * nt + 4 * g; f32x4 v = acc[mt][nt] * rs;
                if (pn == 14) { const int tc = col & 255; f32x4 o;
#pragma unroll
                    for (int i = 0; i < 4; ++i) { const float x = v[i] + gbias[tc + i]; const float ls = fminf(x, 0.f) - __logf(1.0f + __expf(-fabsf(x))); o[i] = __expf(ls * 0.0625f); }
                    *(f32x4*)(GA + (size_t)row * 256 + tc) = o;
                } else {
                    if (pn == 0) v = v * 0.125f;
                    else if (pn == 6 || pn == 7) { v[0] = silu_f(v[0]); v[1] = silu_f(v[1]); v[2] = silu_f(v[2]); v[3] = silu_f(v[3]); }
                    *(u32x2*)(P + ((size_t)(row >> 6) * 14 + (col >> 8)) * 16384 + (row & 63) * 256 + (col & 255)) = (u32x2){pkbf(v[0], v[1]), pkbf(v[2], v[3])};
                } } }
    }
};
}
#define GAS __attribute__((address_space(1)))
#define LAS __attribute__((address_space(3)))
typedef unsigned short bf16;
typedef unsigned v4u __attribute__((ext_vector_type(4)));
typedef float f32x4 __attribute__((ext_vector_type(4)));
constexpr int NWAVES = 8;
constexpr int D = 1024, FF = 2816, MP = 32768, MS = 256, M = MP + MS, PW = 3584, NIN = 3840, DINSRC = 3600;
constexpr float EPS = 1e-6f;
constexpr size_t MiB = 1u << 20;
constexpr size_t WS_SSQ = 0, SSQ_STRIDE = (size_t)M * 4;
constexpr size_t WS_BAR = 768 * 1024, BAR_BYTES = 16384;
constexpr int MISC_OFF = 147456 - 64;
constexpr size_t WS_WGU1 = 1 * MiB, WS_WD1 = 12 * MiB, WS_WIN = 18 * MiB, WS_WO = 26 * MiB, WS_WGU2 = 28 * MiB, WS_WD2 = 39 * MiB;
constexpr size_t WS_XB = 45 * MiB, WS_MIX = 110 * MiB, WS_P = 175 * MiB, WS_HID = WS_P, WS_GA = 401 * MiB, WS_ST = 434 * MiB, WS_DT = 483 * MiB, WS_DUMMY = 484 * MiB, WS_END = 512 * MiB;
static_assert(WS_P + (size_t)M * PW * 2 <= WS_GA && WS_GA + (size_t)M * 256 * 4 <= WS_ST && WS_XB + (size_t)M * D * 2 <= WS_MIX && WS_MIX + (size_t)M * D * 2 <= WS_P, "ws map");
constexpr size_t O_Y = 0, O_SGP = (size_t)M * D, O_SHP = O_SGP + 4 * 4 * 64 * 128, O_SGS = O_SHP + 4 * 4 * 128 * 128, O_SHS = O_SGS + 8 * 4 * 64 * 128, O_END = O_SHS + 8 * 4 * 128 * 128;
constexpr int LDS_BYTES = 147456;

__device__ __forceinline__ unsigned f2bf(float f) { unsigned u = __builtin_bit_cast(unsigned, f); return (u + 0x7fffu + ((u >> 16) & 1u)) >> 16; }
__device__ __forceinline__ unsigned pk2(float lo, float hi) { return f2bf(lo) | (f2bf(hi) << 16); }
__device__ __forceinline__ float bf2f(bf16 b) { return __builtin_bit_cast(float, (unsigned)b << 16); }
#define LDS_WAIT() asm volatile("s_waitcnt lgkmcnt(0)" ::: "memory")

#define XB_TMO      128
#define XB_XCNT(j)  (256  + 64 * (j))
#define XB_XSUB(j)  (1280 + 64 * (j))
#define XB_XGEN(j)  (2304 + 64 * (j))
#define XB_TOP      3328
#define XB_TOPGEN   3392
#define XCD_BAR_WORDS 3456
#define XB_SPIN_CAP (1u << 18)

__device__ __forceinline__ unsigned xb_ld(unsigned* p)              { return __hip_atomic_load(p, __ATOMIC_RELAXED, __HIP_MEMORY_SCOPE_AGENT); }
__device__ __forceinline__ unsigned xb_add(unsigned* p, unsigned v) { return __hip_atomic_fetch_add(p, v, __ATOMIC_RELAXED, __HIP_MEMORY_SCOPE_AGENT); }
__device__ __forceinline__ unsigned xb_xcc_id() { return (unsigned)__builtin_amdgcn_s_getreg((3 << 11) | 20) & 0xFu; }
#define XB_SPIN(cond, bar) do { unsigned _sp = 0; while (cond) { __builtin_amdgcn_s_sleep(1); \
    if ((++_sp & 255u) == 0u) { if (xb_ld(&(bar)[XB_TMO])) break; if (_sp > XB_SPIN_CAP) { atomicAdd(&(bar)[XB_TMO], 1u); break; } } } } while (0)

struct XcdBarrier {
    unsigned* bar; unsigned x;
    volatile LAS unsigned* st;
};

__device__ __forceinline__ XcdBarrier xcd_barrier_post(unsigned* bar, volatile LAS unsigned* st) {
    XcdBarrier b; b.bar = bar; b.x = xb_xcc_id(); b.st = st;
    if (threadIdx.x == 0) (void)xb_add(&bar[XB_XCNT(b.x)], 1u);
    return b;
}
__device__ __forceinline__ void xcd_barrier_complete(unsigned* bar, unsigned x, unsigned& nloc, unsigned& nx) {
    const unsigned G = gridDim.x * gridDim.y * gridDim.z;
    unsigned sum, cnt, mine, sp = 0u;
    for (;;) {
        sum = 0u; cnt = 0u; mine = 0u;
#pragma unroll
        for (unsigned j = 0; j < 16; ++j) { const unsigned c = xb_ld(&bar[XB_XCNT(j)]); sum += c; cnt += (c > 0u) ? 1u : 0u; mine = (j == x) ? c : mine; }
        if (sum == G) break;
        __builtin_amdgcn_s_sleep(1);
        if ((++sp & 255u) == 0u) { if (xb_ld(&bar[XB_TMO])) break; if (sp > XB_SPIN_CAP) { atomicAdd(&bar[XB_TMO], 1u); break; } }
    }
    nloc = mine > 0u ? mine : 1u; nx = cnt > 0u ? cnt : 1u;
}

__device__ __forceinline__ void xcd_barrier(const XcdBarrier& b) {
    asm volatile("s_waitcnt vmcnt(0)" ::: "memory");
    __syncthreads();
    if (threadIdx.x == 0) {
        unsigned* bar = b.bar;
        __builtin_amdgcn_s_waitcnt(0);
        unsigned nloc = b.st[0], nx = b.st[1];
        if (nloc == 0u) { xcd_barrier_complete(bar, b.x, nloc, nx); b.st[0] = nloc; b.st[1] = nx; }
        const unsigned old = xb_add(&bar[XB_XSUB(b.x)], 1u);
        const unsigned gen = old / nloc;
        if (old + 1u == (gen + 1u) * nloc) {
            __builtin_amdgcn_fence(__ATOMIC_RELEASE, "agent");
            asm volatile("s_waitcnt vmcnt(0)" ::: "memory");
            const unsigned og = xb_add(&bar[XB_TOP], 1u);
            const unsigned tg = og / nx;
            if (og + 1u == (tg + 1u) * nx) xb_add(&bar[XB_TOPGEN], 1u);
            else XB_SPIN(xb_ld(&bar[XB_TOPGEN]) == tg, bar);
            __builtin_amdgcn_fence(__ATOMIC_ACQUIRE, "agent");
            xb_add(&bar[XB_XGEN(b.x)], 1u);
            asm volatile("s_waitcnt vmcnt(0)" ::: "memory");
        } else {
            XB_SPIN(xb_ld(&bar[XB_XGEN(b.x)]) == gen, bar);
            __builtin_amdgcn_fence(__ATOMIC_ACQUIRE, "agent");
            asm volatile("s_waitcnt vmcnt(0)" ::: "memory");
        }
    }
    __syncthreads();
}

#ifndef DUPMASK
#define DUPMASK 0
#endif
struct Args { const float* in[21]; float* out; unsigned char* ws; int ph_lo, ph_hi, dup, pad; };
typedef const Args __attribute__((address_space(4))) CArgs;

__device__ __forceinline__ float wave_sum(float v) {
#pragma unroll
    for (int o = 1; o < 64; o <<= 1) v += __shfl_xor(v, o);
    return v;
}
__device__ __forceinline__ void tr_item(const float* W, int ldw, int src_col0, int k0, const float* gain, bf16* WT, int K, int dst_row0, LAS float* scr, int lane) {
    float w[32];
    const float* wp = W + (size_t)(k0 + (lane >> 5)) * ldw + src_col0 + (lane & 31);
#pragma unroll
    for (int i = 0; i < 32; ++i) w[i] = __builtin_nontemporal_load(wp + (size_t)(2 * i) * ldw);
    if (gain) {
#pragma unroll
        for (int i = 0; i < 32; ++i) w[i] *= gain[k0 + 2 * i + (lane >> 5)];
    }
#pragma unroll
    for (int i = 0; i < 32; ++i) scr[(2 * i + (lane >> 5)) * 33 + (lane & 31)] = w[i];
    LDS_WAIT(); asm volatile("" ::: "memory");
    const int c = lane & 7;
#pragma unroll
    for (int j = 0; j < 4; ++j) { const int n = (lane >> 3) + 8 * j; const LAS float* s = scr + (8 * c) * 33 + n;
        v4u o; o.x = pk2(s[0 * 33], s[1 * 33]); o.y = pk2(s[2 * 33], s[3 * 33]); o.z = pk2(s[4 * 33], s[5 * 33]); o.w = pk2(s[6 * 33], s[7 * 33]);
        *(v4u*)(WT + (size_t)(dst_row0 + n) * K + k0 + 8 * c) = o; }
    LDS_WAIT(); asm volatile("" ::: "memory");
}
__device__ __forceinline__ void weff_item(const float* Win, const float* up, int n0, int k0, const float* gain, bf16* WT, LAS float* scr, int lane) {
    float upr[16];
#pragma unroll
    for (int r = 0; r < 16; ++r) upr[r] = up[r * 256 + n0 + (lane & 31)];
#pragma unroll 4
    for (int i = 0; i < 32; ++i) { const int kk = 2 * i + (lane >> 5); const float* wr = Win + (size_t)(k0 + kk) * DINSRC + 1536; float s = 0.f;
#pragma unroll
        for (int r = 0; r < 16; ++r) s += wr[r] * upr[r];
        scr[kk * 33 + (lane & 31)] = s * gain[k0 + kk]; }
    LDS_WAIT(); asm volatile("" ::: "memory");
    const int c = lane & 7;
#pragma unroll
    for (int j = 0; j < 4; ++j) { const int n = (lane >> 3) + 8 * j; const LAS float* s = scr + (8 * c) * 33 + n;
        v4u o; o.x = pk2(s[0 * 33], s[1 * 33]); o.y = pk2(s[2 * 33], s[3 * 33]); o.z = pk2(s[4 * 33], s[5 * 33]); o.w = pk2(s[6 * 33], s[7 * 33]);
        *(v4u*)(WT + (size_t)(3584 + n0 + n) * 1024 + k0 + 8 * c) = o; }
    LDS_WAIT(); asm volatile("" ::: "memory");
}
__device__ __forceinline__ void gu_item(int r, const float* wg, const float* wu, const float* gain, bf16* WT, LAS float* scr, int lane) {
    const int kb = r / 176, nb = r % 176, dst = 32 * nb, tile = dst >> 8, j = dst & 255;
    const float* W = (j < 128) ? wg : wu; const int src = tile * 128 + (j & 127);
    tr_item(W, FF, src, 64 * kb, gain, WT, D, dst, scr, lane);
}

__device__ __forceinline__ int opaque_tid() { int t = threadIdx.x; asm volatile("" : "+v"(t)); return t; }
__device__ __forceinline__ void p0_prologue(CArgs& a, LAS unsigned char* lds, int G, int bx) {
    const int tid = opaque_tid(), lane = tid & 63, wave = __builtin_amdgcn_readfirstlane(tid >> 6);
    const int gw = bx * NWAVES + wave, NGW = G * NWAVES, gtid = bx * (NWAVES * 64) + tid, NGT = G * NWAVES * 64;
    LAS float* scr = (LAS float*)(lds + wave * 16384);
    unsigned char* ws = a.ws;
    constexpr int I_GU = 16 * 176, I_D = 44 * 32, I_IN = 16 * 112, I_EFF = 16 * 8, I_O = 16 * 32;
    constexpr int NITEMS = 2 * I_GU + 2 * I_D + I_IN + I_EFF + I_O;
    for (int it = gw; it < NITEMS; it += NGW) {
        int r = it; asm volatile("" : "+s"(ws));
        if (r < I_GU) { gu_item(r, a.in[5], a.in[6], a.in[4], (bf16*)(ws + WS_WGU1), scr, lane); continue; } r -= I_GU;
        if (r < I_D) { tr_item(a.in[7], D, 32 * (r % 32), 64 * (r / 32), nullptr, (bf16*)(ws + WS_WD1), FF, 32 * (r % 32), scr, lane); continue; } r -= I_D;
        if (r < I_IN) { const int kb = r / 112, nb = r % 112, dst = 32 * nb, src = dst < 1536 ? dst : dst + 16;
            tr_item(a.in[9], DINSRC, src, 64 * kb, a.in[8], (bf16*)(ws + WS_WIN), D, dst, scr, lane); continue; } r -= I_IN;
        if (r < I_EFF) { weff_item(a.in[9], a.in[10], 32 * (r % 8), 64 * (r / 8), a.in[8], (bf16*)(ws + WS_WIN), scr, lane); continue; } r -= I_EFF;
        if (r < I_O) { tr_item(a.in[15], D, 32 * (r % 32), 64 * (r / 32), nullptr, (bf16*)(ws + WS_WO), D, 32 * (r % 32), scr, lane); continue; } r -= I_O;
        if (r < I_GU) { gu_item(r, a.in[17], a.in[18], a.in[16], (bf16*)(ws + WS_WGU2), scr, lane); continue; } r -= I_GU;
        tr_item(a.in[19], D, 32 * (r % 32), 64 * (r / 32), nullptr, (bf16*)(ws + WS_WD2), FF, 32 * (r % 32), scr, lane);
    }
    float* ssq1 = (float*)(ws + WS_SSQ); bf16* XB = (bf16*)(ws + WS_XB);
    for (int m0 = 2 * gw; m0 < M; m0 += 2 * NGW) {
        f32x4 v[2][4]; float s[2];
#pragma unroll
        for (int h = 0; h < 2; ++h) { const int m = m0 + h;
            const float* xrow = (m < MP) ? a.in[0] + (size_t)m * D : a.in[1] + (size_t)(m - MP) * D;
            const f32x4* xr = (const f32x4*)xrow + lane;
#pragma unroll
            for (int j = 0; j < 4; ++j) v[h][j] = __builtin_nontemporal_load(xr + 64 * j); }
#pragma unroll
        for (int h = 0; h < 2; ++h) { const int m = m0 + h; float ss = 0.f;
#pragma unroll
            for (int j = 0; j < 4; ++j) ss += (v[h][j].x * v[h][j].x + v[h][j].y * v[h][j].y) + (v[h][j].z * v[h][j].z + v[h][j].w * v[h][j].w);
            s[h] = wave_sum(ss);
            unsigned long long* o8 = (unsigned long long*)(XB + (size_t)m * D) + lane;
#pragma unroll
            for (int j = 0; j < 4; ++j) o8[64 * j] = (unsigned long long)pk2(v[h][j].x, v[h][j].y) | ((unsigned long long)pk2(v[h][j].z, v[h][j].w) << 32);
            if (lane == 0) ssq1[m] = s[h]; }
    }
    for (int i = gtid; i < 3 * M; i += NGT) ssq1[M + i] = 0.f;
}

__device__ __forceinline__ void p8_final(CArgs& a, int G, int bx) {
    const int tid = opaque_tid(), lane = tid & 63, wave = __builtin_amdgcn_readfirstlane(tid >> 6);
    const int gw = bx * NWAVES + wave, NGW = G * NWAVES;
    const float* ssq4 = (const float*)(a.ws + WS_SSQ) + 3 * (size_t)M; const bf16* XB = (const bf16*)(a.ws + WS_XB);
    const f32x4* g = (const f32x4*)a.in[20] + 2 * lane;
    f32x4 gv[2][2];
#pragma unroll
    for (int j = 0; j < 2; ++j) { gv[j][0] = g[128 * j]; gv[j][1] = g[128 * j + 1]; }
    for (int m0 = 2 * gw; m0 < M; m0 += 2 * NGW) {
        v4u xv[2][2];
#pragma unroll
        for (int h = 0; h < 2; ++h)
#pragma unroll
            for (int j = 0; j < 2; ++j) xv[h][j] = __builtin_nontemporal_load((const v4u*)(XB + (size_t)(m0 + h) * D) + lane + 64 * j);
#pragma unroll
        for (int h = 0; h < 2; ++h) { const float rs = rsqrtf(ssq4[m0 + h] * (1.0f / 1024.0f) + EPS); f32x4* yr = (f32x4*)(a.out + (size_t)(m0 + h) * D) + 2 * lane;
#pragma unroll
            for (int j = 0; j < 2; ++j) { const v4u x = xv[h][j];
                const f32x4 lo = {__builtin_bit_cast(float, x.x << 16), __builtin_bit_cast(float, x.x & 0xffff0000u), __builtin_bit_cast(float, x.y << 16), __builtin_bit_cast(float, x.y & 0xffff0000u)};
                const f32x4 hi = {__builtin_bit_cast(float, x.z << 16), __builtin_bit_cast(float, x.z & 0xffff0000u), __builtin_bit_cast(float, x.w << 16), __builtin_bit_cast(float, x.w & 0xffff0000u)};
                __builtin_nontemporal_store(lo * rs * gv[j][0], yr + 128 * j); __builtin_nontemporal_store(hi * rs * gv[j][1], yr + 128 * j + 1); } }
    }
}

__device__ __forceinline__ CArgs& kargs() { CArgs* p = (CArgs*)__builtin_amdgcn_kernarg_segment_ptr(); asm volatile("" : "+s"(p)); return *p; }
__global__ void __launch_bounds__(NWAVES * 64, 2) mega_fwd(Args args_unused) {
    extern __shared__ __attribute__((aligned(16))) unsigned char lds_raw[];
    cg::grid_group grid = cg::this_grid();
    LAS unsigned char* lds = (LAS unsigned char*)lds_raw;
    const int G = gridDim.x, bx = blockIdx.x;
    const int lo = kargs().ph_lo, hi = kargs().ph_hi, dup = kargs().dup;
    volatile LAS unsigned* misc = (volatile LAS unsigned*)(lds + MISC_OFF);
    if (threadIdx.x < 16) misc[threadIdx.x] = 0u;
    __syncthreads();
    XcdBarrier xbar = xcd_barrier_post((unsigned*)(kargs().ws + WS_BAR), misc);
    if (lo < 0) grid.sync();
#define IN(k) (lo <= (k) && (k) < hi)
#define BOTH(k) (IN(k) && IN((k) + 1))
#define GRID_BAR() xcd_barrier(xbar)
#define REP(k) for (int rep_ = ((dup >> (k)) & 1); rep_ >= 0; --rep_)
#define STAGGER(us_step) do { const unsigned long long t0_ = __builtin_amdgcn_s_memrealtime(); const unsigned long long d_ = (unsigned long long)(((bx >> 3) & 7) * (us_step)) * 100ull; \
        while (__builtin_amdgcn_s_memrealtime() - t0_ < d_) __builtin_amdgcn_s_sleep(8); } while (0)
#define SSQ(a, i) ((float*)((a).ws + WS_SSQ) + (size_t)(i) * M)

    if (IN(0)) REP(0) { p0_prologue(kargs(), lds, G, bx); if (BOTH(0)) GRID_BAR(); }
    if (IN(1)) REP(1) {
        CArgs& a = kargs(); unsigned char* ws = a.ws;
        pg8::Gemm g{(const bf16*)(ws + WS_XB), (const bf16*)(ws + WS_WGU1), MP, 2 * FF, D}; pg8::StaticOrder S; S.init(MP, 2 * FF, G, bx);
        pg8::EpiUp E{(bf16*)(ws + WS_HID), FF, SSQ(a, 0)};
#define SMALL_UP(WOFF, SIDX) for (int u = bx; u < FF / 16; u += G) { const int hc0 = 16 * u; const bf16* W = (const bf16*)(ws + (WOFF)) + (size_t)((hc0 >> 7) * 256 + (hc0 & 127)) * D; \
            sg::EpiUpS Es{(bf16*)(ws + WS_HID) + (size_t)MP * FF, FF, SSQ(a, SIDX) + MP, hc0}; sg::unit<2>(lds, (const bf16*)(ws + WS_XB) + (size_t)MP * D, D, W, W + (size_t)128 * D, Es); }
        const bool pre = bx < G / 2;
        if (pre) { SMALL_UP(WS_WGU1, 0) __syncthreads(); }
        pg8::gemm_phase<pg8::EpiUp, pg8::StaticOrder, true, true>(lds, g, S, E);
        if (!pre) { SMALL_UP(WS_WGU1, 0) }
        if (BOTH(1)) GRID_BAR();
    }
    if (IN(2)) REP(2) {
        CArgs& a = kargs(); unsigned char* ws = a.ws;
        pg8::Gemm g{(const bf16*)(ws + WS_HID), (const bf16*)(ws + WS_WD1), MP, D, FF, 1}; pg8::StaticOrder S; S.init(MP, D, G, bx);
        pg8::EpiRes E{nullptr, nullptr, 1 << 30, (bf16*)(ws + WS_XB), rep_ ? (float*)(ws + WS_DUMMY) : SSQ(a, 1), rep_ ? 0.f : 0.5f};
#define SMALL_DOWN(WOFF, SIDX) for (int u = bx; u < 2 * (D / 16); u += G) { const int c0 = 16 * (u >> 1), rb = 128 * (u & 1); const bf16* W = (const bf16*)(ws + (WOFF)) + (size_t)c0 * FF; \
            sg::EpiResS1 Es{(bf16*)(ws + WS_XB) + (size_t)MP * D, (rep_ ? (float*)(ws + WS_DUMMY) : SSQ(a, SIDX)) + MP, rep_ ? 0.f : 0.5f, c0, rb}; sg::unit_k256(lds, (const bf16*)(ws + WS_HID) + (size_t)(MP + rb) * FF, FF, W, Es); }
        const bool pre = bx < G / 2;
        if (pre) { SMALL_DOWN(WS_WD1, 1) __syncthreads(); }
        pg8::gemm_phase<pg8::EpiRes, pg8::StaticOrder, true, true>(lds, g, S, E);
        if (!pre) { SMALL_DOWN(WS_WD1, 1) }
        if (BOTH(2)) GRID_BAR();
    }
    if (IN(3)) REP(3) {
        CArgs& a = kargs(); unsigned char* ws = a.ws;
        pg8::Gemm g{(const bf16*)(ws + WS_XB), (const bf16*)(ws + WS_WIN), MP, NIN, D}; pg8::StaticOrder S; S.init(MP, NIN, G, bx);
        pg8::EpiWin E{(bf16*)(ws + WS_P), (float*)(ws + WS_GA), SSQ(a, 1), a.in[11]};
        for (int u = (bx + G / 2) % G; u < NIN / 32; u += G) { const int c0 = 32 * u; const bf16* W = (const bf16*)(ws + WS_WIN) + (size_t)c0 * D;
            sg::EpiWinS Es{(bf16*)(ws + WS_P) + (size_t)MP * PW, (float*)(ws + WS_GA) + (size_t)MP * 256, SSQ(a, 1) + MP, a.in[11], c0}; sg::unit<2>(lds, (const bf16*)(ws + WS_XB) + (size_t)MP * D, D, W, W + (size_t)16 * D, Es); }
        __syncthreads();
        pg8::gemm_phase<pg8::EpiWin, pg8::StaticOrder, true, true>(lds, g, S, E);
        if (BOTH(3)) GRID_BAR();
    }
#define MAKE_RA(a) rec::RecArgs ra{(const bf16*)((a).ws + WS_P), (const float*)((a).ws + WS_GA), (bf16*)((a).ws + WS_MIX), (a).in[13], (a).in[12], (a).in[14], (a).in[2], (a).in[3], \
                        (float*)((a).ws + WS_ST), (float*)((a).ws + WS_DT), (a).out + O_SGP, (a).out + O_SHP, (a).out + O_SGS, (a).out + O_SHS}
    if (IN(4)) REP(4) { CArgs& a = kargs(); MAKE_RA(a); rec::phase_r1(lds, ra, G, bx); if (BOTH(4)) GRID_BAR(); }
    if (IN(5)) { CArgs& a = kargs(); MAKE_RA(a); rec::phase_r2(ra, bx * (NWAVES * 64) + opaque_tid(), G * NWAVES * 64); if (BOTH(5)) GRID_BAR(); }
    if (IN(6)) REP(6) { CArgs& a = kargs(); MAKE_RA(a); rec::phase_r3(lds, ra, G, bx); if (BOTH(6)) GRID_BAR(); }
    if (IN(7)) REP(7) {
        CArgs& a = kargs(); unsigned char* ws = a.ws;
        pg8::Gemm g{(const bf16*)(ws + WS_MIX), (const bf16*)(ws + WS_WO), MP, D, D}; pg8::StaticOrder S; S.init(MP, D, G, bx);
        pg8::EpiRes E{nullptr, nullptr, 1 << 30, (bf16*)(ws + WS_XB), rep_ ? (float*)(ws + WS_DUMMY) : SSQ(a, 2), rep_ ? 0.f : 1.0f};
#define SMALL_OUT() for (int u = bx; u < D / 16; u += G) { const int c0 = 16 * u; const bf16* W = (const bf16*)(ws + WS_WO) + (size_t)c0 * D; \
            sg::EpiResS Es{nullptr, (bf16*)(ws + WS_XB) + (size_t)MP * D, (rep_ ? (float*)(ws + WS_DUMMY) : SSQ(a, 2)) + MP, rep_ ? 0.f : 1.0f, c0}; sg::unit<1>(lds, (const bf16*)(ws + WS_MIX) + (size_t)MP * D, D, W, W, Es); }
        const bool pre = bx < G / 2;
        if (pre) { SMALL_OUT() __syncthreads(); }
        pg8::gemm_phase<pg8::EpiRes, pg8::StaticOrder, true, true>(lds, g, S, E);
        if (!pre) { SMALL_OUT() }
        if (BOTH(7)) GRID_BAR();
    }
    if (IN(8)) REP(8) {
        CArgs& a = kargs(); unsigned char* ws = a.ws;
        pg8::Gemm g{(const bf16*)(ws + WS_XB), (const bf16*)(ws + WS_WGU2), MP, 2 * FF, D}; pg8::StaticOrder S; S.init(MP, 2 * FF, G, bx);
        pg8::EpiUp E{(bf16*)(ws + WS_HID), FF, SSQ(a, 2)};
        const bool pre = bx < G / 2;
        if (pre) { SMALL_UP(WS_WGU2, 2) __syncthreads(); }
        pg8::gemm_phase<pg8::EpiUp, pg8::StaticOrder, true, true>(lds, g, S, E);
        if (!pre) { SMALL_UP(WS_WGU2, 2) }
        if (BOTH(8)) GRID_BAR();
    }
    if (IN(9)) REP(9) {
        CArgs& a = kargs(); unsigned char* ws = a.ws;
        pg8::Gemm g{(const bf16*)(ws + WS_HID), (const bf16*)(ws + WS_WD2), MP, D, FF, 1}; pg8::StaticOrder S; S.init(MP, D, G, bx);
        pg8::EpiRes E{nullptr, nullptr, 1 << 30, (bf16*)(ws + WS_XB), rep_ ? (float*)(ws + WS_DUMMY) : SSQ(a, 3), rep_ ? 0.f : 0.5f};
        const bool pre = bx < G / 2;
        if (pre) { SMALL_DOWN(WS_WD2, 3) __syncthreads(); }
        pg8::gemm_phase<pg8::EpiRes, pg8::StaticOrder, true, true>(lds, g, S, E);
        if (!pre) { SMALL_DOWN(WS_WD2, 3) }
        if (BOTH(9)) GRID_BAR();
    }
    if (IN(10)) p8_final(kargs(), G, bx);
    if (dup & 2048) for (int i = 0; i < 20; ++i) GRID_BAR();
#undef IN
#undef BOTH
}

extern "C" void kernel_launch(void* const* d_in, const int* in_sizes, int n_in, void* d_out, int out_size, void* d_ws, size_t ws_size, hipStream_t stream) {
    static int grid = 0;
    if (grid == 0) {
        if (n_in != 21 || out_size != (int)O_END || ws_size < WS_END) { fprintf(stderr, "kernel_launch: unexpected sizes n_in %d out %d ws %zu\n", n_in, out_size, ws_size); grid = -1; return; }
        int dev = 0, cus = 0, per_cu = 0;
        (void)hipGetDevice(&dev); (void)hipDeviceGetAttribute(&cus, hipDeviceAttributeMultiprocessorCount, dev);
        if (hipFuncSetAttribute((const void*)mega_fwd, hipFuncAttributeMaxDynamicSharedMemorySize, LDS_BYTES) != hipSuccess) { fprintf(stderr, "hipFuncSetAttribute failed\n"); grid = -1; return; }
        if (hipOccupancyMaxActiveBlocksPerMultiprocessor(&per_cu, (const void*)mega_fwd, NWAVES * 64, LDS_BYTES) != hipSuccess || per_cu < 1) { fprintf(stderr, "occupancy query: %d\n", per_cu); per_cu = 1; }
        (void)hipGetLastError();
        grid = cus * per_cu;
    }
    if (grid < 0) return;
    Args a{};
    for (int i = 0; i < 21; ++i) a.in[i] = (const float*)d_in[i];
    a.out = (float*)d_out; a.ws = (unsigned char*)d_ws;
    a.ph_lo = 0; a.ph_hi = 11; a.dup = DUPMASK;
    if (hipMemsetAsync((char*)d_ws + WS_BAR, 0, BAR_BYTES, stream) != hipSuccess) { fprintf(stderr, "kernel_launch: memset of the barrier words failed\n"); return; }
    void* kargs[] = {&a};
    hipError_t e = hipLaunchCooperativeKernel((const void*)mega_fwd, dim3(grid), dim3(NWAVES * 64), kargs, LDS_BYTES, stream);
    if (e != hipSuccess) fprintf(stderr, "cooperative launch failed: %s (grid %d)\n", hipGetErrorString(e), grid);
}
```
